# Optimizing an MI355X kernel written in HIP

```python
import math
import jax
import jax.numpy as jnp
from jax import lax
import numpy as np

D_MODEL = 1024
BATCH = 2
SEQ = 8192
DEPTH = 4

HEAD_DIM = 64
Q_BLOCK = 128
GLA_HEADS = 4
GLA_DK = 64
GLA_DV = 128
GLA_GATE_RANK = 16
GLA_GATE_TAU = 16.0
GLA_CHUNK = 64
DSA_HEADS = 8
IDX_HEADS = 8
IDX_DIM = 64
DSA_TOPK_MAX = 256
FOX_HEADS = 8
FORGET_BIAS_MEAN = 2.0
DIL_HEADS = 8
DIL_PATTERNS = ((128, 1), (512, 4), (2048, 16))
REL_BUCKETS = 32
REL_MAX_DIST = 2048
REL_HEADS = 8
D_FF = 2816
N_EXPERTS = 8
TOP_K = 2
D_FF_EXPERT = 3584
ALPHA = (2 * DEPTH) ** 0.25
BETA = (8 * DEPTH) ** -0.25
LN_EPS = 1e-5

AB_SPLITS = (GLA_HEADS * GLA_DK, GLA_HEADS * GLA_DK, GLA_HEADS * GLA_DV, GLA_HEADS * GLA_DV, GLA_GATE_RANK,
             DSA_HEADS * HEAD_DIM, DSA_HEADS * HEAD_DIM, DSA_HEADS * HEAD_DIM,
             IDX_HEADS * IDX_DIM, IDX_DIM, IDX_HEADS)
CD_SPLITS = (FOX_HEADS * HEAD_DIM, FOX_HEADS * HEAD_DIM, FOX_HEADS * HEAD_DIM, FOX_HEADS,
             DIL_HEADS * HEAD_DIM, DIL_HEADS * HEAD_DIM, DIL_HEADS * HEAD_DIM)
W_AB = sum(AB_SPLITS)
W_CD = sum(CD_SPLITS)
MIX_AB = GLA_HEADS * GLA_DV + DSA_HEADS * HEAD_DIM
MIX_CD = (FOX_HEADS + DIL_HEADS) * HEAD_DIM

kernel_name = "hybrid_gla_dsa_fox_dilated_moe"


def _split(y, sizes):
    idx = [int(v) for v in np.cumsum(sizes)[:-1]]
    return jnp.split(y, idx, axis=-1)


def _layernorm(x, g, b):
    xf = x.astype(jnp.float32)
    mu = jnp.mean(xf, axis=-1, keepdims=True)
    var = jnp.mean(jnp.square(xf - mu), axis=-1, keepdims=True)
    return ((xf - mu) * lax.rsqrt(var + LN_EPS) * g + b).astype(x.dtype)


def _rel_bucket(dist):
    max_exact = REL_BUCKETS // 2
    d = jnp.maximum(dist, 0)
    df = jnp.maximum(d, 1).astype(jnp.float32)
    large = max_exact + (jnp.log(df / max_exact) / math.log(REL_MAX_DIST / max_exact)
                         * (REL_BUCKETS - max_exact)).astype(jnp.int32)
    large = jnp.minimum(large, REL_BUCKETS - 1)
    return jnp.where(d < max_exact, d, large)


def _gla(q, k, v, g_log):
    B, L, H, dk = q.shape
    dv = v.shape[-1]
    C = GLA_CHUNK
    n = L // C

    def to_chunks(t):
        return t.reshape(B, n, C, H, t.shape[-1]).transpose(1, 0, 3, 2, 4)

    qc, kc, vc, gc = (to_chunks(q * dk ** -0.5), to_chunks(k), to_chunks(v), to_chunks(g_log))
    causal = jnp.tril(jnp.ones((C, C), dtype=bool))[None, None, :, :, None]

    def step(S, inp):
        qi, ki, vi, gi = inp
        G = jnp.cumsum(gi.astype(jnp.float32), axis=2)
        o_inter = jnp.einsum('bhck,bhkv->bhcv', qi * jnp.exp(G), S)
        diff = G[:, :, :, None, :] - G[:, :, None, :, :]
        decay = jnp.exp(jnp.where(causal, diff, -jnp.inf))
        A = jnp.einsum('bhtk,bhsk,bhtsk->bhts', qi, ki, decay)
        o_intra = jnp.einsum('bhts,bhsv->bhtv', A, vi)
        G_last = G[:, :, -1:, :]
        S_new = (jnp.exp(G_last[:, :, 0, :, None]) * S
                 + jnp.einsum('bhsk,bhsv->bhkv', ki * jnp.exp(G_last - G), vi))
        return S_new, o_inter + o_intra

    S0 = jnp.zeros((B, H, dk, dv), jnp.float32)
    _, o = lax.scan(step, S0, (qc, kc, vc, gc))
    return o.transpose(1, 0, 3, 2, 4).reshape(B, L, H, dv).astype(v.dtype)


def _dsa(q, k, v, q_idx, k_idx, w_idx, rel_table):
    B, L, H, dh = q.shape
    topk = min(DSA_TOPK_MAX, L // 4)
    pos = jnp.arange(L)
    gather = jax.vmap(lambda t, i: t[i])

    def block(i):
        q0 = i * Q_BLOCK
        tq = q0 + jnp.arange(Q_BLOCK)
        qib = lax.dynamic_slice_in_dim(q_idx, q0, Q_BLOCK, axis=1)
        wib = lax.dynamic_slice_in_dim(w_idx, q0, Q_BLOCK, axis=1)
        s = jnp.einsum('bqhd,bkd->bhqk', qib, k_idx).astype(jnp.float32)
        score = jnp.einsum('bqh,bhqk->bqk', wib.astype(jnp.float32), jax.nn.relu(s))
        causal = pos[None, :] <= tq[:, None]
        score = jnp.where(causal[None], score, -jnp.inf)
        _, sel = lax.top_k(score, topk)
        valid = sel <= tq[None, :, None]
        ksel = gather(k, sel)
        vsel = gather(v, sel)
        qb = lax.dynamic_slice_in_dim(q, q0, Q_BLOCK, axis=1)
        logits = jnp.einsum('bqhd,bqkhd->bhqk', qb, ksel).astype(jnp.float32) * dh ** -0.5
        bias = rel_table[_rel_bucket(tq[None, :, None] - sel)]
        logits = logits + bias.transpose(0, 3, 1, 2).astype(jnp.float32)
        logits = jnp.where(valid[:, None], logits, -jnp.inf)
        p = jax.nn.softmax(logits, axis=-1)
        return jnp.einsum('bhqk,bqkhd->bqhd', p.astype(v.dtype), vsel)

    out = lax.map(block, jnp.arange(L // Q_BLOCK))
    return out.transpose(1, 0, 2, 3, 4).reshape(B, L, H, dh)


def _fox(q, k, v, log_f):
    B, L, H, dh = q.shape
    F = jnp.cumsum(log_f, axis=1).transpose(0, 2, 1)
    pos = jnp.arange(L)

    def block(i):
        q0 = i * Q_BLOCK
        tq = q0 + jnp.arange(Q_BLOCK)
        qb = lax.dynamic_slice_in_dim(q, q0, Q_BLOCK, axis=1)
        Fq = lax.dynamic_slice_in_dim(F, q0, Q_BLOCK, axis=2)
        logits = (jnp.einsum('bqhd,bkhd->bhqk', qb, k).astype(jnp.float32) * dh ** -0.5
                  + Fq[..., None] - F[:, :, None, :])
        causal = pos[None, :] <= tq[:, None]
        logits = jnp.where(causal[None, None], logits, -jnp.inf)
        p = jax.nn.softmax(logits, axis=-1)
        return jnp.einsum('bhqk,bkhd->bqhd', p.astype(v.dtype), v)

    out = lax.map(block, jnp.arange(L // Q_BLOCK))
    return out.transpose(1, 0, 2, 3, 4).reshape(B, L, H, dh)


def _dilated(q, k, v, rel_table):
    B, L, H, dh = q.shape

    def block(i):
        q0 = i * Q_BLOCK
        tq = q0 + jnp.arange(Q_BLOCK)
        qb = lax.dynamic_slice_in_dim(q, q0, Q_BLOCK, axis=1)
        outs, log_den = [], []
        for window, dil in DIL_PATTERNS:
            offs = dil * jnp.arange(window // dil + 1)
            idx = tq[:, None] - offs[None, :]
            valid = idx >= 0
            idxc = jnp.maximum(idx, 0)
            ksel = k[:, idxc]
            vsel = v[:, idxc]
            bias = rel_table[_rel_bucket(offs)].T.astype(jnp.float32)
            lg = (jnp.einsum('bqhd,bqjhd->bhqj', qb, ksel).astype(jnp.float32) * dh ** -0.5
                  + bias[None, :, None, :])
            lg = jnp.where(valid[None, None], lg, -jnp.inf)
            m = jnp.max(lg, axis=-1, keepdims=True)
            e = jnp.exp(lg - m)
            s = jnp.sum(e, axis=-1, keepdims=True)
            outs.append(jnp.einsum('bhqj,bqjhd->bhqd', e, vsel.astype(jnp.float32)) / s)
            log_den.append(m + jnp.log(s))
        wts = jax.nn.softmax(jnp.stack(log_den, 0), axis=0)
        o = jnp.sum(wts * jnp.stack(outs, 0), axis=0)
        return o.transpose(0, 2, 1, 3).astype(v.dtype)

    out = lax.map(block, jnp.arange(L // Q_BLOCK))
    return out.transpose(1, 0, 2, 3, 4).reshape(B, L, H, dh)


def _mixer_ab(x, w_in, w_gate, b_gate, g_norm, w_out, rel_table):
    B, L, _ = x.shape
    y = x @ w_in
    qa, ka, va, ra, ga, qb, kb, vb, qi, ki, wi = _split(y, AB_SPLITS)
    g_log = jax.nn.log_sigmoid((ga @ w_gate + b_gate).astype(jnp.float32)) / GLA_GATE_TAU
    oa = _gla(qa.reshape(B, L, GLA_HEADS, GLA_DK), ka.reshape(B, L, GLA_HEADS, GLA_DK),
              va.reshape(B, L, GLA_HEADS, GLA_DV), g_log.reshape(B, L, GLA_HEADS, GLA_DK))
    of = oa.astype(jnp.float32)
    of = of * lax.rsqrt(jnp.mean(jnp.square(of), axis=-1, keepdims=True) + LN_EPS) * g_norm
    oa = of.astype(x.dtype) * jax.nn.silu(ra.reshape(B, L, GLA_HEADS, GLA_DV))
    ob = _dsa(qb.reshape(B, L, DSA_HEADS, HEAD_DIM), kb.reshape(B, L, DSA_HEADS, HEAD_DIM),
              vb.reshape(B, L, DSA_HEADS, HEAD_DIM), qi.reshape(B, L, IDX_HEADS, IDX_DIM), ki, wi, rel_table)
    o = jnp.concatenate([oa.reshape(B, L, -1), ob.reshape(B, L, -1)], axis=-1)
    return o @ w_out


def _mixer_cd(x, w_in, b_forget, w_out, rel_table):
    B, L, _ = x.shape
    y = x @ w_in
    qc, kc, vc, fc, qd, kd, vd = _split(y, CD_SPLITS)
    log_f = jax.nn.log_sigmoid((fc + b_forget).astype(jnp.float32))
    oc = _fox(qc.reshape(B, L, FOX_HEADS, HEAD_DIM), kc.reshape(B, L, FOX_HEADS, HEAD_DIM),
              vc.reshape(B, L, FOX_HEADS, HEAD_DIM), log_f)
    od = _dilated(qd.reshape(B, L, DIL_HEADS, HEAD_DIM), kd.reshape(B, L, DIL_HEADS, HEAD_DIM),
                  vd.reshape(B, L, DIL_HEADS, HEAD_DIM), rel_table)
    o = jnp.concatenate([oc.reshape(B, L, -1), od.reshape(B, L, -1)], axis=-1)
    return o @ w_out


def _swiglu(x, w1, w3, w2):
    return (jax.nn.silu(x @ w1) * (x @ w3)) @ w2


def _moe(x, w_router, w1, w3, w2):
    logits = (x @ w_router).astype(jnp.float32)
    top_v, top_i = lax.top_k(logits, TOP_K)
    gates = jax.nn.softmax(top_v, axis=-1)
    combine = jnp.sum(jax.nn.one_hot(top_i, N_EXPERTS, dtype=jnp.float32) * gates[..., None], axis=-2)
    combine = combine.astype(x.dtype)
    y = jnp.zeros_like(x)
    for e in range(N_EXPERTS):
        y = y + _swiglu(x, w1[e], w3[e], w2[e]) * combine[..., e:e + 1]
    return y


def setup_inputs(seed: int = 0) -> dict:
    key = jax.random.key(seed)
    ks = iter(jax.random.split(key, 32))
    n_e = (DEPTH + 1) // 2
    n_o = DEPTH // 2

    def nrm(shape, scale):
        return jax.random.normal(next(ks), shape, jnp.float32) * scale

    return {
        "x": nrm((BATCH, SEQ, D_MODEL), 1.0),
        "ln_g": 1.0 + nrm((DEPTH, 2, D_MODEL), 0.02),
        "ln_b": nrm((DEPTH, 2, D_MODEL), 0.02),
        "rel_table": nrm((REL_BUCKETS, REL_HEADS), 0.2),
        "w_in_ab": nrm((n_e, D_MODEL, W_AB), D_MODEL ** -0.5),
        "w_gate_a": nrm((n_e, GLA_GATE_RANK, GLA_HEADS * GLA_DK), GLA_GATE_RANK ** -0.5),
        "b_gate_a": nrm((n_e, GLA_HEADS * GLA_DK), 0.1),
        "g_norm_a": 1.0 + nrm((n_e, GLA_DV), 0.02),
        "w_out_ab": nrm((n_e, MIX_AB, D_MODEL), MIX_AB ** -0.5 * BETA),
        "w_in_cd": nrm((n_o, D_MODEL, W_CD), D_MODEL ** -0.5),
        "b_forget": FORGET_BIAS_MEAN + nrm((n_o, FOX_HEADS), 0.1),
        "w_out_cd": nrm((n_o, MIX_CD, D_MODEL), MIX_CD ** -0.5 * BETA),
        "w1_dense": nrm((n_e, D_MODEL, D_FF), D_MODEL ** -0.5),
        "w3_dense": nrm((n_e, D_MODEL, D_FF), D_MODEL ** -0.5),
        "w2_dense": nrm((n_e, D_FF, D_MODEL), D_FF ** -0.5 * BETA),
        "w_router": nrm((n_o, D_MODEL, N_EXPERTS), D_MODEL ** -0.5),
        "w1_moe": nrm((n_o, N_EXPERTS, D_MODEL, D_FF_EXPERT), D_MODEL ** -0.5),
        "w3_moe": nrm((n_o, N_EXPERTS, D_MODEL, D_FF_EXPERT), D_MODEL ** -0.5),
        "w2_moe": nrm((n_o, N_EXPERTS, D_FF_EXPERT, D_MODEL), D_FF_EXPERT ** -0.5 * BETA),
    }


def reference(x, ln_g, ln_b, rel_table, w_in_ab, w_gate_a, b_gate_a, g_norm_a, w_out_ab,
              w_in_cd, b_forget, w_out_cd, w1_dense, w3_dense, w2_dense,
              w_router, w1_moe, w3_moe, w2_moe):
    for layer in range(DEPTH):
        j = layer // 2
        if layer % 2 == 0:
            mix = _mixer_ab(x, w_in_ab[j], w_gate_a[j], b_gate_a[j], g_norm_a[j], w_out_ab[j], rel_table)
        else:
            mix = _mixer_cd(x, w_in_cd[j], b_forget[j], w_out_cd[j], rel_table)
        x = _layernorm(ALPHA * x + mix, ln_g[layer, 0], ln_b[layer, 0])
        if layer % 2 == 0:
            ffn = _swiglu(x, w1_dense[j], w3_dense[j], w2_dense[j])
        else:
            ffn = _moe(x, w_router[j], w1_moe[j], w3_moe[j], w2_moe[j])
        x = _layernorm(ALPHA * x + ffn, ln_g[layer, 1], ln_b[layer, 1])
    return x
```

```cpp
#include <hip/hip_runtime.h>
#include <cstdio>
#include <cstdint>
#include <cmath>
namespace pg8 {
#define PG8_LAS __attribute__((address_space(3)))
typedef unsigned short bf16_t;
typedef short bf16x8 __attribute__((ext_vector_type(8)));
typedef float f32x4 __attribute__((ext_vector_type(4)));
typedef unsigned u32x4 __attribute__((ext_vector_type(4)));
constexpr int BM = 256, BK = 64, HALF = 128, HTB = HALF * BK * 2  , STAGE_BYTES = 8 * HTB, NXCD = 8, WGM = 8;

__host__ __device__ __forceinline__ int lds_byte(int r, int c) { const int st = (r >> 4) * 2 + (c >> 5), rr = r & 15, cc = c & 31, ob = rr * 64 + cc * 2; return st * 1024 + (ob ^ (((ob >> 9) & 1) << 5)); }
__host__ __device__ __forceinline__ void stage_rc(int b, int& R, int& C) { const int st = b / 1024, sb = b % 1024, swz = sb ^ (((sb >> 9) & 1) << 5); R = (st >> 1) * 16 + swz / 64; C = (st & 1) * 32 + (swz % 64) / 2; }
__host__ __device__ __forceinline__ int perm32(int rho) { const int n = rho >> 4, i = rho & 15; return 8 * (i >> 2) + 4 * n + (i & 3); }

struct Unit { int pm, pn; };
struct Gemm { const bf16_t* A; const bf16_t* Bt; int M, N, K; };

struct StaticOrder {
    int nM, nN, nwg, G, c;
    __host__ __device__ void init(int M, int N, int G_, int c_) { nM = M / BM; nN = N / BM; nwg = nM * nN; G = G_; c = c_; }
    __host__ __device__ bool next(int i, Unit& u) const {
        const long L = (long)i * G + c; if (L >= nwg) return false;
        int wgid = (int)L; { const int q = nwg / NXCD, r = nwg % NXCD, xcd = wgid % NXCD, off = wgid / NXCD; wgid = (xcd < r ? xcd * (q + 1) : r * (q + 1) + (xcd - r) * q) + off; }
        const int nig = WGM * nN, gid = wgid / nig, fm = gid * WGM, gsz = (nM - fm) < WGM ? (nM - fm) : WGM;
        u.pm = fm + ((wgid % nig) % gsz); u.pn = (wgid % nig) / gsz; return true;
    }
    __device__ __forceinline__ void a_ready(const Unit&) const {}
    __device__ __forceinline__ void done(const Unit&) const {}
};

__device__ __forceinline__ unsigned cvt_pk_bf16(float lo, float hi) { unsigned r; asm volatile("v_cvt_pk_bf16_f32 %0, %1, %2" : "=v"(r) : "v"(lo), "v"(hi)); return r; }
typedef float f32x2 __attribute__((ext_vector_type(2)));
constexpr float QC2 = 0.125f * 1.4426950408889634f;

constexpr size_t ACT_MB = 1u << 20;
constexpr size_t A_QA = 0, A_KA = 8 * ACT_MB, A_VA = 16 * ACT_MB, A_RA = 32 * ACT_MB, A_QB = 48 * ACT_MB, A_KB = 64 * ACT_MB, A_VB = 80 * ACT_MB, A_QI = 96 * ACT_MB,
                 A_SMALL = 112 * ACT_MB  , A_KI = 114 * ACT_MB  ;
constexpr size_t A_QC = 0, A_KC = 16 * ACT_MB, A_VC = 32 * ACT_MB, A_QD = 48 * ACT_MB, A_KD = 64 * ACT_MB, A_VD = 80 * ACT_MB;
struct EpiProj {
    static constexpr bool PERM = true, AFTER_DRAIN = false;
    unsigned char* act; int mode;
    __device__ __forceinline__ void operator()(const f32x4 (&acc)[2][2][4][2], const Unit& u, int wr, int wc, int fr, int fq) const {
        const int row0 = u.pm * BM + wr * 64 + fr; const int pn = u.pn;
        if (mode == 0 && pn == 14) {
            float* sm = (float*)(act + A_SMALL); bf16_t* ki = (bf16_t*)(act + A_KI);
            if (wc < 3) {
#pragma unroll
                for (int ai = 0; ai < 2; ++ai)
#pragma unroll
                    for (int m = 0; m < 4; ++m) { const int row = row0 + ai * HALF + m * 16; const f32x4 v0 = acc[ai][0][m][0], v1 = acc[ai][0][m][1];
                        const int cl = wc * 32 + 8 * fq;
                        if (cl < 16) { *(f32x4*)(sm + (size_t)row * 32 + cl) = v0; *(f32x4*)(sm + (size_t)row * 32 + cl + 4) = v1; }
                        else if (cl < 80) { u32x4 w; w.x = cvt_pk_bf16(v0[0], v0[1]); w.y = cvt_pk_bf16(v0[2], v0[3]); w.z = cvt_pk_bf16(v1[0], v1[1]); w.w = cvt_pk_bf16(v1[2], v1[3]);
                            *(u32x4*)(ki + (size_t)row * 64 + (cl - 16)) = w; }
                        else if (cl < 88) { *(f32x4*)(sm + (size_t)row * 32 + 16) = v0; *(f32x4*)(sm + (size_t)row * 32 + 20) = v1; } }
            }
            return;
        }
        size_t off; int ld, colt; float sc = 1.f;
        if (mode == 0) {
            if (pn == 0) { off = A_QA; ld = 256; colt = 0; sc = 0.125f; }
            else if (pn == 1) { off = A_KA; ld = 256; colt = 0; }
            else { const int t = (pn - 2) >> 1; colt = ((pn - 2) & 1) * 256; ld = 512; off = A_VA + (size_t)t * 16 * ACT_MB; if (t == 2) sc = QC2; }
        } else { const int t = pn >> 1; colt = (pn & 1) * 256; ld = 512; off = (size_t)t * 16 * ACT_MB; if (t == 0 || t == 3) sc = QC2; }
        bf16_t* base = (bf16_t*)(act + off);
        const int col0 = colt + wc * 32 + 8 * fq;
#pragma unroll
        for (int ai = 0; ai < 2; ++ai)
#pragma unroll
            for (int m = 0; m < 4; ++m) { bf16_t* rowp = base + (size_t)(row0 + ai * HALF + m * 16) * ld + col0;
#pragma unroll
                for (int bj = 0; bj < 2; ++bj) { const f32x4 v0 = acc[ai][bj][m][0] * sc, v1 = acc[ai][bj][m][1] * sc;
                    u32x4 w; w.x = cvt_pk_bf16(v0[0], v0[1]); w.y = cvt_pk_bf16(v0[2], v0[3]); w.z = cvt_pk_bf16(v1[0], v1[1]); w.w = cvt_pk_bf16(v1[2], v1[3]);
                    *(u32x4*)(rowp + bj * HALF) = w; } }
    }
};
struct EpiPlain {
    static constexpr bool PERM = true, AFTER_DRAIN = false;
    bf16_t* O; int ld, nct;
    __device__ __forceinline__ void operator()(const f32x4 (&acc)[2][2][4][2], const Unit& u, int wr, int wc, int fr, int fq) const {
        const int row0 = u.pm * BM + wr * 64 + fr; const int col0 = (u.pn % nct) * BM + wc * 32 + 8 * fq;
#pragma unroll
        for (int ai = 0; ai < 2; ++ai)
#pragma unroll
            for (int m = 0; m < 4; ++m) { bf16_t* rowp = O + (size_t)(row0 + ai * HALF + m * 16) * ld + col0;
#pragma unroll
                for (int bj = 0; bj < 2; ++bj) { const f32x4 v0 = acc[ai][bj][m][0], v1 = acc[ai][bj][m][1];
                    u32x4 w; w.x = cvt_pk_bf16(v0[0], v0[1]); w.y = cvt_pk_bf16(v0[2], v0[3]); w.z = cvt_pk_bf16(v1[0], v1[1]); w.w = cvt_pk_bf16(v1[2], v1[3]);
                    *(u32x4*)(rowp + bj * HALF) = w; } }
    }
};
__device__ __forceinline__ float silu_mul(float a, float b) { return a * b * __builtin_amdgcn_rcpf(1.0f + __builtin_amdgcn_exp2f(-1.4426950408889634f * a)); }
struct EpiSwiGLU {
    static constexpr bool PERM = true, AFTER_DRAIN = false;
    bf16_t* H; int ld, nct;
    __device__ __forceinline__ void operator()(const f32x4 (&acc)[2][2][4][2], const Unit& u, int wr, int wc, int fr, int fq) const {
        const int row0 = u.pm * BM + wr * 64 + fr; const int col0 = (u.pn % nct) * HALF + wc * 32 + 8 * fq;
#pragma unroll
        for (int ai = 0; ai < 2; ++ai)
#pragma unroll
            for (int m = 0; m < 4; ++m) { bf16_t* rowp = H + (size_t)(row0 + ai * HALF + m * 16) * ld + col0;
                const f32x4 a0 = acc[ai][0][m][0], a1 = acc[ai][0][m][1], b0 = acc[ai][1][m][0], b1 = acc[ai][1][m][1];
                u32x4 w; w.x = cvt_pk_bf16(silu_mul(a0[0], b0[0]), silu_mul(a0[1], b0[1])); w.y = cvt_pk_bf16(silu_mul(a0[2], b0[2]), silu_mul(a0[3], b0[3]));
                w.z = cvt_pk_bf16(silu_mul(a1[0], b1[0]), silu_mul(a1[1], b1[1])); w.w = cvt_pk_bf16(silu_mul(a1[2], b1[2]), silu_mul(a1[3], b1[3]));
                *(u32x4*)rowp = w; }
    }
};
struct GroupOrder {
    int ts0, ts1, ts2, ts3, ts4, ts5, ts6, ts7, ts8; int nct, total, G, c;
    __device__ __forceinline__ void init(const int (&ts)[9], int nct_, int G_, int c_) { ts0 = ts[0]; ts1 = ts[1]; ts2 = ts[2]; ts3 = ts[3]; ts4 = ts[4]; ts5 = ts[5]; ts6 = ts[6]; ts7 = ts[7]; ts8 = ts[8];
        nct = nct_; total = (ts8 - ts0) * nct_; G = G_; c = c_; }
    __device__ __forceinline__ bool next(int i, Unit& u) const {
        const long L = (long)i * G + c; if (L >= total) return false;
        int w = (int)L; { const int q = total / NXCD, r = total % NXCD, xcd = w % NXCD, off = w / NXCD; w = (xcd < r ? xcd * (q + 1) : r * (q + 1) + (xcd - r) * q) + off; }
        int e = 0, first = ts0, T = ts1 - ts0;
#define PG8_GO_STEP(E, A, B) if (e == (E) - 1 && w >= T * nct) { w -= T * nct; e = (E); first = (A); T = (B) - (A); }
        PG8_GO_STEP(1, ts1, ts2) PG8_GO_STEP(2, ts2, ts3) PG8_GO_STEP(3, ts3, ts4) PG8_GO_STEP(4, ts4, ts5) PG8_GO_STEP(5, ts5, ts6) PG8_GO_STEP(6, ts6, ts7) PG8_GO_STEP(7, ts7, ts8)
#undef PG8_GO_STEP
        const int nig = WGM * nct, gid = w / nig, fm = gid * WGM, gsz = (T - fm) < WGM ? (T - fm) : WGM;
        u.pm = first + fm + ((w % nig) % gsz); u.pn = e * nct + (w % nig) / gsz; return true;
    }
    __device__ __forceinline__ void a_ready(const Unit&) const {}
    __device__ __forceinline__ void done(const Unit&) const {}
};
template <class Epi, class Sched, bool ALIGN_EPI = false, bool SP2 = false>
__device__ __forceinline__ void gemm_phase(PG8_LAS unsigned char* lds, const Gemm g, const Sched& S, const Epi& E) {
    int tid_ = threadIdx.x; asm volatile("" : "+v"(tid_)); const int tid = tid_, wid = __builtin_amdgcn_readfirstlane(tid >> 6), lane = tid & 63, wr = wid >> 2, wc = wid & 3, fr = lane & 15, fq = lane >> 4;
    const int K = g.K, nt = K / BK;
    unsigned voffA[2], voffB[2];
#pragma unroll
    for (int i = 0; i < 2; ++i) { int R, C; stage_rc(tid * 16 + i * 8192, R, C); const int Rb = Epi::PERM ? ((R & ~31) + perm32(R & 31)) : R;
        voffA[i] = (unsigned)(R * K + C) * 2u; voffB[i] = (unsigned)(Rb * K + C) * 2u; }
    const size_t kstep = (size_t)(BK * 2);
    const size_t hstep = (size_t)HALF * K * 2;
    const size_t tstep = 2 * hstep;
    const unsigned ldsw = (unsigned)wid * 1024u;
    const int aoff = lds_byte(wr * 64 + fr, fq * 8), boff = lds_byte(wc * 32 + fr, fq * 8);
#define PG8_SA(b, h) (((b) * 2 + (h)) * HTB)
#define PG8_SB(b, h) ((4 + (b) * 2 + (h)) * HTB)
#define PG8_STAGE(bufoff, gbase, voff) do { _Pragma("unroll") for (int _i = 0; _i < 2; ++_i) \
        __builtin_amdgcn_global_load_lds((const unsigned*)((const char*)(gbase) + (voff)[_i]), (PG8_LAS unsigned*)(lds + (bufoff) + ldsw + _i * 8192), 16, 0, 0); } while (0)
#define PG8_LDA(dst, b, h) do { _Pragma("unroll") for (int m = 0; m < 4; ++m) _Pragma("unroll") for (int k = 0; k < 2; ++k) dst[m][k] = *(const PG8_LAS bf16x8*)(lds + PG8_SA(b, h) + aoff + m * 2048 + k * 1024); } while (0)
#define PG8_LDB(dst, b, h) do { _Pragma("unroll") for (int n = 0; n < 2; ++n) _Pragma("unroll") for (int k = 0; k < 2; ++k) dst[n][k] = *(const PG8_LAS bf16x8*)(lds + PG8_SB(b, h) + boff + n * 2048 + k * 1024); } while (0)
#define PG8_MMA(ai, bj, At, Bt) do { __builtin_amdgcn_s_setprio(1); _Pragma("unroll") for (int m = 0; m < 4; ++m) _Pragma("unroll") for (int n = 0; n < 2; ++n) _Pragma("unroll") for (int k = 0; k < 2; ++k) \
        acc[ai][bj][m][n] = __builtin_amdgcn_mfma_f32_16x16x32_bf16(Bt[n][k], At[m][k], acc[ai][bj][m][n], 0, 0, 0); __builtin_amdgcn_s_setprio(0); } while (0)
#define PG8_WAIT_V(n) asm volatile("s_waitcnt vmcnt(" #n ")" ::: "memory")
#define PG8_WAIT_L(n) asm volatile("s_waitcnt lgkmcnt(" #n ")" ::: "memory")
#define PG8_BAR __builtin_amdgcn_s_barrier()
#define PG8_SCHED __builtin_amdgcn_sched_barrier(0)
    Unit cur, nxt; int ui = 0;
    if (!S.next(0, cur)) return;
    f32x4 acc[2][2][4][2];
#pragma unroll
    for (int a = 0; a < 2; ++a)
#pragma unroll
        for (int b = 0; b < 2; ++b)
#pragma unroll
            for (int m = 0; m < 4; ++m)
#pragma unroll
                for (int n = 0; n < 2; ++n) acc[a][b][m][n] = (f32x4){0.f, 0.f, 0.f, 0.f};
    bf16x8 At[4][2], B0[2][2], B1[2][2];
    const char* cA = (const char*)g.A + (size_t)cur.pm * tstep; const char* cB = (const char*)g.Bt + (size_t)cur.pn * tstep;
    S.a_ready(cur);
    if constexpr (SP2) {
        PG8_STAGE(PG8_SB(0, 0), cB, voffB); PG8_STAGE(PG8_SB(0, 1), cB + hstep, voffB); PG8_STAGE(PG8_SA(0, 0), cA, voffA); PG8_STAGE(PG8_SA(0, 1), cA + hstep, voffA);
        if (wr == 1) PG8_BAR;
        PG8_WAIT_V(2); PG8_BAR;
        PG8_STAGE(PG8_SB(1, 0), cB + kstep, voffB); PG8_STAGE(PG8_SA(1, 0), cA + kstep, voffA); PG8_STAGE(PG8_SB(1, 1), cB + hstep + kstep, voffB);
        PG8_WAIT_V(6); PG8_BAR;
    } else {
        PG8_STAGE(PG8_SB(0, 0), cB, voffB); PG8_STAGE(PG8_SA(0, 0), cA, voffA); PG8_STAGE(PG8_SB(0, 1), cB + hstep, voffB); PG8_STAGE(PG8_SA(0, 1), cA + hstep, voffA);
        if (wr == 1) PG8_BAR;
        PG8_WAIT_V(4); PG8_BAR;
        PG8_STAGE(PG8_SB(1, 0), cB + kstep, voffB); PG8_STAGE(PG8_SA(1, 0), cA + kstep, voffA); PG8_STAGE(PG8_SB(1, 1), cB + hstep + kstep, voffB);
        PG8_WAIT_V(6); PG8_BAR;
    }
    for (;;) {
        const bool has_next = S.next(ui + 1, nxt);
        const char* nA = has_next ? (const char*)g.A + (size_t)nxt.pm * tstep : cA; const char* nB = has_next ? (const char*)g.Bt + (size_t)nxt.pn * tstep : cB;
        for (int t = 0; t < nt; t += 2) {
            const bool last = (t == nt - 2);
            const char* a1 = cA + (size_t)(t + 1) * kstep;
            const char* a2 = last ? nA : cA + (size_t)(t + 2) * kstep; const char* b2 = last ? nB : cB + (size_t)(t + 2) * kstep;
            const char* a3 = a2 + kstep; const char* b3 = b2 + kstep;
            if (last && has_next) S.a_ready(nxt);
            if constexpr (SP2) {
            PG8_LDB(B0, 0, 0); PG8_LDB(B1, 0, 1); PG8_SCHED; PG8_LDA(At, 0, 0); PG8_STAGE(PG8_SA(1, 1), a1 + hstep, voffA);
            PG8_WAIT_V(8); PG8_WAIT_L(0); PG8_BAR; PG8_MMA(0, 0, At, B0); PG8_MMA(0, 1, At, B1); PG8_BAR; PG8_SCHED;
            PG8_LDA(At, 0, 1); PG8_STAGE(PG8_SB(0, 0), b2, voffB); PG8_STAGE(PG8_SB(0, 1), b2 + hstep, voffB); PG8_STAGE(PG8_SA(0, 0), a2, voffA);
            PG8_WAIT_V(8); PG8_WAIT_L(0); PG8_BAR; PG8_MMA(1, 0, At, B0); PG8_MMA(1, 1, At, B1); PG8_BAR; PG8_SCHED;
            PG8_LDB(B0, 1, 0); PG8_LDB(B1, 1, 1); PG8_SCHED; PG8_LDA(At, 1, 0); PG8_STAGE(PG8_SA(0, 1), a2 + hstep, voffA);
            PG8_WAIT_V(8); PG8_WAIT_L(0); PG8_BAR; PG8_MMA(0, 0, At, B0); PG8_MMA(0, 1, At, B1); PG8_BAR; PG8_SCHED;
            PG8_LDA(At, 1, 1); PG8_STAGE(PG8_SB(1, 0), b3, voffB); PG8_STAGE(PG8_SB(1, 1), b3 + hstep, voffB); PG8_STAGE(PG8_SA(1, 0), a3, voffA);
            PG8_WAIT_V(8); PG8_WAIT_L(0); PG8_BAR; PG8_MMA(1, 0, At, B0); PG8_MMA(1, 1, At, B1); PG8_BAR; PG8_SCHED;
            } else {
            PG8_LDB(B0, 0, 0); PG8_SCHED; PG8_LDA(At, 0, 0); PG8_STAGE(PG8_SA(1, 1), a1 + hstep, voffA);
            PG8_WAIT_L(8); PG8_BAR; PG8_WAIT_L(0); PG8_MMA(0, 0, At, B0); PG8_BAR; PG8_SCHED;
            PG8_LDB(B1, 0, 1); PG8_STAGE(PG8_SB(0, 0), b2, voffB);
            PG8_BAR; PG8_WAIT_L(0); PG8_MMA(0, 1, At, B1); PG8_BAR;
            PG8_LDA(At, 0, 1); PG8_STAGE(PG8_SA(0, 0), a2, voffA);
            PG8_BAR; PG8_WAIT_L(0); PG8_MMA(1, 0, At, B0); PG8_BAR; PG8_SCHED;
            PG8_STAGE(PG8_SB(0, 1), b2 + hstep, voffB);
            PG8_WAIT_V(6); PG8_BAR; PG8_MMA(1, 1, At, B1); PG8_BAR;
            PG8_LDB(B0, 1, 0); PG8_SCHED; PG8_LDA(At, 1, 0); PG8_STAGE(PG8_SA(0, 1), a2 + hstep, voffA);
            PG8_WAIT_L(8); PG8_BAR; PG8_WAIT_L(0); PG8_MMA(0, 0, At, B0); PG8_BAR; PG8_SCHED;
            PG8_LDB(B1, 1, 1); PG8_STAGE(PG8_SB(1, 0), b3, voffB);
            PG8_BAR; PG8_WAIT_L(0); PG8_MMA(0, 1, At, B1); PG8_BAR;
            PG8_LDA(At, 1, 1); PG8_STAGE(PG8_SA(1, 0), a3, voffA);
            PG8_BAR; PG8_WAIT_L(0); PG8_MMA(1, 0, At, B0); PG8_BAR; PG8_SCHED;
            PG8_STAGE(PG8_SB(1, 1), b3 + hstep, voffB);
            PG8_WAIT_V(6); PG8_BAR; PG8_MMA(1, 1, At, B1); PG8_BAR;
            }
        }
        if constexpr (ALIGN_EPI) { if (wr == 0) PG8_BAR; }
        if constexpr (!Epi::AFTER_DRAIN) { E(acc, cur, wr, wc, fr, fq); S.done(cur); }
        if (!has_next) break;
#pragma unroll
        for (int a = 0; a < 2; ++a)
#pragma unroll
            for (int b = 0; b < 2; ++b)
#pragma unroll
                for (int m = 0; m < 4; ++m)
#pragma unroll
                    for (int n = 0; n < 2; ++n) acc[a][b][m][n] = (f32x4){0.f, 0.f, 0.f, 0.f};
        cur = nxt; cA = nA; cB = nB; ++ui;
        if constexpr (ALIGN_EPI) { if (wr == 1) PG8_BAR; }
    }
    PG8_WAIT_V(0);
    if constexpr (!ALIGN_EPI) { if (wr == 0) PG8_BAR; }
    PG8_BAR;
    if constexpr (Epi::AFTER_DRAIN) { E.fused(acc, cur, wr, wc, fr, fq, lds, wid, lane); S.done(cur); }
#undef PG8_SA
#undef PG8_SB
#undef PG8_STAGE
#undef PG8_LDA
#undef PG8_LDB
#undef PG8_MMA
#undef PG8_WAIT_V
#undef PG8_WAIT_L
#undef PG8_BAR
#undef PG8_SCHED
}
}
#define GAS __attribute__((address_space(1)))
#define LAS __attribute__((address_space(3)))
typedef unsigned short bf16;
typedef unsigned v4u __attribute__((ext_vector_type(4)));
typedef unsigned v2u __attribute__((ext_vector_type(2)));
typedef float f32x4 __attribute__((ext_vector_type(4)));
typedef float f32x2 __attribute__((ext_vector_type(2)));
typedef float f32x16 __attribute__((ext_vector_type(16)));
typedef short bf16x8 __attribute__((ext_vector_type(8)));
typedef short s16x4 __attribute__((ext_vector_type(4)));
typedef GAS unsigned gu32;
typedef GAS unsigned long long gu64;
#define RLX_AGENT __ATOMIC_RELAXED, __HIP_MEMORY_SCOPE_AGENT
#define LDS_WAIT() asm volatile("s_waitcnt lgkmcnt(0)" ::: "memory")
#define VM_WAIT() asm volatile("s_waitcnt vmcnt(0)" ::: "memory")
#define WG_BAR() asm volatile("s_waitcnt vmcnt(0) lgkmcnt(0)\n\ts_barrier" ::: "memory")
#define LDS_BAR() asm volatile("s_waitcnt lgkmcnt(0)\n\ts_barrier" ::: "memory")
__device__ __forceinline__ unsigned f2bf(float f) { unsigned u = __builtin_bit_cast(unsigned, f); return (u + 0x7fffu + ((u >> 16) & 1u)) >> 16; }
__device__ __forceinline__ unsigned pk2(float lo, float hi) { return f2bf(lo) | (f2bf(hi) << 16); }
__device__ __forceinline__ float bf2f(unsigned short b) { return __builtin_bit_cast(float, (unsigned)b << 16); }
__device__ __forceinline__ float bflo(unsigned w) { return __builtin_bit_cast(float, w << 16); }
__device__ __forceinline__ float bfhi(unsigned w) { return __builtin_bit_cast(float, w & 0xffff0000u); }
__device__ __forceinline__ float wave_sum(float v) {
#pragma unroll
    for (int o = 1; o < 64; o <<= 1) v += __shfl_xor(v, o);
    return v;
}
constexpr float LOG2E = 1.4426950408889634f;
__device__ __forceinline__ float fast_exp(float x) { return __builtin_amdgcn_exp2f(x * LOG2E); }
__device__ __forceinline__ float log_sigmoid(float z) { return fminf(z, 0.f) - log1pf(expf(-fabsf(z))); }
#define XB_TMO      128
#define XB_XCNT(j)  (256  + 64 * (j))
#define XB_XSUB(j)  (1280 + 64 * (j))
#define XB_XGEN(j)  (2304 + 64 * (j))
#define XB_TOP      3328
#define XB_TOPGEN   3392
#define XCD_BAR_WORDS 3456
#define XB_SPIN_CAP (1u << 18)

__device__ __forceinline__ unsigned xb_ld(unsigned* p)              { return __hip_atomic_load(p, __ATOMIC_RELAXED, __HIP_MEMORY_SCOPE_AGENT); }
__device__ __forceinline__ unsigned xb_add(unsigned* p, unsigned v) { return __hip_atomic_fetch_add(p, v, __ATOMIC_RELAXED, __HIP_MEMORY_SCOPE_AGENT); }
__device__ __forceinline__ unsigned xb_xcc_id() { return (unsigned)__builtin_amdgcn_s_getreg((3 << 11) | 20) & 0xFu; }
#define XB_SPIN(cond, bar) do { unsigned _sp = 0; while (cond) { __builtin_amdgcn_s_sleep(1); \
    if ((++_sp & 255u) == 0u) { if (xb_ld(&(bar)[XB_TMO])) break; if (_sp > XB_SPIN_CAP) { atomicAdd(&(bar)[XB_TMO], 1u); break; } } } } while (0)

struct XcdBarrier {
    unsigned* bar; unsigned x;
    volatile LAS unsigned* st;
};

__device__ __forceinline__ XcdBarrier xcd_barrier_post(unsigned* bar, volatile LAS unsigned* st) {
    XcdBarrier b; b.bar = bar; b.x = xb_xcc_id(); b.st = st;
    if (threadIdx.x == 0) (void)xb_add(&bar[XB_XCNT(b.x)], 1u);
    return b;
}
__device__ __forceinline__ void xcd_barrier_complete(unsigned* bar, unsigned x, unsigned& nloc, unsigned& nx) {
    const unsigned G = gridDim.x * gridDim.y * gridDim.z;
    unsigned sum, cnt, mine, sp = 0u;
    for (;;) {
        sum = 0u; cnt = 0u; mine = 0u;
#pragma unroll
        for (unsigned j = 0; j < 16; ++j) { const unsigned c = xb_ld(&bar[XB_XCNT(j)]); sum += c; cnt += (c > 0u) ? 1u : 0u; mine = (j == x) ? c : mine; }
        if (sum == G) break;
        __builtin_amdgcn_s_sleep(1);
        if ((++sp & 255u) == 0u) { if (xb_ld(&bar[XB_TMO])) break; if (sp > XB_SPIN_CAP) { atomicAdd(&bar[XB_TMO], 1u); break; } }
    }
    nloc = mine > 0u ? mine : 1u; nx = cnt > 0u ? cnt : 1u;
}

__device__ __forceinline__ void xcd_barrier(const XcdBarrier& b) {
    asm volatile("s_waitcnt vmcnt(0)" ::: "memory");
    __syncthreads();
    if (threadIdx.x == 0) {
        unsigned* bar = b.bar;
        __builtin_amdgcn_s_waitcnt(0);
        unsigned nloc = b.st[0], nx = b.st[1];
        if (nloc == 0u) { xcd_barrier_complete(bar, b.x, nloc, nx); b.st[0] = nloc; b.st[1] = nx; }
        const unsigned old = xb_add(&bar[XB_XSUB(b.x)], 1u);
        const unsigned gen = old / nloc;
        if (old + 1u == (gen + 1u) * nloc) {
            __builtin_amdgcn_fence(__ATOMIC_RELEASE, "agent");
            asm volatile("s_waitcnt vmcnt(0)" ::: "memory");
            const unsigned og = xb_add(&bar[XB_TOP], 1u);
            const unsigned tg = og / nx;
            if (og + 1u == (tg + 1u) * nx) xb_add(&bar[XB_TOPGEN], 1u);
            else XB_SPIN(xb_ld(&bar[XB_TOPGEN]) == tg, bar);
            __builtin_amdgcn_fence(__ATOMIC_ACQUIRE, "agent");
            xb_add(&bar[XB_XGEN(b.x)], 1u);
            asm volatile("s_waitcnt vmcnt(0)" ::: "memory");
        } else {
            XB_SPIN(xb_ld(&bar[XB_XGEN(b.x)]) == gen, bar);
            __builtin_amdgcn_fence(__ATOMIC_ACQUIRE, "agent");
            asm volatile("s_waitcnt vmcnt(0)" ::: "memory");
        }
    }
    __syncthreads();
}
constexpr int NWAVES = 8, NTHR = 512;
constexpr int BATCH = 2, SEQ = 8192, DM = 1024, M = BATCH * SEQ, DEPTH = 4;
constexpr int W_AB = 3672, W_CD = 3080, FFD = 2816, FFE = 3584, NEXP = 8;
constexpr int NAB = 3840, NCD = 3072;
constexpr float ALPHA = 1.6817928305074290f, LN_EPS = 1e-5f;
constexpr int MOE_ROWS = 34816;
constexpr size_t MiB = 1u << 20;
constexpr size_t WS_CTL = 0, CTL_ZERO_BYTES = 1 * MiB;
constexpr size_t WS_X = 1 * MiB, WS_XB = 65 * MiB, WS_MIX = 97 * MiB, WS_Y = 129 * MiB, WS_ACT = 161 * MiB;
constexpr size_t WS_EVW = 289 * MiB, EV_WAB = 0, EV_WO = 8 * MiB, EV_W13 = 10 * MiB, EV_W2 = 21 * MiB;
constexpr size_t WS_MASK = 317 * MiB;
constexpr size_t WS_MISC = 349 * MiB, MI_FL = 0, MI_RTE = 1 * MiB, MI_RTR1 = MI_RTE + 65536, MI_RTR2 = MI_RTR1 + 65536, MI_RTG = MI_RTR2 + 65536, MI_ROW1 = MI_RTG + 131072, MI_ROW2 = MI_ROW1 + 65536;
constexpr size_t WS_BIG = 351 * MiB;
constexpr size_t BG_WCD = 0, BG_WOD = 6 * MiB, BG_W13M = 8 * MiB, BG_W2M = 120 * MiB, BG_H = 176 * MiB, BG_XG = 414 * MiB, BG_END = 482 * MiB;
constexpr size_t BG_SC = 176 * MiB;
constexpr size_t BG_DS = 0, BG_OI = 32 * MiB, BG_QS = 64 * MiB, BG_SP = 72 * MiB, BG_DEC = 88 * MiB;
constexpr size_t WS_END = WS_BIG + BG_END;
constexpr size_t SCB = (size_t)4096 * 128 * 129 / 2;
static_assert(BG_SC + 2 * SCB * 4 <= BG_END, "scores fit");
constexpr int CW_TMO = 0, CW_BAR = 4096, CW_Q = 8192, CW_CNT = 12288;
constexpr int RING_BYTES = 131072;
constexpr int LDSCTL_OFF = RING_BYTES, MISC_OFF = LDSCTL_OFF + 320;
constexpr int LDS_BYTES = 147456;
struct Frame {
    LAS unsigned char* lds;
    volatile LAS unsigned* MISC;
    gu32* ctl;
    unsigned char* ws;
    int tid, lane, wave;
    int vcu, G;
};
__device__ __forceinline__ int sel8i(int e, int a0, int a1, int a2, int a3, int a4, int a5, int a6, int a7) {
    int r = a0; r = e == 1 ? a1 : r; r = e == 2 ? a2 : r; r = e == 3 ? a3 : r; r = e == 4 ? a4 : r; r = e == 5 ? a5 : r; r = e == 6 ? a6 : r; r = e == 7 ? a7 : r; return r; }
__device__ __forceinline__ float sel8f(int e, const float (&a)[8]) {
    float r = a[0]; r = e == 1 ? a[1] : r; r = e == 2 ? a[2] : r; r = e == 3 ? a[3] : r; r = e == 4 ? a[4] : r; r = e == 5 ? a[5] : r; r = e == 6 ? a[6] : r; r = e == 7 ? a[7] : r; return r; }
__device__ __forceinline__ int q_next(Frame& F, gu32* head) {
    volatile LAS int* slot = (volatile LAS int*)(F.lds + LDSCTL_OFF + 64);
    WG_BAR();
    if (F.tid == 0) { const unsigned v = __hip_atomic_fetch_add(head, 1u, RLX_AGENT); *slot = (int)v; }
    WG_BAR();
    return *slot;
}
__device__ __forceinline__ void conv_item(const float* __restrict__ W, int ldw, int k0, int srccol, bf16* WT, int ldt, int drow0, LAS float* scr, int lane) {
#pragma unroll 8
    for (int i = 0; i < 32; ++i) { const int kk = 2 * i + (lane >> 5); scr[kk * 33 + (lane & 31)] = srccol >= 0 ? W[(size_t)(k0 + kk) * ldw + srccol] : 0.f; }
    LDS_WAIT();
    const int c = lane & 7;
#pragma unroll
    for (int j = 0; j < 4; ++j) { const int n = (lane >> 3) + 8 * j; const LAS float* s = scr + (8 * c) * 33 + n;
        v4u o; o.x = pk2(s[0 * 33], s[1 * 33]); o.y = pk2(s[2 * 33], s[3 * 33]); o.z = pk2(s[4 * 33], s[5 * 33]); o.w = pk2(s[6 * 33], s[7 * 33]);
        *(GAS v4u*)(WT + (size_t)(drow0 + n) * ldt + k0 + 8 * c) = o; }
    LDS_WAIT();
}
__device__ __forceinline__ void conv_matrix(Frame& F, int kind, const float* W, const float* W3, int ldw, int K, bf16* WT, int nrows) {
    LAS float* scr = (LAS float*)(F.lds + F.wave * 8704);
    const int gw = F.vcu * NWAVES + F.wave, NGW = F.G * NWAVES;
    const int ngrp = nrows / 32, nkb = K / 64, nitems = ngrp * nkb;
    for (int it = gw; it < nitems; it += NGW) {
        const int grp = it % ngrp, kb = it / ngrp; const int r = grp * 32 + (F.lane & 31);
        int sc = r; const float* src = W;
        if (kind == 1) { sc = r < 1536 ? r : (r < 3584 ? r + 16 : (r < 3600 ? 1536 + (r - 3584) : (r < 3672 ? r : -1))); }
        else if (kind == 2) { sc = r < 1536 ? r : r + 8; }
        else if (kind == 3) { const int j = r >> 8, w = r & 255; sc = 128 * j + (w & 127); src = (w < 128) ? W : W3; }
        conv_item(src, ldw, kb * 64, sc, WT, K, grp * 32, scr, F.lane);
    }
}
__device__ __forceinline__ void rows_to_bf16(Frame& F, const float* x, bf16* xb) {
    const int gw = F.vcu * NWAVES + F.wave, NGW = F.G * NWAVES;
    for (int m = gw; m < M; m += NGW) {
        const GAS f32x4* xr = (const GAS f32x4*)(x + (size_t)m * DM) + F.lane; GAS v2u* o = (GAS v2u*)(xb + (size_t)m * DM) + F.lane;
#pragma unroll
        for (int j = 0; j < 4; ++j) { const f32x4 v = xr[64 * j]; v2u w; w.x = pk2(v.x, v.y); w.y = pk2(v.z, v.w); o[64 * j] = w; }
    }
}
__device__ __forceinline__ void ln_phase(Frame& F, const float* xres, const bf16* Y, int ymode, const float* g, const float* bvec, float* xout, bf16* xbout,
                                         int proj, const float* pw, const float* pb, gu32* cnt) {
    LAS float* W8 = (LAS float*)(F.lds);
    volatile LAS int* tokE = (volatile LAS int*)(F.lds + 32768);
    const int* row1 = (const int*)(F.ws + WS_MISC + MI_ROW1); const int* row2 = (const int*)(F.ws + WS_MISC + MI_ROW2);
    float* rtg = (float*)(F.ws + WS_MISC + MI_RTG); int* rte = (int*)(F.ws + WS_MISC + MI_RTE); int* rtr1 = (int*)(F.ws + WS_MISC + MI_RTR1); int* rtr2 = (int*)(F.ws + WS_MISC + MI_RTR2);
    float* fl = (float*)(F.ws + WS_MISC + MI_FL);
    if (proj == 1) { for (int i = F.tid; i < 8192; i += NTHR) W8[i] = pw[i]; }
    else if (proj == 2) { for (int i = F.tid; i < 8192; i += NTHR) W8[i] = pw[(size_t)(i >> 3) * W_CD + 1536 + (i & 7)]; }
    WG_BAR();
    const int lane = F.lane;
    for (int slab = blockIdx.x; slab < M / 64; slab += F.G) {
        for (int rr = 0; rr < 8; ++rr) {
            const int m = slab * 64 + F.wave * 8 + rr;
            const GAS f32x4* xr = (const GAS f32x4*)(xres + (size_t)m * DM) + lane;
            f32x4 v[4];
            if (ymode == 0) {
                const GAS v2u* yr = (const GAS v2u*)(Y + (size_t)m * DM) + lane;
#pragma unroll
                for (int j = 0; j < 4; ++j) { const f32x4 xv = xr[64 * j]; const v2u yw = yr[64 * j];
                    v[j].x = ALPHA * xv.x + bflo(yw.x); v[j].y = ALPHA * xv.y + bfhi(yw.x); v[j].z = ALPHA * xv.z + bflo(yw.y); v[j].w = ALPHA * xv.w + bfhi(yw.y); }
            } else {
                const int r1 = row1[m], r2 = row2[m]; const float g1 = rtg[2 * m], g2 = rtg[2 * m + 1];
                const GAS v2u* y1 = (const GAS v2u*)(Y + (size_t)r1 * DM) + lane; const GAS v2u* y2 = (const GAS v2u*)(Y + (size_t)r2 * DM) + lane;
#pragma unroll
                for (int j = 0; j < 4; ++j) { const f32x4 xv = xr[64 * j]; const v2u a = y1[64 * j], c = y2[64 * j];
                    v[j].x = ALPHA * xv.x + (g1 * bflo(a.x) + g2 * bflo(c.x)); v[j].y = ALPHA * xv.y + (g1 * bfhi(a.x) + g2 * bfhi(c.x));
                    v[j].z = ALPHA * xv.z + (g1 * bflo(a.y) + g2 * bflo(c.y)); v[j].w = ALPHA * xv.w + (g1 * bfhi(a.y) + g2 * bfhi(c.y)); }
            }
            float s = 0.f;
#pragma unroll
            for (int j = 0; j < 4; ++j) s += (v[j].x + v[j].y) + (v[j].z + v[j].w);
            const float mean = wave_sum(s) * (1.f / DM); float s2 = 0.f;
#pragma unroll
            for (int j = 0; j < 4; ++j) { v[j] = v[j] - mean; s2 += (v[j].x * v[j].x + v[j].y * v[j].y) + (v[j].z * v[j].z + v[j].w * v[j].w); }
            const float rstd = 1.f / sqrtf(wave_sum(s2) * (1.f / DM) + LN_EPS);
            GAS f32x4* xo = (GAS f32x4*)(xout + (size_t)m * DM) + lane; GAS v2u* bo = (GAS v2u*)(xbout + (size_t)m * DM) + lane;
#pragma unroll
            for (int j = 0; j < 4; ++j) { const f32x4 gg = ((const GAS f32x4*)g)[lane + 64 * j], bb = ((const GAS f32x4*)bvec)[lane + 64 * j];
                v[j] = v[j] * rstd * gg + bb; xo[64 * j] = v[j]; v2u w; w.x = pk2(v[j].x, v[j].y); w.y = pk2(v[j].z, v[j].w); bo[64 * j] = w; }
            if (proj != 0) {
                float a8[8];
#pragma unroll
                for (int e = 0; e < 8; ++e) a8[e] = 0.f;
#pragma unroll
                for (int j = 0; j < 4; ++j)
#pragma unroll
                    for (int c = 0; c < 4; ++c) { const int i = 4 * lane + 256 * j + c; const f32x4 w0 = *(const LAS f32x4*)(W8 + i * 8), w1 = *(const LAS f32x4*)(W8 + i * 8 + 4); const float xv = v[j][c];
                        a8[0] += xv * w0.x; a8[1] += xv * w0.y; a8[2] += xv * w0.z; a8[3] += xv * w0.w; a8[4] += xv * w1.x; a8[5] += xv * w1.y; a8[6] += xv * w1.z; a8[7] += xv * w1.w; }
#pragma unroll
                for (int e = 0; e < 8; ++e) a8[e] = wave_sum(a8[e]);
                if (proj == 2) {
                    const int e8 = lane & 7; float z = a8[0]; z = e8 == 1 ? a8[1] : z; z = e8 == 2 ? a8[2] : z; z = e8 == 3 ? a8[3] : z; z = e8 == 4 ? a8[4] : z; z = e8 == 5 ? a8[5] : z; z = e8 == 6 ? a8[6] : z; z = e8 == 7 ? a8[7] : z; z += pb[e8];
                    if (lane < 8) fl[(size_t)m * 8 + lane] = log_sigmoid(z);
                } else {
                    int e1 = 0; float v1 = a8[0];
#pragma unroll
                    for (int e = 1; e < 8; ++e) if (a8[e] > v1) { v1 = a8[e]; e1 = e; }
                    int e2 = -1; float v2 = -INFINITY;
#pragma unroll
                    for (int e = 0; e < 8; ++e) if (e != e1 && (e2 < 0 || a8[e] > v2)) { v2 = a8[e]; e2 = e; }
                    const float ex = __expf(v2 - v1); const float g1 = 1.f / (1.f + ex), g2 = ex / (1.f + ex);
                    if (lane == 0) { rtg[2 * m] = g1; rtg[2 * m + 1] = g2; tokE[F.wave * 8 + rr] = e1 | (e2 << 8); }
                }
            }
        }
        if (proj == 1) {
            LDS_BAR();
            if (F.wave == 0) {
                const int ee = tokE[lane]; const int e1 = ee & 255, e2 = ee >> 8; int r1 = 0, r2 = 0;
                const unsigned long long lt = (1ull << lane) - 1ull;
#pragma unroll
                for (int e = 0; e < 8; ++e) {
                    const unsigned long long b1 = __ballot(e1 == e), b2 = __ballot(e2 == e);
                    const int c = __popcll(b1) + __popcll(b2);
                    unsigned base = 0; if (lane == 0 && c > 0) base = __hip_atomic_fetch_add(cnt + 64 * e, (unsigned)c, RLX_AGENT);
                    base = (unsigned)__builtin_amdgcn_readfirstlane((int)base);
                    const int pos = (int)base + __popcll(b1 & lt) + __popcll(b2 & lt);
                    if (e1 == e) r1 = pos; if (e2 == e) r2 = pos;
                }
                const int m = slab * 64 + lane; rte[m] = ee; rtr1[m] = r1; rtr2[m] = r2;
            }
            LDS_BAR();
        }
    }
}
__device__ __forceinline__ void moe_tiles(const gu32* cnt, int (&ts)[9]) {
    ts[0] = 0;
#pragma unroll
    for (int e = 0; e < 8; ++e) { const int c = (int)__hip_atomic_load(cnt + 64 * e, RLX_AGENT); ts[e + 1] = ts[e] + ((c + 255) >> 8); }
}
__device__ __forceinline__ void scatter_phase(Frame& F, const bf16* xb, bf16* xg, const gu32* cnt) {
    int ts[9]; moe_tiles(cnt, ts);
    const int* rte = (const int*)(F.ws + WS_MISC + MI_RTE); const int* rtr1 = (const int*)(F.ws + WS_MISC + MI_RTR1); const int* rtr2 = (const int*)(F.ws + WS_MISC + MI_RTR2);
    int* row1 = (int*)(F.ws + WS_MISC + MI_ROW1); int* row2 = (int*)(F.ws + WS_MISC + MI_ROW2);
    const int gw = F.vcu * NWAVES + F.wave, NGW = F.G * NWAVES;
    for (int m = gw; m < M; m += NGW) {
        const int ee = rte[m]; const int e1 = ee & 255, e2 = ee >> 8;
        const int ra = 256 * sel8i(e1, ts[0], ts[1], ts[2], ts[3], ts[4], ts[5], ts[6], ts[7]) + rtr1[m];
        const int rb = 256 * sel8i(e2, ts[0], ts[1], ts[2], ts[3], ts[4], ts[5], ts[6], ts[7]) + rtr2[m];
        const GAS v4u* src = (const GAS v4u*)(xb + (size_t)m * DM) + F.lane;
        const v4u a = src[0], b = src[64];
        GAS v4u* d1 = (GAS v4u*)(xg + (size_t)ra * DM) + F.lane; GAS v4u* d2 = (GAS v4u*)(xg + (size_t)rb * DM) + F.lane;
        d1[0] = a; d1[64] = b; d2[0] = a; d2[64] = b;
        if (F.lane == 0) { row1[m] = ra; row2[m] = rb; }
    }
}
namespace att {
constexpr int SLOTB = 8192, NSLOT = 3;
constexpr int L_K = 0, L_V = NSLOT * SLOTB, L_WS = 2 * NSLOT * SLOTB, L_OST = L_WS + 8 * 256, L_END = L_OST + 8 * 4096;
constexpr int L_TAB = L_END;
constexpr int PITCH = 512;
__device__ __forceinline__ int crow(int r, int hi) { return (r & 3) + 8 * (r >> 2) + 4 * hi; }
__device__ __forceinline__ void glds16(const void* gsrc, unsigned lds_dst) { unsigned keep;
    asm volatile("s_mov_b32 %0, m0\n\ts_mov_b32 m0, %2\n\ts_nop 0\n\tglobal_load_lds_dwordx4 %1, off\n\ts_mov_b32 m0, %0" : "=&s"(keep) : "v"(gsrc), "s"(lds_dst) : "memory"); }
__device__ __forceinline__ float max3f(float a, float b, float c) { return __builtin_fmaxf(__builtin_fmaxf(a, b), c); }
typedef __bf16 bf16x2_t __attribute__((ext_vector_type(2)));
__device__ __forceinline__ unsigned cvtpk_s(float lo, float hi) { f32x2 v = {lo, hi}; bf16x2_t b = __builtin_convertvector(v, bf16x2_t); return __builtin_bit_cast(unsigned, b); }
#define ATT_WAIT_BAR(N) asm volatile("s_waitcnt vmcnt(" #N ") lgkmcnt(0)\n\ts_barrier" ::: "memory")
__device__ __forceinline__ void qkt(f32x16& p0, f32x16& p1, const LAS unsigned char* Kslot, const bf16x8* qr, int r32, int hi) {
    const LAS unsigned char* kb = Kslot + hi * 1024 + r32 * 16;
    const f32x16 z = {};
#pragma unroll
    for (int d0 = 0; d0 < 4; ++d0) {
        const bf16x8 b0 = *(const LAS bf16x8*)(kb + d0 * 2048);
        const bf16x8 b1 = *(const LAS bf16x8*)(kb + d0 * 2048 + 512);
        if (d0 == 0) { p0 = __builtin_amdgcn_mfma_f32_32x32x16_bf16(b0, qr[0], z, 0, 0, 0); p1 = __builtin_amdgcn_mfma_f32_32x32x16_bf16(b1, qr[0], z, 0, 0, 0); }
        else { p0 = __builtin_amdgcn_mfma_f32_32x32x16_bf16(b0, qr[d0], p0, 0, 0, 0); p1 = __builtin_amdgcn_mfma_f32_32x32x16_bf16(b1, qr[d0], p1, 0, 0, 0); }
    }
}
__device__ __forceinline__ float rowmax(const f32x16& p0, const f32x16& p1) {
    float a = max3f(p0[0], p0[1], p1[0]), b = max3f(p0[2], p0[3], p1[1]); a = max3f(a, p1[2], p1[3]);
#pragma unroll
    for (int r = 4; r < 16; r += 4) { a = max3f(a, p0[r], p0[r + 1]); b = max3f(b, p0[r + 2], p0[r + 3]); a = max3f(a, p1[r], p1[r + 1]); b = max3f(b, p1[r + 2], p1[r + 3]); }
    const float m = __builtin_fmaxf(a, b);
    auto rr = __builtin_amdgcn_permlane32_swap(__float_as_uint(m), __float_as_uint(m), false, false);
    return __builtin_fmaxf(__uint_as_float(rr[0]), __uint_as_float(rr[1]));
}
__device__ __forceinline__ void pv(f32x16* o, int vb, bf16x8 pa0, bf16x8 pa1, bf16x8 pa2, bf16x8 pa3) {
#pragma unroll
    for (int d0 = 0; d0 < 2; ++d0) { s16x4 lo[4], hi[4];
#pragma unroll
        for (int ks = 0; ks < 4; ++ks) {
            asm volatile("ds_read_b64_tr_b16 %0,%1 offset:%c2" : "=&v"(lo[ks]) : "v"(vb), "i"(d0 * 4096 + ks * 1024) : "memory");
            asm volatile("ds_read_b64_tr_b16 %0,%1 offset:%c2" : "=&v"(hi[ks]) : "v"(vb), "i"(d0 * 4096 + ks * 1024 + 512) : "memory"); }
        asm volatile("s_waitcnt lgkmcnt(0)" ::: "memory"); __builtin_amdgcn_sched_barrier(0);
#define ATT_PK(k) (bf16x8){lo[k][0], lo[k][1], lo[k][2], lo[k][3], hi[k][0], hi[k][1], hi[k][2], hi[k][3]}
        o[d0] = __builtin_amdgcn_mfma_f32_32x32x16_bf16(pa0, ATT_PK(0), o[d0], 0, 0, 0);
        o[d0] = __builtin_amdgcn_mfma_f32_32x32x16_bf16(pa1, ATT_PK(1), o[d0], 0, 0, 0);
        o[d0] = __builtin_amdgcn_mfma_f32_32x32x16_bf16(pa2, ATT_PK(2), o[d0], 0, 0, 0);
        o[d0] = __builtin_amdgcn_mfma_f32_32x32x16_bf16(pa3, ATT_PK(3), o[d0], 0, 0, 0);
#undef ATT_PK
    }
}
template <class Hook>
__device__ __forceinline__ void attn_unit(Hook& hk, const bf16* Qh, const bf16* Kh, const bf16* Vh, bf16* Oh, long qrow0, int NT, LAS unsigned char* shm, int opitch) {
    int tid_ = threadIdx.x; asm volatile("" : "+v"(tid_)); const int tid = tid_, lane = tid & 63, r32 = lane & 31, hi = lane >> 5; const int wid = __builtin_amdgcn_readfirstlane(tid >> 6);
    const unsigned lds0 = (unsigned)(size_t)shm;
    LAS float* wsf = (LAS float*)(shm + L_WS) + wid * 64;
    const bf16* Qw = Qh + (qrow0 + wid * 32) * PITCH;
    const bf16* ksrc = Kh + (long)lane * PITCH + wid * 8;
    const bf16* vsrc = Vh + (long)(16 * (wid & 3) + (lane >> 2)) * PITCH + (wid >> 2) * 32 + (lane & 3) * 8;
    const unsigned kdst = lds0 + L_K + wid * 1024, vdst = lds0 + L_V + wid * 1024;
#define ATT_DMA(t, slot) do { const long rr_ = hk.tile_row(t); glds16(ksrc + rr_ * PITCH, (unsigned)__builtin_amdgcn_readfirstlane(kdst + (slot))); \
                              glds16(vsrc + rr_ * PITCH, (unsigned)__builtin_amdgcn_readfirstlane(vdst + (slot))); } while (0)
    const int vb0 = (int)(lds0 + L_V) + ((lane >> 4) & 1) * 32 + (lane & 3) * 8 + (4 * hi + ((lane & 15) >> 2)) * 64;
    bf16x8 qr[4];
#pragma unroll
    for (int d0 = 0; d0 < 4; ++d0) qr[d0] = *(const bf16x8*)(Qw + (long)r32 * PITCH + d0 * 16 + hi * 8);
    ATT_DMA(0, 0); if (NT > 1) ATT_DMA(1, SLOTB);
    float mhat = -1e30f, l_reg = 0.f; f32x16 o[2]; o[0] = f32x16{}; o[1] = f32x16{};
    int sl = 0, sl2 = 2 * SLOTB;
    for (int t = 0; t < NT; ++t) {
        if (t + 1 < NT) { ATT_WAIT_BAR(2); } else { ATT_WAIT_BAR(0); }
        if (t + 2 < NT) ATT_DMA(t + 2, sl2);
        f32x16 p0, p1;
        qkt(p0, p1, shm + L_K + sl, qr, r32, hi);
        hk.apply(p0, p1, t, r32, hi, wid);
        const float rm = rowmax(p0, p1);
        bool resc = false;
        if (__any(rm > mhat + 8.0f)) { const float mn = __builtin_fmaxf(mhat, rm); const float f = __builtin_amdgcn_exp2f(mhat - mn); l_reg *= f; mhat = mn; if (hi == 0) wsf[r32] = f; resc = true; }
        float sacc = 0.f;
#pragma unroll
        for (int r = 0; r < 16; ++r) { p0[r] = __builtin_amdgcn_exp2f(p0[r] - mhat); p1[r] = __builtin_amdgcn_exp2f(p1[r] - mhat); sacc += p0[r] + p1[r]; }
        l_reg += sacc;
        v4u pw0, pw1, pw2, pw3;
        pw0 = (v4u){cvtpk_s(p0[0], p0[1]), cvtpk_s(p0[2], p0[3]), cvtpk_s(p0[4], p0[5]), cvtpk_s(p0[6], p0[7])};
        pw1 = (v4u){cvtpk_s(p0[8], p0[9]), cvtpk_s(p0[10], p0[11]), cvtpk_s(p0[12], p0[13]), cvtpk_s(p0[14], p0[15])};
        pw2 = (v4u){cvtpk_s(p1[0], p1[1]), cvtpk_s(p1[2], p1[3]), cvtpk_s(p1[4], p1[5]), cvtpk_s(p1[6], p1[7])};
        pw3 = (v4u){cvtpk_s(p1[8], p1[9]), cvtpk_s(p1[10], p1[11]), cvtpk_s(p1[12], p1[13]), cvtpk_s(p1[14], p1[15])};
        if (resc) {
            LDS_WAIT();
#pragma unroll
            for (int r = 0; r < 16; ++r) { const float f = wsf[crow(r, hi)]; o[0][r] *= f; o[1][r] *= f; }
        }
        pv(o, vb0 + sl, __builtin_bit_cast(bf16x8, pw0), __builtin_bit_cast(bf16x8, pw1), __builtin_bit_cast(bf16x8, pw2), __builtin_bit_cast(bf16x8, pw3));
        sl = (sl == (NSLOT - 1) * SLOTB) ? 0 : sl + SLOTB; sl2 = (sl2 == (NSLOT - 1) * SLOTB) ? 0 : sl2 + SLOTB;
    }
    { auto rr = __builtin_amdgcn_permlane32_swap(__float_as_uint(l_reg), __float_as_uint(l_reg), false, false); l_reg = __uint_as_float(rr[0]) + __uint_as_float(rr[1]); }
    if (hi == 0) wsf[32 + r32] = l_reg;
    LDS_WAIT();
    float rli[16];
#pragma unroll
    for (int r = 0; r < 16; ++r) rli[r] = __builtin_amdgcn_rcpf(wsf[32 + crow(r, hi)]);
    bf16* Ow = Oh + (qrow0 + wid * 32) * opitch;
    { LAS bf16* stg = (LAS bf16*)(shm + L_OST) + wid * 2048;
#pragma unroll
        for (int r = 0; r < 16; ++r) { const int orow = crow(r, hi);
#pragma unroll
            for (int d0 = 0; d0 < 2; ++d0) stg[orow * 64 + d0 * 32 + r32] = (bf16)f2bf(o[d0][r] * rli[r]); }
        LDS_WAIT();
#pragma unroll
        for (int i = 0; i < 4; ++i) { const int row = i * 8 + (lane >> 3), ch = lane & 7; const v4u v = *(const LAS v4u*)(stg + row * 64 + ch * 8); *(v4u*)(Ow + (long)row * opitch + ch * 8) = v; } }
    asm volatile("s_waitcnt lgkmcnt(0)\n\ts_barrier" ::: "memory");
#undef ATT_DMA
}
__device__ __forceinline__ int t5_bucket(int d) {
    if (d < 16) return d < 0 ? 0 : d;
    return 16 + (d >= 22) + (d >= 30) + (d >= 40) + (d >= 54) + (d >= 73) + (d >= 99) + (d >= 134) + (d >= 182) + (d >= 246) + (d >= 332) + (d >= 450) + (d >= 609) + (d >= 825) + (d >= 1117) + (d >= 1513);
}
struct FoxHook {
    long rowbase; int NT, q0; const LAS float* Ft;
    __device__ __forceinline__ long tile_row(int t) const { return rowbase + 64 * (NT - 1 - t); }
    __device__ __forceinline__ void apply(f32x16& p0, f32x16& p1, int t, int r32, int hi, int wid) const {
        const int kb = 64 * (NT - 1 - t); const int tq = q0 + wid * 32 + r32; const float Fq = Ft[tq];
#pragma unroll
        for (int g = 0; g < 4; ++g) { const f32x4 f0 = *(const LAS f32x4*)(Ft + kb + 8 * g + 4 * hi), f1 = *(const LAS f32x4*)(Ft + kb + 32 + 8 * g + 4 * hi);
#pragma unroll
            for (int i = 0; i < 4; ++i) { p0[4 * g + i] += Fq - f0[i]; p1[4 * g + i] += Fq - f1[i]; } }
        if (kb + 63 > q0 + wid * 32) {
#pragma unroll
            for (int r = 0; r < 16; ++r) { const int key = kb + crow(r, hi); if (key > tq) p0[r] = -INFINITY; if (key + 32 > tq) p1[r] = -INFINITY; }
        }
    }
};
typedef unsigned u32x16 __attribute__((ext_vector_type(16)));
struct DsaHook {
    long rowbase; int q0; const LAS float* tb; float c31; const unsigned long long* maskq;
    __device__ __forceinline__ long tile_row(int t) const { return rowbase + 64 * t; }
    __device__ __forceinline__ void apply(f32x16& p0, f32x16& p1, int t, int r32, int hi, int wid) const {
        const int kb = 64 * t; const int q0w = q0 + wid * 32; const int tq = q0w + r32;
        if (q0w - (kb + 63) >= 1513) {
#pragma unroll
            for (int r = 0; r < 16; ++r) { p0[r] += c31; p1[r] += c31; }
        } else {
            const LAS float* tl = tb + (tq + 256 - kb - 4 * hi);
#pragma unroll
            for (int r = 0; r < 16; ++r) { const int o = (r & 3) + 8 * (r >> 2); p0[r] += tl[-o]; p1[r] += tl[-o - 32]; }
        }
        const unsigned long long* mp = maskq + ((size_t)wid * 128 + t) * 32;
        const unsigned long long mpu = (unsigned long long)__builtin_amdgcn_readfirstlane((int)((unsigned long long)mp & 0xffffffffu)) & 0xffffffffull |
                                       ((unsigned long long)(unsigned)__builtin_amdgcn_readfirstlane((int)((unsigned long long)mp >> 32)) << 32);
        u32x16 a, b;
        asm volatile("s_load_dwordx16 %0, %2, 0x0\n\ts_load_dwordx16 %1, %2, 0x40\n\ts_waitcnt lgkmcnt(0)" : "=&s"(a), "=&s"(b) : "s"(mpu) : "memory");
        const float NEG = -INFINITY;
#pragma unroll
        for (int r = 0; r < 8; ++r) { const unsigned long long mk = ((unsigned long long)a[2 * r + 1] << 32) | a[2 * r]; asm volatile("v_cndmask_b32_e64 %0, %1, %2, %3" : "=v"(p0[r]) : "v"(NEG), "v"(p0[r]), "s"(mk)); }
#pragma unroll
        for (int r = 0; r < 8; ++r) { const unsigned long long mk = ((unsigned long long)b[2 * r + 1] << 32) | b[2 * r]; asm volatile("v_cndmask_b32_e64 %0, %1, %2, %3" : "=v"(p0[8 + r]) : "v"(NEG), "v"(p0[8 + r]), "s"(mk)); }
        asm volatile("s_load_dwordx16 %0, %2, 0x80\n\ts_load_dwordx16 %1, %2, 0xc0\n\ts_waitcnt lgkmcnt(0)" : "=&s"(a), "=&s"(b) : "s"(mpu) : "memory");
#pragma unroll
        for (int r = 0; r < 8; ++r) { const unsigned long long mk = ((unsigned long long)a[2 * r + 1] << 32) | a[2 * r]; asm volatile("v_cndmask_b32_e64 %0, %1, %2, %3" : "=v"(p1[r]) : "v"(NEG), "v"(p1[r]), "s"(mk)); }
#pragma unroll
        for (int r = 0; r < 8; ++r) { const unsigned long long mk = ((unsigned long long)b[2 * r + 1] << 32) | b[2 * r]; asm volatile("v_cndmask_b32_e64 %0, %1, %2, %3" : "=v"(p1[8 + r]) : "v"(NEG), "v"(p1[8 + r]), "s"(mk)); }
    }
};
struct DilHook {
    long rowbase; int q0, kt0; const LAS float* tb;
    __device__ __forceinline__ long tile_row(int t) const { return rowbase + 64 * (kt0 + t); }
    __device__ __forceinline__ void apply(f32x16& p0, f32x16& p1, int t, int r32, int hi, int wid) const {
        const int kb = 64 * (kt0 + t); const int tq = q0 + wid * 32 + r32;
        const LAS float* tl = tb + (tq + 256 - kb - 4 * hi);
#pragma unroll
        for (int r = 0; r < 16; ++r) { const int o = (r & 3) + 8 * (r >> 2); p0[r] += tl[-o]; p1[r] += tl[-o - 32]; }
    }
};
}
namespace gla {
constexpr int LS = 72;
constexpr int O_QT = 0, O_KT = 9216, O_KHT = 18432, O_VT = 27648, O_AT = 46080, O_GA = 55296, O_WG = 59392, O_TOT = 63488, O_END = 65536;
__device__ __forceinline__ bf16x8 frag(const LAS bf16* base, int row, int k0) { return *(const LAS bf16x8*)(base + row * LS + k0); }
#define GLA_MFMA(x, y, c) __builtin_amdgcn_mfma_f32_16x16x32_bf16(x, y, c, 0, 0, 0)
__device__ __forceinline__ void chunk_unit(Frame& F, int b, int h, int c, const float* w_gate, const float* b_gate) {
    unsigned char* act = F.ws + WS_ACT; unsigned char* big = F.ws + WS_BIG;
    const bf16* QA = (const bf16*)(act + pg8::A_QA); const bf16* KA = (const bf16*)(act + pg8::A_KA); const bf16* VA = (const bf16*)(act + pg8::A_VA);
    const float* SM = (const float*)(act + pg8::A_SMALL);
    float* DS = (float*)(big + BG_DS); float* OI = (float*)(big + BG_OI); bf16* QS = (bf16*)(big + BG_QS); float* DEC = (float*)(big + BG_DEC);
    LAS bf16* QT = (LAS bf16*)(F.lds + O_QT); LAS bf16* KT = (LAS bf16*)(F.lds + O_KT); LAS bf16* KHT = (LAS bf16*)(F.lds + O_KHT); LAS bf16* VT = (LAS bf16*)(F.lds + O_VT); LAS bf16* AT = (LAS bf16*)(F.lds + O_AT);
    LAS float* GA = (LAS float*)(F.lds + O_GA); LAS float* WG = (LAS float*)(F.lds + O_WG); LAS float* TOT = (LAS float*)(F.lds + O_TOT);
    const int tid = F.tid, lane = F.lane, wave = F.wave; const size_t m0 = (size_t)b * SEQ + 64 * c; const int bh = b * 4 + h;
    for (int i = tid; i < 1024; i += NTHR) { GA[i] = SM[(m0 + (i >> 4)) * 32 + (i & 15)]; WG[i] = w_gate[(i >> 6) * 256 + 64 * h + (i & 63)]; }
    for (int ch = tid; ch < 1024; ch += NTHR) { const int j = ch >> 4, v0 = (ch & 15) * 8; const v4u w = *(const GAS v4u*)(VA + (m0 + j) * 512 + 128 * h + v0);
        VT[(v0 + 0) * LS + j] = (bf16)(w.x & 0xffff); VT[(v0 + 1) * LS + j] = (bf16)(w.x >> 16); VT[(v0 + 2) * LS + j] = (bf16)(w.y & 0xffff); VT[(v0 + 3) * LS + j] = (bf16)(w.y >> 16);
        VT[(v0 + 4) * LS + j] = (bf16)(w.z & 0xffff); VT[(v0 + 5) * LS + j] = (bf16)(w.z >> 16); VT[(v0 + 6) * LS + j] = (bf16)(w.w & 0xffff); VT[(v0 + 7) * LS + j] = (bf16)(w.w >> 16); }
    LDS_BAR();
    const int kap = tid & 63, part = wave;
    float cg[8];
    { const float bg = b_gate[64 * h + kap]; float run = 0.f;
#pragma unroll
      for (int a = 0; a < 8; ++a) { float z = bg;
#pragma unroll
          for (int r = 0; r < 16; ++r) z += GA[(8 * part + a) * 16 + r] * WG[r * 64 + kap];
          run += log_sigmoid(z) * (1.0f / 16.0f); cg[a] = run; }
      TOT[part * 64 + kap] = run; }
    LDS_BAR();
    float offs = 0.f, gmid = 0.f, glast = 0.f;
#pragma unroll
    for (int p = 0; p < 8; ++p) { const float tv = TOT[p * 64 + kap]; if (p < part) offs += tv; if (p < 4) gmid += tv; glast += tv; }
#pragma unroll
    for (int a = 0; a < 8; ++a) { const int i = 8 * part + a; const float G = offs + cg[a];
        const float q = bf2f(QA[(m0 + i) * 256 + 64 * h + kap]), k = bf2f(KA[(m0 + i) * 256 + 64 * h + kap]);
        QT[i * LS + kap] = (bf16)f2bf(q * __expf(G - gmid)); KT[i * LS + kap] = (bf16)f2bf(k * __expf(gmid - G)); KHT[kap * LS + i] = (bf16)f2bf(k * __expf(glast - G));
        QS[(m0 + i) * 256 + 64 * h + kap] = (bf16)f2bf(q * __expf(G)); }
    if (part == 7) DEC[((size_t)bh * 128 + c) * 64 + kap] = __expf(glast);
    LDS_BAR();
    const int fr = lane & 15, fq = lane >> 4;
#pragma unroll
    for (int tt = 0; tt < 2; ++tt) { const int tile = 2 * wave + tt, it = tile >> 2, jt = tile & 3; f32x4 acc = {0.f, 0.f, 0.f, 0.f};
        if (jt <= it) {
#pragma unroll
            for (int ks = 0; ks < 2; ++ks) acc = GLA_MFMA(frag(QT, 16 * it + fr, 32 * ks + 8 * fq), frag(KT, 16 * jt + fr, 32 * ks + 8 * fq), acc); }
#pragma unroll
        for (int r = 0; r < 4; ++r) { const int i = 16 * it + 4 * fq + r, j = 16 * jt + fr; AT[i * LS + j] = (bf16)f2bf(j <= i ? acc[r] : 0.f); } }
    LDS_BAR();
    { const int it = wave & 3;
#pragma unroll
      for (int vv = 0; vv < 4; ++vv) { const int vt = 4 * (wave >> 2) + vv; f32x4 ao = {0.f, 0.f, 0.f, 0.f}, ad = {0.f, 0.f, 0.f, 0.f};
#pragma unroll
          for (int ks = 0; ks < 2; ++ks) { const bf16x8 y = frag(VT, 16 * vt + fr, 32 * ks + 8 * fq);
              ao = GLA_MFMA(frag(AT, 16 * it + fr, 32 * ks + 8 * fq), y, ao); ad = GLA_MFMA(frag(KHT, 16 * it + fr, 32 * ks + 8 * fq), y, ad); }
#pragma unroll
          for (int r = 0; r < 4; ++r) { const int i = 16 * it + 4 * fq + r, v = 16 * vt + fr;
              OI[(m0 + i) * 512 + 128 * h + v] = ao[r]; DS[(((size_t)bh * 128 + c) * 64 + i) * 128 + v] = ad[r]; } } }
}
__device__ __forceinline__ void scan_unit(Frame& F, int u) {
    unsigned char* big = F.ws + WS_BIG;
    const float* DS = (const float*)(big + BG_DS); const float* DEC = (const float*)(big + BG_DEC); bf16* SP = (bf16*)(big + BG_SP);
    const int bh = u >> 4, e = (u & 15) * 512 + F.tid, kap = e >> 7;
    const float* ds = DS + (size_t)bh * 128 * 8192 + e; const float* dc = DEC + (size_t)bh * 128 * 64 + kap; bf16* sp = SP + (size_t)bh * 128 * 8192 + e;
    float S = 0.f;
    for (int c0 = 0; c0 < 128; c0 += 8) { float d[8], g[8];
#pragma unroll
        for (int k = 0; k < 8; ++k) { d[k] = ds[(size_t)(c0 + k) * 8192]; g[k] = dc[(c0 + k) * 64]; }
#pragma unroll
        for (int k = 0; k < 8; ++k) { sp[(size_t)(c0 + k) * 8192] = (bf16)f2bf(S); S = g[k] * S + d[k]; } }
}
__device__ __forceinline__ void out_unit(Frame& F, int b, int h, int c, const float* g_norm) {
    unsigned char* act = F.ws + WS_ACT; unsigned char* big = F.ws + WS_BIG;
    const bf16* RA = (const bf16*)(act + pg8::A_RA); const float* OI = (const float*)(big + BG_OI); const bf16* QS = (const bf16*)(big + BG_QS); const bf16* SP = (const bf16*)(big + BG_SP);
    bf16* MIX = (bf16*)(F.ws + WS_MIX);
    LAS bf16* QL = (LAS bf16*)(F.lds + 0); LAS bf16* ST = (LAS bf16*)(F.lds + 9216); LAS float* SS = (LAS float*)(F.lds + 27648);
    const int tid = F.tid, lane = F.lane, wave = F.wave; const size_t m0 = (size_t)b * SEQ + 64 * c; const int bh = b * 4 + h;
    { const int i = tid >> 3, k0 = (tid & 7) * 8; *(LAS v4u*)(QL + i * LS + k0) = *(const GAS v4u*)(QS + (m0 + i) * 256 + 64 * h + k0); }
    const bf16* sp = SP + ((size_t)bh * 128 + c) * 8192;
    for (int ch = tid; ch < 1024; ch += NTHR) { const int kap = ch >> 4, v0 = (ch & 15) * 8; const v4u w = *(const GAS v4u*)(sp + kap * 128 + v0);
        ST[(v0 + 0) * LS + kap] = (bf16)(w.x & 0xffff); ST[(v0 + 1) * LS + kap] = (bf16)(w.x >> 16); ST[(v0 + 2) * LS + kap] = (bf16)(w.y & 0xffff); ST[(v0 + 3) * LS + kap] = (bf16)(w.y >> 16);
        ST[(v0 + 4) * LS + kap] = (bf16)(w.z & 0xffff); ST[(v0 + 5) * LS + kap] = (bf16)(w.z >> 16); ST[(v0 + 6) * LS + kap] = (bf16)(w.w & 0xffff); ST[(v0 + 7) * LS + kap] = (bf16)(w.w >> 16); }
    LDS_BAR();
    const int fr = lane & 15, fq = lane >> 4, it = wave & 3, vh = wave >> 2;
    f32x4 o[4]; float ss[4] = {0.f, 0.f, 0.f, 0.f};
#pragma unroll
    for (int vv = 0; vv < 4; ++vv) { const int vt = 4 * vh + vv; f32x4 a = {0.f, 0.f, 0.f, 0.f};
#pragma unroll
        for (int ks = 0; ks < 2; ++ks) a = GLA_MFMA(frag(QL, 16 * it + fr, 32 * ks + 8 * fq), frag(ST, 16 * vt + fr, 32 * ks + 8 * fq), a);
#pragma unroll
        for (int r = 0; r < 4; ++r) { const int i = 16 * it + 4 * fq + r, v = 16 * vt + fr; const float x = a[r] + OI[(m0 + i) * 512 + 128 * h + v]; a[r] = x; ss[r] += x * x; }
        o[vv] = a; }
#pragma unroll
    for (int r = 0; r < 4; ++r) { float s = ss[r]; s += __shfl_xor(s, 1); s += __shfl_xor(s, 2); s += __shfl_xor(s, 4); s += __shfl_xor(s, 8); ss[r] = s; }
    if (fr == 0) {
#pragma unroll
        for (int r = 0; r < 4; ++r) SS[vh * 64 + 16 * it + 4 * fq + r] = ss[r]; }
    LDS_BAR();
#pragma unroll
    for (int r = 0; r < 4; ++r) { const int i = 16 * it + 4 * fq + r; const float tot = SS[i] + SS[64 + i]; const float rinv = 1.0f / sqrtf(tot * (1.0f / 128.0f) + LN_EPS);
#pragma unroll
        for (int vv = 0; vv < 4; ++vv) { const int v = 16 * (4 * vh + vv) + fr; const float rr = bf2f(RA[(m0 + i) * 512 + 128 * h + v]);
            const float of = o[vv][r] * rinv * g_norm[v]; const float sg = rr / (1.0f + __expf(-rr));
            MIX[(m0 + i) * 1024 + 128 * h + v] = (bf16)f2bf(of * sg); } }
}
}

namespace dsa {
__device__ __forceinline__ size_t sc_base(int b, int tq) { const size_t J = (size_t)(tq >> 6); return (size_t)b * SCB + 4096 * (J * (J + 1) / 2) + (size_t)(tq & 63) * 64 * (J + 1); }
__device__ __forceinline__ void score_unit(Frame& F, int b, int qb32) {
    unsigned char* act = F.ws + WS_ACT;
    const bf16* QI = (const bf16*)(act + pg8::A_QI); const bf16* KI = (const bf16*)(act + pg8::A_KI); const float* SM = (const float*)(act + pg8::A_SMALL);
    float* SC = (float*)(F.ws + WS_BIG + BG_SC);
    const int lane = F.lane, fr = lane & 15, fq = lane >> 4, qs = F.wave & 1, kp = F.wave >> 1;
    const int tq = 32 * qb32 + 16 * qs + fr; const size_t m = (size_t)b * SEQ + tq;
    bf16x8 qf[8][2]; float wv[8];
#pragma unroll
    for (int h = 0; h < 8; ++h) { wv[h] = SM[m * 32 + 16 + h];
#pragma unroll
        for (int ks = 0; ks < 2; ++ks) qf[h][ks] = *(const bf16x8*)(QI + m * 512 + 64 * h + 32 * ks + 8 * fq); }
    float* srow = SC + sc_base(b, tq);
    const int ntile = (qb32 >> 1) + 1;
    for (int kt = kp; kt < ntile; kt += 4) {
#pragma unroll
        for (int s4 = 0; s4 < 4; ++s4) { const size_t km = (size_t)b * SEQ + 64 * kt + 16 * s4 + fr;
            const bf16x8 k0 = *(const bf16x8*)(KI + km * 64 + 8 * fq), k1 = *(const bf16x8*)(KI + km * 64 + 32 + 8 * fq);
            f32x4 acc = {0.f, 0.f, 0.f, 0.f};
#pragma unroll
            for (int h = 0; h < 8; ++h) { f32x4 d = {0.f, 0.f, 0.f, 0.f}; d = GLA_MFMA(k0, qf[h][0], d); d = GLA_MFMA(k1, qf[h][1], d);
#pragma unroll
                for (int r = 0; r < 4; ++r) acc[r] += wv[h] * __builtin_fmaxf(d[r], 0.f); }
            *(f32x4*)(srow + 64 * kt + 16 * s4 + 4 * fq) = acc; }
    }
}
__device__ __forceinline__ unsigned okey(float v) { const unsigned u = __float_as_uint(v + 0.0f); return u ^ ((u >> 31) ? 0xffffffffu : 0x80000000u); }
__device__ __forceinline__ void find_bin(const LAS unsigned* hist, int per, int need, int lane, int& bin, int& above) {
    int cnt = 0; for (int i = 0; i < per; ++i) cnt += (int)hist[lane * per + ((i + lane) & (per - 1))];
    int incl = cnt;
#pragma unroll
    for (int o = 1; o < 64; o <<= 1) { const int t = __shfl_down(incl, o); if (lane + o < 64) incl += t; }
    const int sfx = incl - cnt; int fb = 0, fa = 0; const bool mine = (sfx < need) && (sfx + cnt >= need);
    if (mine) { int run = sfx; for (int bb = per - 1; bb >= 0; --bb) { const int hv = (int)hist[lane * per + bb]; if (run + hv >= need) { fb = lane * per + bb; fa = run; break; } run += hv; } }
    const unsigned long long bal = __ballot(mine); const int src = __ffsll((long long)bal) - 1;
    bin = __shfl(fb, src); above = __shfl(fa, src);
}
__device__ __forceinline__ void select_unit(Frame& F, int b, int qb32, unsigned long long* maskp) {
    const float* SC = (const float*)(F.ws + WS_BIG + BG_SC);
    LAS unsigned* W = (LAS unsigned*)(F.lds); LAS unsigned* hist = (LAS unsigned*)(F.lds + 32768 + F.wave * 8192);
    const int lane = F.lane, tid = F.tid;
    for (int i = tid; i < 8192; i += NTHR) W[i] = 0u;
    LDS_BAR();
    for (int qi = 0; qi < 4; ++qi) {
        const int q = 4 * F.wave + qi, tq = 32 * qb32 + q, n = tq + 1; const unsigned qbit = 1u << q;
        const float* row = SC + sc_base(b, tq);
        if (n <= 256) { for (int s = lane; s < n; s += 64) __hip_atomic_fetch_or(&W[s], qbit, __ATOMIC_RELAXED, __HIP_MEMORY_SCOPE_WORKGROUP); continue; }
        const int nch = (n + 255) >> 8;
        int B1, B2, B3, ab1, ab2, ab3;
        for (int i = lane; i < 2048; i += 64) hist[i] = 0u; LDS_WAIT();
        for (int ci = 0; ci < nch; ++ci) { const int s0 = ci * 256 + lane * 4; if (s0 < n) { const f32x4 v = *(const GAS f32x4*)(row + s0);
#pragma unroll
            for (int c = 0; c < 4; ++c) if (s0 + c < n) __hip_atomic_fetch_add(&hist[okey(v[c]) >> 21], 1u, __ATOMIC_RELAXED, __HIP_MEMORY_SCOPE_WORKGROUP); } }
        LDS_WAIT(); find_bin(hist, 32, 256, lane, B1, ab1);
        LDS_WAIT(); for (int i = lane; i < 2048; i += 64) hist[i] = 0u; LDS_WAIT();
        for (int ci = 0; ci < nch; ++ci) { const int s0 = ci * 256 + lane * 4; if (s0 < n) { const f32x4 v = *(const GAS f32x4*)(row + s0);
#pragma unroll
            for (int c = 0; c < 4; ++c) { const unsigned k = okey(v[c]); if (s0 + c < n && (int)(k >> 21) == B1) __hip_atomic_fetch_add(&hist[(k >> 10) & 2047u], 1u, __ATOMIC_RELAXED, __HIP_MEMORY_SCOPE_WORKGROUP); } } }
        LDS_WAIT(); find_bin(hist, 32, 256 - ab1, lane, B2, ab2);
        const unsigned pre2 = ((unsigned)B1 << 11) | (unsigned)B2;
        LDS_WAIT(); for (int i = lane; i < 1024; i += 64) hist[i] = 0u; LDS_WAIT();
        for (int ci = 0; ci < nch; ++ci) { const int s0 = ci * 256 + lane * 4; if (s0 < n) { const f32x4 v = *(const GAS f32x4*)(row + s0);
#pragma unroll
            for (int c = 0; c < 4; ++c) { const unsigned k = okey(v[c]); if (s0 + c < n && (k >> 10) == pre2) __hip_atomic_fetch_add(&hist[k & 1023u], 1u, __ATOMIC_RELAXED, __HIP_MEMORY_SCOPE_WORKGROUP); } } }
        LDS_WAIT(); find_bin(hist, 16, 256 - ab1 - ab2, lane, B3, ab3);
        const unsigned T = (pre2 << 10) | (unsigned)B3; const int need_eq = 256 - ab1 - ab2 - ab3; const int cnt_eq = (int)hist[B3];
        if (need_eq >= cnt_eq) {
            for (int ci = 0; ci < nch; ++ci) { const int s0 = ci * 256 + lane * 4; if (s0 < n) { const f32x4 v = *(const GAS f32x4*)(row + s0);
#pragma unroll
                for (int c = 0; c < 4; ++c) if (s0 + c < n && okey(v[c]) >= T) __hip_atomic_fetch_or(&W[s0 + c], qbit, __ATOMIC_RELAXED, __HIP_MEMORY_SCOPE_WORKGROUP); } }
        } else {
            int running = 0; const unsigned long long lt = (1ull << lane) - 1ull;
            for (int s0 = 0; s0 < n; s0 += 64) { const int s = s0 + lane; const bool valid = s < n; const unsigned k = valid ? okey(row[s]) : 0u;
                const bool eq = valid && k == T, gt = valid && k > T; const unsigned long long bal = __ballot(eq);
                const int rank = running + __popcll(bal & lt); if (gt || (eq && rank < need_eq)) __hip_atomic_fetch_or(&W[s], qbit, __ATOMIC_RELAXED, __HIP_MEMORY_SCOPE_WORKGROUP); running += __popcll(bal); }
        }
        LDS_WAIT();
    }
    LDS_BAR();
    const int ntile = 4 * (qb32 >> 3) + 4;
    for (int idx = tid; idx < ntile * 32; idx += NTHR) { const int kt = idx >> 5, j = idx & 31, p = j >> 4, r = j & 15; const int klo = 64 * kt + 32 * p + (r & 3) + 8 * (r >> 2);
        maskp[(size_t)kt * 32 + j] = (unsigned long long)W[klo] | ((unsigned long long)W[klo + 4] << 32); }
}
}
__device__ __forceinline__ void dsa_attn_unit(Frame& F, int b, int h, int qb, const float* rel, const unsigned long long* mask_layer) {
    unsigned char* act = F.ws + WS_ACT;
    LAS float* tb = (LAS float*)(F.lds + att::L_TAB);
    for (int i = F.tid; i < 1920; i += NTHR) { const int d = i - 256; tb[i] = rel[att::t5_bucket(d) * 8 + h] * LOG2E; }
    att::DsaHook hk; hk.rowbase = (long)b * SEQ; hk.q0 = 256 * qb; hk.tb = tb; hk.c31 = rel[31 * 8 + h] * LOG2E;
    hk.maskq = mask_layer + ((size_t)(b * 256 + 8 * qb) * 128) * 32;
    att::attn_unit(hk, (const bf16*)(act + pg8::A_QB) + 64 * h, (const bf16*)(act + pg8::A_KB) + 64 * h, (const bf16*)(act + pg8::A_VB) + 64 * h,
                   (bf16*)(F.ws + WS_MIX) + 512 + 64 * h, (long)b * SEQ + 256 * qb, 4 * (qb + 1), F.lds, 1024);
}
__device__ __forceinline__ void dil_attn_unit(Frame& F, int b, int h, int qb, const float* rel) {
    unsigned char* act = F.ws + WS_ACT;
    LAS float* tb = (LAS float*)(F.lds + att::L_TAB);
    for (int i = F.tid; i < 2560; i += NTHR) { const int d = i - 256; float v = -INFINITY;
        if (d >= 0 && d <= 2048) { const int mult = (d <= 128 ? 1 : 0) + (((d & 3) == 0 && d <= 512) ? 1 : 0) + (((d & 15) == 0) ? 1 : 0);
            if (mult > 0) v = (rel[att::t5_bucket(d) * 8 + h] + (mult == 1 ? 0.f : (mult == 2 ? 0.6931471805599453f : 1.0986122886681098f))) * LOG2E; }
        tb[i] = v; }
    att::DilHook hk; hk.rowbase = (long)b * SEQ; hk.q0 = 256 * qb; hk.kt0 = (4 * qb - 32) > 0 ? (4 * qb - 32) : 0; hk.tb = tb;
    att::attn_unit(hk, (const bf16*)(act + pg8::A_QD) + 64 * h, (const bf16*)(act + pg8::A_KD) + 64 * h, (const bf16*)(act + pg8::A_VD) + 64 * h,
                   (bf16*)(F.ws + WS_MIX) + 512 + 64 * h, (long)b * SEQ + 256 * qb, 4 * (qb + 1) - hk.kt0, F.lds, 1024);
}
__device__ __forceinline__ void fox_attn_unit(Frame& F, int b, int h, int qb) {
    unsigned char* act = F.ws + WS_ACT;
    LAS float* Ft = (LAS float*)(F.lds + att::L_TAB); LAS float* wt = (LAS float*)(F.lds + att::L_TAB + 32768);
    const float* fl = (const float*)(F.ws + WS_MISC + MI_FL) + (size_t)b * SEQ * 8 + h;
    const int n = 256 * (qb + 1);
    { const int s0 = 16 * F.tid; float v[16]; float run = 0.f;
#pragma unroll
      for (int k = 0; k < 16; ++k) { const float x = (s0 < n) ? fl[(size_t)(s0 + k) * 8] : 0.f; run += x; v[k] = run; }
      float incl = run;
#pragma unroll
      for (int o = 1; o < 64; o <<= 1) { const float t = __shfl_up(incl, o); if (F.lane >= o) incl += t; }
      if (F.lane == 63) wt[F.wave] = incl;
      LDS_BAR();
      float base = incl - run;
#pragma unroll
      for (int w = 0; w < 8; ++w) if (w < F.wave) base += wt[w];
      if (s0 < n) {
#pragma unroll
          for (int k = 0; k < 16; ++k) Ft[s0 + k] = (base + v[k]) * LOG2E; }
      LDS_BAR(); }
    att::FoxHook hk; hk.rowbase = (long)b * SEQ; hk.NT = 4 * (qb + 1); hk.q0 = 256 * qb; hk.Ft = Ft;
    att::attn_unit(hk, (const bf16*)(act + pg8::A_QC) + 64 * h, (const bf16*)(act + pg8::A_KC) + 64 * h, (const bf16*)(act + pg8::A_VC) + 64 * h,
                   (bf16*)(F.ws + WS_MIX) + 64 * h, (long)b * SEQ + 256 * qb, 4 * (qb + 1), F.lds, 1024);
}

struct Args {
    const float *x, *ln_g, *ln_b, *rel, *w_in_ab, *w_gate, *b_gate, *g_norm, *w_out_ab, *w_in_cd, *b_forget, *w_out_cd, *w1d, *w3d, *w2d, *w_router, *w1m, *w3m, *w2m;
    float* out; unsigned char* ws; int ph_lo, ph_hi;
};
#ifndef PH_MASK
#define PH_MASK 0x7ff
#endif
#define PH_EN(k) (((PH_MASK) >> (k)) & 1)
constexpr int PH_PER_LAYER = 11, PH_TOTAL = DEPTH * PH_PER_LAYER;
__global__ void __launch_bounds__(NTHR, 2) hyb_fwd(Args args) {
    extern __shared__ __attribute__((aligned(16))) unsigned char lds_raw[];
    Frame F;
    F.lds = (LAS unsigned char*)lds_raw;
    F.MISC = (volatile LAS unsigned*)(F.lds + MISC_OFF);
    F.tid = threadIdx.x; F.lane = F.tid & 63; F.wave = __builtin_amdgcn_readfirstlane(F.tid >> 6);
    F.G = gridDim.x; { const int bx = blockIdx.x; F.vcu = (F.G % 8 == 0) ? (bx % 8) * (F.G / 8) + bx / 8 : bx; }
    F.ws = args.ws; F.ctl = (gu32*)(args.ws + WS_CTL);
    for (int u = F.tid; u < (LDS_BYTES - LDSCTL_OFF) / 4; u += NTHR) ((LAS unsigned*)(F.lds + LDSCTL_OFF))[u] = 0u;
    __syncthreads();
    const int lo = args.ph_lo, hi = args.ph_hi;
    const bool use_bar = (hi - lo) > 1;
    XcdBarrier bar; bar.bar = (unsigned*)(F.ctl + CW_BAR); bar.x = 0; bar.st = nullptr;
    if (use_bar) bar = xcd_barrier_post((unsigned*)(F.ctl + CW_BAR), F.MISC + 8);
#define RUN(g) (lo <= (g) && (g) < hi)
#define PHASE_BEGIN() do { int t_ = threadIdx.x; asm volatile("" : "+v"(t_)); F.tid = t_; F.lane = t_ & 63; F.wave = __builtin_amdgcn_readfirstlane(t_ >> 6); \
        GAS unsigned char* wg_ = (GAS unsigned char*)args.ws; asm volatile("" : "+s"(wg_)); unsigned char* w_ = (unsigned char*)wg_; F.ws = w_; F.ctl = (gu32*)(w_ + WS_CTL); ws = w_; act = w_ + WS_ACT; big = w_ + WS_BIG; \
        X = (float*)(w_ + WS_X); XB = (bf16*)(w_ + WS_XB); MIX = (bf16*)(w_ + WS_MIX); Y = (bf16*)(w_ + WS_Y); Hb = (bf16*)(w_ + WS_BIG + BG_H); XG = (bf16*)(w_ + WS_BIG + BG_XG); } while (0)
#define BAR_AFTER(g) do { if ((g) + 1 < hi) { xcd_barrier(bar); } } while (0)
    unsigned char* ws = args.ws; unsigned char* act = ws + WS_ACT; unsigned char* big = ws + WS_BIG;
    float* X = (float*)(ws + WS_X); bf16* XB = (bf16*)(ws + WS_XB); bf16* MIX = (bf16*)(ws + WS_MIX); bf16* Y = (bf16*)(ws + WS_Y);
    bf16* Hb = (bf16*)(big + BG_H); bf16* XG = (bf16*)(big + BG_XG);

    for (int ly = 0; ly < DEPTH; ++ly) {
        const int j = ly >> 1; const bool even = (ly & 1) == 0; const int g0 = ly * PH_PER_LAYER;
        gu32* qh = F.ctl + CW_Q + (ly * 4) * 64; gu32* cnt = F.ctl + CW_CNT + (j * 8) * 64;
        unsigned long long* mask_layer = (unsigned long long*)(ws + WS_MASK + (size_t)j * 16 * MiB);
        if (RUN(g0 + 0) && PH_EN(0)) { PHASE_BEGIN();
            if (even) {
                conv_matrix(F, 1, args.w_in_ab + (size_t)j * DM * W_AB, nullptr, W_AB, DM, (bf16*)(ws + WS_EVW + EV_WAB), NAB);
                conv_matrix(F, 0, args.w_out_ab + (size_t)j * DM * DM, nullptr, DM, DM, (bf16*)(ws + WS_EVW + EV_WO), DM);
                conv_matrix(F, 3, args.w1d + (size_t)j * DM * FFD, args.w3d + (size_t)j * DM * FFD, FFD, DM, (bf16*)(ws + WS_EVW + EV_W13), 2 * FFD);
                conv_matrix(F, 0, args.w2d + (size_t)j * FFD * DM, nullptr, DM, FFD, (bf16*)(ws + WS_EVW + EV_W2), DM);
                if (ly == 0) rows_to_bf16(F, args.x, XB);
            } else {
                conv_matrix(F, 2, args.w_in_cd + (size_t)j * DM * W_CD, nullptr, W_CD, DM, (bf16*)(big + BG_WCD), NCD);
                conv_matrix(F, 0, args.w_out_cd + (size_t)j * DM * DM, nullptr, DM, DM, (bf16*)(big + BG_WOD), DM);
                for (int e = 0; e < NEXP; ++e) {
                    const size_t eo = ((size_t)j * NEXP + e) * DM * FFE;
                    conv_matrix(F, 3, args.w1m + eo, args.w3m + eo, FFE, DM, (bf16*)(big + BG_W13M) + (size_t)e * 2 * FFE * DM, 2 * FFE);
                    conv_matrix(F, 0, args.w2m + eo, nullptr, DM, FFE, (bf16*)(big + BG_W2M) + (size_t)e * DM * FFE, DM);
                }
            }
            BAR_AFTER(g0 + 0);
        }
        if (RUN(g0 + 1) && PH_EN(1)) { PHASE_BEGIN();
            pg8::Gemm g{XB, even ? (const bf16*)(ws + WS_EVW + EV_WAB) : (const bf16*)(big + BG_WCD), M, even ? NAB : NCD, DM};
            pg8::StaticOrder S; S.init(M, even ? NAB : NCD, F.G, (int)blockIdx.x);
            pg8::EpiProj E{act, even ? 0 : 1};
            pg8::gemm_phase<pg8::EpiProj, pg8::StaticOrder, true, true>(F.lds, g, S, E);
            BAR_AFTER(g0 + 1);
        }
        if (RUN(g0 + 2) && PH_EN(2)) { PHASE_BEGIN();
            if (even) {
                for (;;) { const int u = q_next(F, qh + 0 * 64); if (u >= 1536) break;
                    if (u < 512) dsa::score_unit(F, u & 1, 255 - (u >> 1));
                    else { const int v = u - 512; gla::chunk_unit(F, v >> 9, (v >> 7) & 3, v & 127, args.w_gate + (size_t)j * 16 * 256, args.b_gate + (size_t)j * 256); } }
            } else {
                for (;;) { const int u = q_next(F, qh + 0 * 64); if (u >= 1024) break;
                    if (u < 368) fox_attn_unit(F, (u >> 3) & 1, u & 7, 31 - (u >> 4));
                    else if (u < 752) { const int v = u - 368; dil_attn_unit(F, (v >> 3) & 1, v & 7, 31 - (v >> 4), args.rel); }
                    else if (u < 896) { const int v = u - 752; fox_attn_unit(F, (v >> 3) & 1, v & 7, 8 - (v >> 4)); }
                    else { const int v = u - 896; dil_attn_unit(F, (v >> 3) & 1, v & 7, 7 - (v >> 4), args.rel); } }
            }
            BAR_AFTER(g0 + 2);
        }
        if (even && RUN(g0 + 3) && PH_EN(3)) { PHASE_BEGIN();
            for (;;) { const int u = q_next(F, qh + 1 * 64); if (u >= 640) break;
                if (u < 128) gla::scan_unit(F, u);
                else { const int v = u - 128; const int b = v & 1, qb32 = 255 - (v >> 1); dsa::select_unit(F, b, qb32, mask_layer + ((size_t)(b * 256 + qb32) * 128) * 32); } }
            BAR_AFTER(g0 + 3);
        }
        if (even && RUN(g0 + 4) && PH_EN(4)) { PHASE_BEGIN();
            for (;;) { const int u = q_next(F, qh + 2 * 64); if (u >= 1536) break;
                if (u < 512) dsa_attn_unit(F, (u >> 3) & 1, u & 7, 31 - (u >> 4), args.rel, mask_layer);
                else { const int v = u - 512; gla::out_unit(F, v >> 9, (v >> 7) & 3, v & 127, args.g_norm + (size_t)j * 128); } }
            BAR_AFTER(g0 + 4);
        }
        if (RUN(g0 + 5) && PH_EN(5)) { PHASE_BEGIN();
            pg8::Gemm g{MIX, even ? (const bf16*)(ws + WS_EVW + EV_WO) : (const bf16*)(big + BG_WOD), M, DM, DM};
            pg8::StaticOrder S; S.init(M, DM, F.G, (int)blockIdx.x);
            pg8::EpiPlain E{Y, DM, 4};
            pg8::gemm_phase<pg8::EpiPlain, pg8::StaticOrder, true, true>(F.lds, g, S, E);
            BAR_AFTER(g0 + 5);
        }
        if (RUN(g0 + 6) && PH_EN(6)) { PHASE_BEGIN();
            ln_phase(F, ly == 0 ? args.x : X, Y, 0, args.ln_g + (size_t)(ly * 2) * DM, args.ln_b + (size_t)(ly * 2) * DM, X, XB,
                     even ? 0 : 1, args.w_router + (size_t)j * DM * NEXP, nullptr, cnt);
            BAR_AFTER(g0 + 6);
        }
        if (!even && RUN(g0 + 7) && PH_EN(7)) { PHASE_BEGIN(); scatter_phase(F, XB, XG, cnt); BAR_AFTER(g0 + 7); }
        int ts[9];
        if (even) { ts[0] = 0;
#pragma unroll
            for (int e = 1; e < 9; ++e) ts[e] = M / 256; }
        else moe_tiles(cnt, ts);
        if (RUN(g0 + 8) && PH_EN(8)) { PHASE_BEGIN();
            pg8::Gemm g{even ? XB : XG, even ? (const bf16*)(ws + WS_EVW + EV_W13) : (const bf16*)(big + BG_W13M), M, 0, DM};
            pg8::GroupOrder S; S.init(ts, even ? 22 : 28, F.G, (int)blockIdx.x);
            pg8::EpiSwiGLU E{Hb, even ? FFD : FFE, even ? 22 : 28};
            pg8::gemm_phase<pg8::EpiSwiGLU, pg8::GroupOrder, true, true>(F.lds, g, S, E);
            BAR_AFTER(g0 + 8);
        }
        if (RUN(g0 + 9) && PH_EN(9)) { PHASE_BEGIN();
            pg8::Gemm g{Hb, even ? (const bf16*)(ws + WS_EVW + EV_W2) : (const bf16*)(big + BG_W2M), M, 0, even ? FFD : FFE};
            pg8::GroupOrder S; S.init(ts, 4, F.G, (int)blockIdx.x);
            pg8::EpiPlain E{even ? Y : XG, DM, 4};
            pg8::gemm_phase<pg8::EpiPlain, pg8::GroupOrder, true, true>(F.lds, g, S, E);
            BAR_AFTER(g0 + 9);
        }
        if (RUN(g0 + 10) && PH_EN(10)) { PHASE_BEGIN();
            ln_phase(F, X, even ? Y : XG, even ? 0 : 1, args.ln_g + (size_t)(ly * 2 + 1) * DM, args.ln_b + (size_t)(ly * 2 + 1) * DM, ly == DEPTH - 1 ? args.out : X, XB,
                     even ? 2 : 0, args.w_in_cd + (size_t)j * DM * W_CD, args.b_forget + (size_t)j * 8, cnt);
            BAR_AFTER(g0 + 10);
        }
    }
#undef RUN
#undef BAR_AFTER
}

#ifndef HYB_N_LAUNCHES
#define HYB_N_LAUNCHES 1
#endif
extern "C" void kernel_launch(void* const* d_in, const int* in_sizes, int n_in, void* d_out, int out_size, void* d_ws, size_t ws_size, hipStream_t stream) {
    static int grid = 0;
    if (grid == 0) {
        if (n_in != 19 || in_sizes[0] != M * DM || out_size != M * DM || ws_size < WS_END) { fprintf(stderr, "kernel_launch: unexpected shapes / workspace (n_in %d, ws %zu, need %zu)\n", n_in, ws_size, (size_t)WS_END); grid = -1; return; }
        { const long exp_sz[19] = {(long)M * DM, (long)DEPTH * 2 * DM, (long)DEPTH * 2 * DM, 32 * 8, 2L * DM * W_AB, 2L * 16 * 256, 2L * 256, 2L * 128, 2L * DM * DM, 2L * DM * W_CD, 2L * 8, 2L * DM * DM,
              2L * DM * FFD, 2L * DM * FFD, 2L * FFD * DM, 2L * DM * NEXP, 2L * NEXP * DM * FFE, 2L * NEXP * DM * FFE, 2L * NEXP * FFE * DM};
          for (int i = 0; i < 19; ++i) if ((long)in_sizes[i] != exp_sz[i]) { fprintf(stderr, "kernel_launch: input %d has %d elements, expected %ld\n", i, in_sizes[i], exp_sz[i]); grid = -1; return; } }
        int dev = 0, cus = 0, per_cu = 0;
        if (hipGetDevice(&dev) != hipSuccess || hipDeviceGetAttribute(&cus, hipDeviceAttributeMultiprocessorCount, dev) != hipSuccess) { grid = -1; return; }
        if (hipFuncSetAttribute((const void*)hyb_fwd, hipFuncAttributeMaxDynamicSharedMemorySize, LDS_BYTES) != hipSuccess) { fprintf(stderr, "kernel_launch: hipFuncSetAttribute failed\n"); grid = -1; return; }
        if (hipOccupancyMaxActiveBlocksPerMultiprocessor(&per_cu, (const void*)hyb_fwd, NTHR, LDS_BYTES) != hipSuccess || per_cu < 1) fprintf(stderr, "kernel_launch: occupancy query reports %d\n", per_cu);
        (void)hipGetLastError();
        grid = cus;
    }
    if (grid < 0) return;
    if (hipMemsetAsync((char*)d_ws + WS_CTL, 0, CTL_ZERO_BYTES, stream) != hipSuccess) { fprintf(stderr, "kernel_launch: memset failed\n"); return; }
    Args a{};
    a.x = (const float*)d_in[0]; a.ln_g = (const float*)d_in[1]; a.ln_b = (const float*)d_in[2]; a.rel = (const float*)d_in[3]; a.w_in_ab = (const float*)d_in[4]; a.w_gate = (const float*)d_in[5];
    a.b_gate = (const float*)d_in[6]; a.g_norm = (const float*)d_in[7]; a.w_out_ab = (const float*)d_in[8]; a.w_in_cd = (const float*)d_in[9]; a.b_forget = (const float*)d_in[10]; a.w_out_cd = (const float*)d_in[11];
    a.w1d = (const float*)d_in[12]; a.w3d = (const float*)d_in[13]; a.w2d = (const float*)d_in[14]; a.w_router = (const float*)d_in[15]; a.w1m = (const float*)d_in[16]; a.w3m = (const float*)d_in[17]; a.w2m = (const float*)d_in[18];
    a.out = (float*)d_out; a.ws = (unsigned char*)d_ws;
#if HYB_N_LAUNCHES == 1
#ifndef HYB_PH_HI
#define HYB_PH_HI PH_TOTAL
#endif
#ifndef HYB_PH_LO
#define HYB_PH_LO 0
#endif
    a.ph_lo = HYB_PH_LO; a.ph_hi = HYB_PH_HI;
    hipLaunchKernelGGL(hyb_fwd, dim3(grid), dim3(NTHR), LDS_BYTES, stream, a);
#else
    for (int ph = 0; ph < PH_TOTAL; ++ph) {
        const int ly = ph / PH_PER_LAYER, k = ph % PH_PER_LAYER; const bool even = (ly & 1) == 0;
        if (even && k == 7) continue; if (!even && (k == 3 || k == 4)) continue;
        a.ph_lo = ph; a.ph_hi = ph + 1;
        hipLaunchKernelGGL(hyb_fwd, dim3(grid), dim3(NTHR), LDS_BYTES, stream, a);
    }
#endif
    const hipError_t le = hipPeekAtLastError();
    if (le != hipSuccess) fprintf(stderr, "kernel_launch: launch failed: %s\n", hipGetErrorName(le));
}
```

```cpp
#include <hip/hip_runtime.h>
#include <cstdio>
#include <cstdint>
#include <cmath>
namespace pg8 {
#define PG8_LAS __attribute__((address_space(3)))
typedef unsigned short bf16_t;
typedef short bf16x8 __attribute__((ext_vector_type(8)));
typedef float f32x4 __attribute__((ext_vector_type(4)));
typedef unsigned u32x4 __attribute__((ext_vector_type(4)));
constexpr int BM = 256, BK = 64, HALF = 128, HTB = HALF * BK * 2  , STAGE_BYTES = 8 * HTB, NXCD = 8, WGM = 8;

__host__ __device__ __forceinline__ int lds_byte(int r, int c) { const int st = (r >> 4) * 2 + (c >> 5), rr = r & 15, cc = c & 31, ob = rr * 64 + cc * 2; return st * 1024 + (ob ^ (((ob >> 9) & 1) << 5)); }
__host__ __device__ __forceinline__ void stage_rc(int b, int& R, int& C) { const int st = b / 1024, sb = b % 1024, swz = sb ^ (((sb >> 9) & 1) << 5); R = (st >> 1) * 16 + swz / 64; C = (st & 1) * 32 + (swz % 64) / 2; }
__host__ __device__ __forceinline__ int perm32(int rho) { const int n = rho >> 4, i = rho & 15; return 8 * (i >> 2) + 4 * n + (i & 3); }

struct Unit { int pm, pn; };
struct Gemm { const bf16_t* A; const bf16_t* Bt; int M, N, K; };

struct StaticOrder {
    int nM, nN, nwg, G, c;
    __host__ __device__ void init(int M, int N, int G_, int c_) { nM = M / BM; nN = N / BM; nwg = nM * nN; G = G_; c = c_; }
    __host__ __device__ bool next(int i, Unit& u) const {
        const long L = (long)i * G + c; if (L >= nwg) return false;
        int wgid = (int)L; { const int q = nwg / NXCD, r = nwg % NXCD, xcd = wgid % NXCD, off = wgid / NXCD; wgid = (xcd < r ? xcd * (q + 1) : r * (q + 1) + (xcd - r) * q) + off; }
        const int nig = WGM * nN, gid = wgid / nig, fm = gid * WGM, gsz = (nM - fm) < WGM ? (nM - fm) : WGM;
        u.pm = fm + ((wgid % nig) % gsz); u.pn = (wgid % nig) / gsz; return true;
    }
    __device__ __forceinline__ void a_ready(const Unit&) const {}
    __device__ __forceinline__ void done(const Unit&) const {}
};

__device__ __forceinline__ unsigned cvt_pk_bf16(float lo, float hi) { unsigned r; asm volatile("v_cvt_pk_bf16_f32 %0, %1, %2" : "=v"(r) : "v"(lo), "v"(hi)); return r; }
typedef float f32x2 __attribute__((ext_vector_type(2)));
constexpr float QC2 = 0.125f * 1.4426950408889634f;

constexpr size_t ACT_MB = 1u << 20;
constexpr size_t A_QA = 0, A_KA = 8 * ACT_MB, A_VA = 16 * ACT_MB, A_RA = 32 * ACT_MB, A_QB = 48 * ACT_MB, A_KB = 64 * ACT_MB, A_VB = 80 * ACT_MB, A_QI = 96 * ACT_MB,
                 A_SMALL = 112 * ACT_MB  , A_KI = 114 * ACT_MB  ;
constexpr size_t A_QC = 0, A_KC = 16 * ACT_MB, A_VC = 32 * ACT_MB, A_QD = 48 * ACT_MB, A_KD = 64 * ACT_MB, A_VD = 80 * ACT_MB;
struct EpiProj {
    static constexpr bool PERM = true, AFTER_DRAIN = false;
    unsigned char* act; int mode;
    __device__ __forceinline__ void operator()(const f32x4 (&acc)[2][2][4][2], const Unit& u, int wr, int wc, int fr, int fq) const {
        const int row0 = u.pm * BM + wr * 64 + fr; const int pn = u.pn;
        if (mode == 0 && pn == 14) {
            float* sm = (float*)(act + A_SMALL); bf16_t* ki = (bf16_t*)(act + A_KI);
            if (wc < 3) {
#pragma unroll
                for (int ai = 0; ai < 2; ++ai)
#pragma unroll
                    for (int m = 0; m < 4; ++m) { const int row = row0 + ai * HALF + m * 16; const f32x4 v0 = acc[ai][0][m][0], v1 = acc[ai][0][m][1];
                        const int cl = wc * 32 + 8 * fq;
                        if (cl < 16) { *(f32x4*)(sm + (size_t)row * 32 + cl) = v0; *(f32x4*)(sm + (size_t)row * 32 + cl + 4) = v1; }
                        else if (cl < 80) { u32x4 w; w.x = cvt_pk_bf16(v0[0], v0[1]); w.y = cvt_pk_bf16(v0[2], v0[3]); w.z = cvt_pk_bf16(v1[0], v1[1]); w.w = cvt_pk_bf16(v1[2], v1[3]);
                            *(u32x4*)(ki + (size_t)row * 64 + (cl - 16)) = w; }
                        else if (cl < 88) { *(f32x4*)(sm + (size_t)row * 32 + 16) = v0; *(f32x4*)(sm + (size_t)row * 32 + 20) = v1; } }
            }
            return;
        }
        size_t off; int ld, colt; float sc = 1.f;
        if (mode == 0) {
            if (pn == 0) { off = A_QA; ld = 256; colt = 0; sc = 0.125f; }
            else if (pn == 1) { off = A_KA; ld = 256; colt = 0; }
            else { const int t = (pn - 2) >> 1; colt = ((pn - 2) & 1) * 256; ld = 512; off = A_VA + (size_t)t * 16 * ACT_MB; if (t == 2) sc = QC2; }
        } else { const int t = pn >> 1; colt = (pn & 1) * 256; ld = 512; off = (size_t)t * 16 * ACT_MB; if (t == 0 || t == 3) sc = QC2; }
        bf16_t* base = (bf16_t*)(act + off);
        const int col0 = colt + wc * 32 + 8 * fq;
#pragma unroll
        for (int ai = 0; ai < 2; ++ai)
#pragma unroll
            for (int m = 0; m < 4; ++m) { bf16_t* rowp = base + (size_t)(row0 + ai * HALF + m * 16) * ld + col0;
#pragma unroll
                for (int bj = 0; bj < 2; ++bj) { const f32x4 v0 = acc[ai][bj][m][0] * sc, v1 = acc[ai][bj][m][1] * sc;
                    u32x4 w; w.x = cvt_pk_bf16(v0[0], v0[1]); w.y = cvt_pk_bf16(v0[2], v0[3]); w.z = cvt_pk_bf16(v1[0], v1[1]); w.w = cvt_pk_bf16(v1[2], v1[3]);
                    *(u32x4*)(rowp + bj * HALF) = w; } }
    }
};
struct EpiPlain {
    static constexpr bool PERM = true, AFTER_DRAIN = false;
    bf16_t* O; int ld, nct;
    __device__ __forceinline__ void operator()(const f32x4 (&acc)[2][2][4][2], const Unit& u, int wr, int wc, int fr, int fq) const {
        const int row0 = u.pm * BM + wr * 64 + fr; const int col0 = (u.pn % nct) * BM + wc * 32 + 8 * fq;
#pragma unroll
        for (int ai = 0; ai < 2; ++ai)
#pragma unroll
            for (int m = 0; m < 4; ++m) { bf16_t* rowp = O + (size_t)(row0 + ai * HALF + m * 16) * ld + col0;
#pragma unroll
                for (int bj = 0; bj < 2; ++bj) { const f32x4 v0 = acc[ai][bj][m][0], v1 = acc[ai][bj][m][1];
                    u32x4 w; w.x = cvt_pk_bf16(v0[0], v0[1]); w.y = cvt_pk_bf16(v0[2], v0[3]); w.z = cvt_pk_bf16(v1[0], v1[1]); w.w = cvt_pk_bf16(v1[2], v1[3]);
                    *(u32x4*)(rowp + bj * HALF) = w; } }
    }
};
__device__ __forceinline__ float silu_mul(float a, float b) { return a * b * __builtin_amdgcn_rcpf(1.0f + __builtin_amdgcn_exp2f(-1.4426950408889634f * a)); }
struct EpiSwiGLU {
    static constexpr bool PERM = true, AFTER_DRAIN = false;
    bf16_t* H; int ld, nct;
    __device__ __forceinline__ void operator()(const f32x4 (&acc)[2][2][4][2], const Unit& u, int wr, int wc, int fr, int fq) const {
        const int row0 = u.pm * BM + wr * 64 + fr; const int col0 = (u.pn % nct) * HALF + wc * 32 + 8 * fq;
#pragma unroll
        for (int ai = 0; ai < 2; ++ai)
#pragma unroll
            for (int m = 0; m < 4; ++m) { bf16_t* rowp = H + (size_t)(row0 + ai * HALF + m * 16) * ld + col0;
                const f32x4 a0 = acc[ai][0][m][0], a1 = acc[ai][0][m][1], b0 = acc[ai][1][m][0], b1 = acc[ai][1][m][1];
                u32x4 w; w.x = cvt_pk_bf16(silu_mul(a0[0], b0[0]), silu_mul(a0[1], b0[1])); w.y = cvt_pk_bf16(silu_mul(a0[2], b0[2]), silu_mul(a0[3], b0[3]));
                w.z = cvt_pk_bf16(silu_mul(a1[0], b1[0]), silu_mul(a1[1], b1[1])); w.w = cvt_pk_bf16(silu_mul(a1[2], b1[2]), silu_mul(a1[3], b1[3]));
                *(u32x4*)rowp = w; }
    }
};
struct GroupOrder {
    int ts0, ts1, ts2, ts3, ts4, ts5, ts6, ts7, ts8; int nct, total, G, c;
    __device__ __forceinline__ void init(const int (&ts)[9], int nct_, int G_, int c_) { ts0 = ts[0]; ts1 = ts[1]; ts2 = ts[2]; ts3 = ts[3]; ts4 = ts[4]; ts5 = ts[5]; ts6 = ts[6]; ts7 = ts[7]; ts8 = ts[8];
        nct = nct_; total = (ts8 - ts0) * nct_; G = G_; c = c_; }
    __device__ __forceinline__ bool next(int i, Unit& u) const {
        const long L = (long)i * G + c; if (L >= total) return false;
        int w = (int)L; { const int q = total / NXCD, r = total % NXCD, xcd = w % NXCD, off = w / NXCD; w = (xcd < r ? xcd * (q + 1) : r * (q + 1) + (xcd - r) * q) + off; }
        int e = 0, first = ts0, T = ts1 - ts0;
#define PG8_GO_STEP(E, A, B) if (e == (E) - 1 && w >= T * nct) { w -= T * nct; e = (E); first = (A); T = (B) - (A); }
        PG8_GO_STEP(1, ts1, ts2) PG8_GO_STEP(2, ts2, ts3) PG8_GO_STEP(3, ts3, ts4) PG8_GO_STEP(4, ts4, ts5) PG8_GO_STEP(5, ts5, ts6) PG8_GO_STEP(6, ts6, ts7) PG8_GO_STEP(7, ts7, ts8)
#undef PG8_GO_STEP
        const int nig = WGM * nct, gid = w / nig, fm = gid * WGM, gsz = (T - fm) < WGM ? (T - fm) : WGM;
        u.pm = first + fm + ((w % nig) % gsz); u.pn = e * nct + (w % nig) / gsz; return true;
    }
    __device__ __forceinline__ void a_ready(const Unit&) const {}
    __device__ __forceinline__ void done(const Unit&) const {}
};
template <class Epi, class Sched, bool ALIGN_EPI = false, bool SP2 = false>
__device__ __forceinline__ void gemm_phase(PG8_LAS unsigned char* lds, const Gemm g, const Sched& S, const Epi& E) {
    int tid_ = threadIdx.x; asm volatile("" : "+v"(tid_)); const int tid = tid_, wid = __builtin_amdgcn_readfirstlane(tid >> 6), lane = tid & 63, wr = wid >> 2, wc = wid & 3, fr = lane & 15, fq = lane >> 4;
    const int K = g.K, nt = K / BK;
    unsigned voffA[2], voffB[2];
#pragma unroll
    for (int i = 0; i < 2; ++i) { int R, C; stage_rc(tid * 16 + i * 8192, R, C); const int Rb = Epi::PERM ? ((R & ~31) + perm32(R & 31)) : R;
        voffA[i] = (unsigned)(R * K + C) * 2u; voffB[i] = (unsigned)(Rb * K + C) * 2u; }
    const size_t kstep = (size_t)(BK * 2);
    const size_t hstep = (size_t)HALF * K * 2;
    const size_t tstep = 2 * hstep;
    const unsigned ldsw = (unsigned)wid * 1024u;
    const int aoff = lds_byte(wr * 64 + fr, fq * 8), boff = lds_byte(wc * 32 + fr, fq * 8);
#define PG8_SA(b, h) (((b) * 2 + (h)) * HTB)
#define PG8_SB(b, h) ((4 + (b) * 2 + (h)) * HTB)
#define PG8_STAGE(bufoff, gbase, voff) do { _Pragma("unroll") for (int _i = 0; _i < 2; ++_i) \
        __builtin_amdgcn_global_load_lds((const unsigned*)((const char*)(gbase) + (voff)[_i]), (PG8_LAS unsigned*)(lds + (bufoff) + ldsw + _i * 8192), 16, 0, 0); } while (0)
#define PG8_LDA(dst, b, h) do { _Pragma("unroll") for (int m = 0; m < 4; ++m) _Pragma("unroll") for (int k = 0; k < 2; ++k) dst[m][k] = *(const PG8_LAS bf16x8*)(lds + PG8_SA(b, h) + aoff + m * 2048 + k * 1024); } while (0)
#define PG8_LDB(dst, b, h) do { _Pragma("unroll") for (int n = 0; n < 2; ++n) _Pragma("unroll") for (int k = 0; k < 2; ++k) dst[n][k] = *(const PG8_LAS bf16x8*)(lds + PG8_SB(b, h) + boff + n * 2048 + k * 1024); } while (0)
#define PG8_MMA(ai, bj, At, Bt) do { __builtin_amdgcn_s_setprio(1); _Pragma("unroll") for (int m = 0; m < 4; ++m) _Pragma("unroll") for (int n = 0; n < 2; ++n) _Pragma("unroll") for (int k = 0; k < 2; ++k) \
        acc[ai][bj][m][n] = __builtin_amdgcn_mfma_f32_16x16x32_bf16(Bt[n][k], At[m][k], acc[ai][bj][m][n], 0, 0, 0); __builtin_amdgcn_s_setprio(0); } while (0)
#define PG8_WAIT_V(n) asm volatile("s_waitcnt vmcnt(" #n ")" ::: "memory")
#define PG8_WAIT_L(n) asm volatile("s_waitcnt lgkmcnt(" #n ")" ::: "memory")
#define PG8_BAR __builtin_amdgcn_s_barrier()
#define PG8_SCHED __builtin_amdgcn_sched_barrier(0)
    Unit cur, nxt; int ui = 0;
    if (!S.next(0, cur)) return;
    f32x4 acc[2][2][4][2];
#pragma unroll
    for (int a = 0; a < 2; ++a)
#pragma unroll
        for (int b = 0; b < 2; ++b)
#pragma unroll
            for (int m = 0; m < 4; ++m)
#pragma unroll
                for (int n = 0; n < 2; ++n) acc[a][b][m][n] = (f32x4){0.f, 0.f, 0.f, 0.f};
    bf16x8 At[4][2], B0[2][2], B1[2][2];
    const char* cA = (const char*)g.A + (size_t)cur.pm * tstep; const char* cB = (const char*)g.Bt + (size_t)cur.pn * tstep;
    S.a_ready(cur);
    if constexpr (SP2) {
        PG8_STAGE(PG8_SB(0, 0), cB, voffB); PG8_STAGE(PG8_SB(0, 1), cB + hstep, voffB); PG8_STAGE(PG8_SA(0, 0), cA, voffA); PG8_STAGE(PG8_SA(0, 1), cA + hstep, voffA);
        if (wr == 1) PG8_BAR;
        PG8_WAIT_V(2); PG8_BAR;
        PG8_STAGE(PG8_SB(1, 0), cB + kstep, voffB); PG8_STAGE(PG8_SA(1, 0), cA + kstep, voffA); PG8_STAGE(PG8_SB(1, 1), cB + hstep + kstep, voffB);
        PG8_WAIT_V(6); PG8_BAR;
    } else {
        PG8_STAGE(PG8_SB(0, 0), cB, voffB); PG8_STAGE(PG8_SA(0, 0), cA, voffA); PG8_STAGE(PG8_SB(0, 1), cB + hstep, voffB); PG8_STAGE(PG8_SA(0, 1), cA + hstep, voffA);
        if (wr == 1) PG8_BAR;
        PG8_WAIT_V(4); PG8_BAR;
        PG8_STAGE(PG8_SB(1, 0), cB + kstep, voffB); PG8_STAGE(PG8_SA(1, 0), cA + kstep, voffA); PG8_STAGE(PG8_SB(1, 1), cB + hstep + kstep, voffB);
        PG8_WAIT_V(6); PG8_BAR;
    }
    for (;;) {
        const bool has_next = S.next(ui + 1, nxt);
        const char* nA = has_next ? (const char*)g.A + (size_t)nxt.pm * tstep : cA; const char* nB = has_next ? (const char*)g.Bt + (size_t)nxt.pn * tstep : cB;
        for (int t = 0; t < nt; t += 2) {
            const bool last = (t == nt - 2);
            const char* a1 = cA + (size_t)(t + 1) * kstep;
            const char* a2 = last ? nA : cA + (size_t)(t + 2) * kstep; const char* b2 = last ? nB : cB + (size_t)(t + 2) * kstep;
            const char* a3 = a2 + kstep; const char* b3 = b2 + kstep;
            if (last && has_next) S.a_ready(nxt);
            if constexpr (SP2) {
            PG8_LDB(B0, 0, 0); PG8_LDB(B1, 0, 1); PG8_SCHED; PG8_LDA(At, 0, 0); PG8_STAGE(PG8_SA(1, 1), a1 + hstep, voffA);
            PG8_WAIT_V(8); PG8_WAIT_L(0); PG8_BAR; PG8_MMA(0, 0, At, B0); PG8_MMA(0, 1, At, B1); PG8_BAR; PG8_SCHED;
            PG8_LDA(At, 0, 1); PG8_STAGE(PG8_SB(0, 0), b2, voffB); PG8_STAGE(PG8_SB(0, 1), b2 + hstep, voffB); PG8_STAGE(PG8_SA(0, 0), a2, voffA);
            PG8_WAIT_V(8); PG8_WAIT_L(0); PG8_BAR; PG8_MMA(1, 0, At, B0); PG8_MMA(1, 1, At, B1); PG8_BAR; PG8_SCHED;
            PG8_LDB(B0, 1, 0); PG8_LDB(B1, 1, 1); PG8_SCHED; PG8_LDA(At, 1, 0); PG8_STAGE(PG8_SA(0, 1), a2 + hstep, voffA);
            PG8_WAIT_V(8); PG8_WAIT_L(0); PG8_BAR; PG8_MMA(0, 0, At, B0); PG8_MMA(0, 1, At, B1); PG8_BAR; PG8_SCHED;
            PG8_LDA(At, 1, 1); PG8_STAGE(PG8_SB(1, 0), b3, voffB); PG8_STAGE(PG8_SB(1, 1), b3 + hstep, voffB); PG8_STAGE(PG8_SA(1, 0), a3, voffA);
            PG8_WAIT_V(8); PG8_WAIT_L(0); PG8_BAR; PG8_MMA(1, 0, At, B0); PG8_MMA(1, 1, At, B1); PG8_BAR; PG8_SCHED;
            } else {
            PG8_LDB(B0, 0, 0); PG8_SCHED; PG8_LDA(At, 0, 0); PG8_STAGE(PG8_SA(1, 1), a1 + hstep, voffA);
            PG8_WAIT_L(8); PG8_BAR; PG8_WAIT_L(0); PG8_MMA(0, 0, At, B0); PG8_BAR; PG8_SCHED;
            PG8_LDB(B1, 0, 1); PG8_STAGE(PG8_SB(0, 0), b2, voffB);
            PG8_BAR; PG8_WAIT_L(0); PG8_MMA(0, 1, At, B1); PG8_BAR;
            PG8_LDA(At, 0, 1); PG8_STAGE(PG8_SA(0, 0), a2, voffA);
            PG8_BAR; PG8_WAIT_L(0); PG8_MMA(1, 0, At, B0); PG8_BAR; PG8_SCHED;
            PG8_STAGE(PG8_SB(0, 1), b2 + hstep, voffB);
            PG8_WAIT_V(6); PG8_BAR; PG8_MMA(1, 1, At, B1); PG8_BAR;
            PG8_LDB(B0, 1, 0); PG8_SCHED; PG8_LDA(At, 1, 0); PG8_STAGE(PG8_SA(0, 1), a2 + hstep, voffA);
            PG8_WAIT_L(8); PG8_BAR; PG8_WAIT_L(0); PG8_MMA(0, 0, At, B0); PG8_BAR; PG8_SCHED;
            PG8_LDB(B1, 1, 1); PG8_STAGE(PG8_SB(1, 0), b3, voffB);
            PG8_BAR; PG8_WAIT_L(0); PG8_MMA(0, 1, At, B1); PG8_BAR;
            PG8_LDA(At, 1, 1); PG8_STAGE(PG8_SA(1, 0), a3, voffA);
            PG8_BAR; PG8_WAIT_L(0); PG8_MMA(1, 0, At, B0); PG8_BAR; PG8_SCHED;
            PG8_STAGE(PG8_SB(1, 1), b3 + hstep, voffB);
            PG8_WAIT_V(6); PG8_BAR; PG8_MMA(1, 1, At, B1); PG8_BAR;
            }
        }
        if constexpr (ALIGN_EPI) { if (wr == 0) PG8_BAR; }
        if constexpr (!Epi::AFTER_DRAIN) { E(acc, cur, wr, wc, fr, fq); S.done(cur); }
        if (!has_next) break;
#pragma unroll
        for (int a = 0; a < 2; ++a)
#pragma unroll
            for (int b = 0; b < 2; ++b)
#pragma unroll
                for (int m = 0; m < 4; ++m)
#pragma unroll
                    for (int n = 0; n < 2; ++n) acc[a][b][m][n] = (f32x4){0.f, 0.f, 0.f, 0.f};
        cur = nxt; cA = nA; cB = nB; ++ui;
        if constexpr (ALIGN_EPI) { if (wr == 1) PG8_BAR; }
    }
    PG8_WAIT_V(0);
    if constexpr (!ALIGN_EPI) { if (wr == 0) PG8_BAR; }
    PG8_BAR;
    if constexpr (Epi::AFTER_DRAIN) { E.fused(acc, cur, wr, wc, fr, fq, lds, wid, lane); S.done(cur); }
#undef PG8_SA
#undef PG8_SB
#undef PG8_STAGE
#undef PG8_LDA
#undef PG8_LDB
#undef PG8_MMA
#undef PG8_WAIT_V
#undef PG8_WAIT_L
#undef PG8_BAR
#undef PG8_SCHED
}
}
#define GAS __attribute__((address_space(1)))
#define LAS __attribute__((address_space(3)))
typedef unsigned short bf16;
typedef unsigned v4u __attribute__((ext_vector_type(4)));
typedef unsigned v2u __attribute__((ext_vector_type(2)));
typedef float f32x4 __attribute__((ext_vector_type(4)));
typedef float f32x2 __attribute__((ext_vector_type(2)));
typedef float f32x16 __attribute__((ext_vector_type(16)));
typedef short bf16x8 __attribute__((ext_vector_type(8)));
typedef short s16x4 __attribute__((ext_vector_type(4)));
typedef GAS unsigned gu32;
typedef GAS unsigned long long gu64;
#define RLX_AGENT __ATOMIC_RELAXED, __HIP_MEMORY_SCOPE_AGENT
#define LDS_WAIT() asm volatile("s_waitcnt lgkmcnt(0)" ::: "memory")
#define VM_WAIT() asm volatile("s_waitcnt vmcnt(0)" ::: "memory")
#define WG_BAR() asm volatile("s_waitcnt vmcnt(0) lgkmcnt(0)\n\ts_barrier" ::: "memory")
#define LDS_BAR() asm volatile("s_waitcnt lgkmcnt(0)\n\ts_barrier" ::: "memory")
__device__ __forceinline__ unsigned f2bf(float f) { unsigned u = __builtin_bit_cast(unsigned, f); return (u + 0x7fffu + ((u >> 16) & 1u)) >> 16; }
__device__ __forceinline__ unsigned pk2(float lo, float hi) { return f2bf(lo) | (f2bf(hi) << 16); }
__device__ __forceinline__ float bf2f(unsigned short b) { return __builtin_bit_cast(float, (unsigned)b << 16); }
__device__ __forceinline__ float bflo(unsigned w) { return __builtin_bit_cast(float, w << 16); }
__device__ __forceinline__ float bfhi(unsigned w) { return __builtin_bit_cast(float, w & 0xffff0000u); }
__device__ __forceinline__ float wave_sum(float v) {
#pragma unroll
    for (int o = 1; o < 64; o <<= 1) v += __shfl_xor(v, o);
    return v;
}
constexpr float LOG2E = 1.4426950408889634f;
__device__ __forceinline__ float fast_exp(float x) { return __builtin_amdgcn_exp2f(x * LOG2E); }
__device__ __forceinline__ float log_sigmoid(float z) { return fminf(z, 0.f) - log1pf(expf(-fabsf(z))); }
#define XB_TMO      128
#define XB_XCNT(j)  (256  + 64 * (j))
#define XB_XSUB(j)  (1280 + 64 * (j))
#define XB_XGEN(j)  (2304 + 64 * (j))
#define XB_TOP      3328
#define XB_TOPGEN   3392
#define XCD_BAR_WORDS 3456
#define XB_SPIN_CAP (1u << 18)

__device__ __forceinline__ unsigned xb_ld(unsigned* p)              { return __hip_atomic_load(p, __ATOMIC_RELAXED, __HIP_MEMORY_SCOPE_AGENT); }
__device__ __forceinline__ unsigned xb_add(unsigned* p, unsigned v) { return __hip_atomic_fetch_add(p, v, __ATOMIC_RELAXED, __HIP_MEMORY_SCOPE_AGENT); }
__device__ __forceinline__ unsigned xb_xcc_id() { return (unsigned)__builtin_amdgcn_s_getreg((3 << 11) | 20) & 0xFu; }
#define XB_SPIN(cond, bar) do { unsigned _sp = 0; while (cond) { __builtin_amdgcn_s_sleep(1); \
    if ((++_sp & 255u) == 0u) { if (xb_ld(&(bar)[XB_TMO])) break; if (_sp > XB_SPIN_CAP) { atomicAdd(&(bar)[XB_TMO], 1u); break; } } } } while (0)

struct XcdBarrier {
    unsigned* bar; unsigned x;
    volatile LAS unsigned* st;
};

__device__ __forceinline__ XcdBarrier xcd_barrier_post(unsigned* bar, volatile LAS unsigned* st) {
    XcdBarrier b; b.bar = bar; b.x = xb_xcc_id(); b.st = st;
    if (threadIdx.x == 0) (void)xb_add(&bar[XB_XCNT(b.x)], 1u);
    return b;
}
__device__ __forceinline__ void xcd_barrier_complete(unsigned* bar, unsigned x, unsigned& nloc, unsigned& nx) {
    const unsigned G = gridDim.x * gridDim.y * gridDim.z;
    unsigned sum, cnt, mine, sp = 0u;
    for (;;) {
        sum = 0u; cnt = 0u; mine = 0u;
#pragma unroll
        for (unsigned j = 0; j < 16; ++j) { const unsigned c = xb_ld(&bar[XB_XCNT(j)]); sum += c; cnt += (c > 0u) ? 1u : 0u; mine = (j == x) ? c : mine; }
        if (sum == G) break;
        __builtin_amdgcn_s_sleep(1);
        if ((++sp & 255u) == 0u) { if (xb_ld(&bar[XB_TMO])) break; if (sp > XB_SPIN_CAP) { atomicAdd(&bar[XB_TMO], 1u); break; } }
    }
    nloc = mine > 0u ? mine : 1u; nx = cnt > 0u ? cnt : 1u;
}

__device__ __forceinline__ void xcd_barrier(const XcdBarrier& b) {
    asm volatile("s_waitcnt vmcnt(0)" ::: "memory");
    __syncthreads();
    if (threadIdx.x == 0) {
        unsigned* bar = b.bar;
        __builtin_amdgcn_s_waitcnt(0);
        unsigned nloc = b.st[0], nx = b.st[1];
        if (nloc == 0u) { xcd_barrier_complete(bar, b.x, nloc, nx); b.st[0] = nloc; b.st[1] = nx; }
        const unsigned old = xb_add(&bar[XB_XSUB(b.x)], 1u);
        const unsigned gen = old / nloc;
        if (old + 1u == (gen + 1u) * nloc) {
            __builtin_amdgcn_fence(__ATOMIC_RELEASE, "agent");
            asm volatile("s_waitcnt vmcnt(0)" ::: "memory");
            const unsigned og = xb_add(&bar[XB_TOP], 1u);
            const unsigned tg = og / nx;
            if (og + 1u == (tg + 1u) * nx) xb_add(&bar[XB_TOPGEN], 1u);
            else XB_SPIN(xb_ld(&bar[XB_TOPGEN]) == tg, bar);
            __builtin_amdgcn_fence(__ATOMIC_ACQUIRE, "agent");
            xb_add(&bar[XB_XGEN(b.x)], 1u);
            asm volatile("s_waitcnt vmcnt(0)" ::: "memory");
        } else {
            XB_SPIN(xb_ld(&bar[XB_XGEN(b.x)]) == gen, bar);
            __builtin_amdgcn_fence(__ATOMIC_ACQUIRE, "agent");
            asm volatile("s_waitcnt vmcnt(0)" ::: "memory");
        }
    }
    __syncthreads();
}
constexpr int NWAVES = 8, NTHR = 512;
constexpr int BATCH = 2, SEQ = 8192, DM = 1024, M = BATCH * SEQ, DEPTH = 4;
constexpr int W_AB = 3672, W_CD = 3080, FFD = 2816, FFE = 3584, NEXP = 8;
constexpr int NAB = 3840, NCD = 3072;
constexpr float ALPHA = 1.6817928305074290f, LN_EPS = 1e-5f;
constexpr int MOE_ROWS = 34816;
constexpr size_t MiB = 1u << 20;
constexpr size_t WS_CTL = 0, CTL_ZERO_BYTES = 1 * MiB;
constexpr size_t WS_X = 1 * MiB, WS_XB = 65 * MiB, WS_MIX = 97 * MiB, WS_Y = 129 * MiB, WS_ACT = 161 * MiB;
constexpr size_t WS_EVW = 289 * MiB, EV_WAB = 0, EV_WO = 8 * MiB, EV_W13 = 10 * MiB, EV_W2 = 21 * MiB;
constexpr size_t WS_MASK = 317 * MiB;
constexpr size_t WS_MISC = 349 * MiB, MI_FL = 0, MI_RTE = 1 * MiB, MI_RTR1 = MI_RTE + 65536, MI_RTR2 = MI_RTR1 + 65536, MI_RTG = MI_RTR2 + 65536, MI_ROW1 = MI_RTG + 131072, MI_ROW2 = MI_ROW1 + 65536, MI_SLC = MI_ROW2 + 65536  ;
constexpr size_t WS_BIG = 353 * MiB;
constexpr size_t BG_WCD = 0, BG_WOD = 6 * MiB, BG_W13M = 8 * MiB, BG_W2M = 120 * MiB, BG_H = 176 * MiB, BG_XG = 414 * MiB, BG_END = 482 * MiB;
constexpr size_t BG_SC = 176 * MiB;
constexpr size_t BG_DS = BG_END, BG_DEC = BG_END + 32 * MiB, BG_QS = 434 * MiB, BG_SP = 442 * MiB;
constexpr size_t WS_END = WS_BIG + BG_END + 33 * MiB;
constexpr size_t SCB = (size_t)4096 * 128 * 129 / 2;
static_assert(BG_SC + 2 * SCB * 4 <= BG_END, "scores fit");
constexpr int CW_TMO = 0, CW_BAR = 4096, CW_Q = 8192, CW_CNT = 12288;
constexpr int RING_BYTES = 131072;
constexpr int LDSCTL_OFF = RING_BYTES, MISC_OFF = LDSCTL_OFF + 320;
constexpr int LDS_BYTES = 147456;
struct Frame {
    LAS unsigned char* lds;
    volatile LAS unsigned* MISC;
    gu32* ctl;
    unsigned char* ws;
    int tid, lane, wave;
    int vcu, G;
};
__device__ __forceinline__ int sel8i(int e, int a0, int a1, int a2, int a3, int a4, int a5, int a6, int a7) {
    int r = a0; r = e == 1 ? a1 : r; r = e == 2 ? a2 : r; r = e == 3 ? a3 : r; r = e == 4 ? a4 : r; r = e == 5 ? a5 : r; r = e == 6 ? a6 : r; r = e == 7 ? a7 : r; return r; }
__device__ __forceinline__ float sel8f(int e, const float (&a)[8]) {
    float r = a[0]; r = e == 1 ? a[1] : r; r = e == 2 ? a[2] : r; r = e == 3 ? a[3] : r; r = e == 4 ? a[4] : r; r = e == 5 ? a[5] : r; r = e == 6 ? a[6] : r; r = e == 7 ? a[7] : r; return r; }
__device__ __forceinline__ int q_issue(Frame& F, gu32* head) { unsigned v = 0u; if (F.tid == 0) v = __hip_atomic_fetch_add(head, 1u, RLX_AGENT); return (int)v; }
__device__ __forceinline__ int q_share(Frame& F, int v) {
    volatile LAS int* slot = (volatile LAS int*)(F.lds + LDSCTL_OFF + 64);
    WG_BAR();
    if (F.tid == 0) *slot = v;
    WG_BAR();
    return *slot;
}
__device__ __forceinline__ void conv_item(const float* __restrict__ W, int ldw, int k0, int sc4, bf16* WT, int ldt, int drow0, LAS unsigned* P, int lane) {
    const int n4 = (lane & 15) * 4, kq = lane >> 4;
    f32x4 a[8], b[8];
    if (sc4 >= 0) {
#pragma unroll
        for (int i = 0; i < 8; ++i) { const float* p = W + (size_t)(k0 + 8 * i + 2 * kq) * ldw + sc4; a[i] = *(const GAS f32x4*)p; b[i] = *(const GAS f32x4*)(p + ldw); }
    } else {
#pragma unroll
        for (int i = 0; i < 8; ++i) { a[i] = (f32x4){0.f, 0.f, 0.f, 0.f}; b[i] = a[i]; }
    }
#pragma unroll
    for (int i = 0; i < 8; ++i) { v4u w; w.x = pk2(a[i].x, b[i].x); w.y = pk2(a[i].y, b[i].y); w.z = pk2(a[i].z, b[i].z); w.w = pk2(a[i].w, b[i].w);
        *(LAS v4u*)(P + (4 * i + kq) * 68 + n4) = w; }
    LDS_WAIT();
#pragma unroll
    for (int j = 0; j < 8; ++j) { const int ch = j * 64 + lane, n = ch >> 3, c = ch & 7; const LAS unsigned* s = P + (4 * c) * 68 + n;
        v4u o; o.x = s[0]; o.y = s[68]; o.z = s[136]; o.w = s[204];
        *(GAS v4u*)(WT + (size_t)(drow0 + n) * ldt + k0 + 8 * c) = o; }
    LDS_WAIT();
}
__device__ __forceinline__ void conv_matrix(Frame& F, int kind, const float* W, const float* W3, int ldw, int K, bf16* WT, int nrows) {
    LAS unsigned* scr = (LAS unsigned*)(F.lds + F.wave * 8704);
    const int gw = F.vcu * NWAVES + F.wave, NGW = F.G * NWAVES;
    const int ngrp = nrows / 64, nkb = K / 64, nitems = ngrp * nkb;
    for (int it = gw; it < nitems; it += NGW) {
        const int grp = it % ngrp, kb = it / ngrp; const int r = grp * 64 + (F.lane & 15) * 4;
        int sc = r; const float* src = W;
        if (kind == 1) { sc = r < 1536 ? r : (r < 3584 ? r + 16 : (r < 3600 ? 1536 + (r - 3584) : (r < 3672 ? r : -1))); }
        else if (kind == 2) { sc = r < 1536 ? r : r + 8; }
        else if (kind == 3) { const int j = r >> 8, w = r & 255; sc = 128 * j + (w & 127); src = (w < 128) ? W : W3; }
        conv_item(src, ldw, kb * 64, sc, WT, K, grp * 64, scr, F.lane);
    }
}
__device__ __forceinline__ void conv_odd_item(Frame& F, int lane_, int idx, const float* w1m, const float* w3m, const float* w2m, const float* wcd, const float* wod, unsigned char* big) {
    LAS unsigned* scr = (LAS unsigned*)(F.lds + F.wave * 8704);
    const int l4 = (lane_ & 15) * 4;
    if (idx < 14336) { const int e = idx / 1792, it = idx % 1792, grp = it % 112, kb = it / 112; const int r = grp * 64 + l4; const int jj = r >> 8, w = r & 255;
        const size_t eo = (size_t)e * DM * FFE;
        conv_item((w < 128 ? w1m : w3m) + eo, FFE, kb * 64, 128 * jj + (w & 127), (bf16*)(big + BG_W13M) + (size_t)e * 2 * FFE * DM, DM, grp * 64, scr, lane_); }
    else if (idx < 21504) { const int i2 = idx - 14336, e = i2 / 896, it = i2 % 896, grp = it % 16, kb = it / 16;
        conv_item(w2m + (size_t)e * DM * FFE, DM, kb * 64, grp * 64 + l4, (bf16*)(big + BG_W2M) + (size_t)e * DM * FFE, FFE, grp * 64, scr, lane_); }
    else if (idx < 22272) { const int it = idx - 21504, grp = it % 48, kb = it / 48; const int r = grp * 64 + l4;
        conv_item(wcd, W_CD, kb * 64, r < 1536 ? r : r + 8, (bf16*)(big + BG_WCD), DM, grp * 64, scr, lane_); }
    else { const int it = idx - 22272, grp = it % 16, kb = it / 16;
        conv_item(wod, DM, kb * 64, grp * 64 + l4, (bf16*)(big + BG_WOD), DM, grp * 64, scr, lane_); }
}
__device__ __forceinline__ void conv_even_item(Frame& F, int lane_, int idx, const float* wab, const float* wo, const float* w1, const float* w3, const float* w2, unsigned char* evw) {
    LAS unsigned* scr = (LAS unsigned*)(F.lds + F.wave * 8704);
    const int l4 = (lane_ & 15) * 4;
    if (idx < 960) { const int grp = idx % 60, kb = idx / 60; const int r = grp * 64 + l4;
        const int sc = r < 1536 ? r : (r < 3584 ? r + 16 : (r < 3600 ? 1536 + (r - 3584) : (r < 3672 ? r : -1)));
        conv_item(wab, W_AB, kb * 64, sc, (bf16*)(evw + EV_WAB), DM, grp * 64, scr, lane_); }
    else if (idx < 1216) { const int it = idx - 960, grp = it % 16, kb = it / 16;
        conv_item(wo, DM, kb * 64, grp * 64 + l4, (bf16*)(evw + EV_WO), DM, grp * 64, scr, lane_); }
    else if (idx < 2624) { const int it = idx - 1216, grp = it % 88, kb = it / 88; const int r = grp * 64 + l4; const int jj = r >> 8, w = r & 255;
        conv_item(w < 128 ? w1 : w3, FFD, kb * 64, 128 * jj + (w & 127), (bf16*)(evw + EV_W13), DM, grp * 64, scr, lane_); }
    else if (idx < 3328) { const int it = idx - 2624, grp = it % 16, kb = it / 16;
        conv_item(w2, DM, kb * 64, grp * 64 + l4, (bf16*)(evw + EV_W2), FFD, grp * 64, scr, lane_); }
}
__device__ __forceinline__ void rows_to_bf16(Frame& F, const float* x, bf16* xb) {
    const int gw = F.vcu * NWAVES + F.wave, NGW = F.G * NWAVES;
    for (int m = gw; m < M; m += NGW) {
        const GAS f32x4* xr = (const GAS f32x4*)(x + (size_t)m * DM) + F.lane; GAS v2u* o = (GAS v2u*)(xb + (size_t)m * DM) + F.lane;
#pragma unroll
        for (int j = 0; j < 4; ++j) { const f32x4 v = xr[64 * j]; v2u w; w.x = pk2(v.x, v.y); w.y = pk2(v.z, v.w); o[64 * j] = w; }
    }
}
__device__ __forceinline__ void ln_phase(Frame& F, const float* xres, const bf16* Y, int ymode, const float* g, const float* bvec, float* xout, bf16* xbout,
                                         int proj, const float* pw, const float* pb, gu32* cnt) {
    LAS float* W8 = (LAS float*)(F.lds);
    volatile LAS int* tokE = (volatile LAS int*)(F.lds + 32768);
    const int* row1 = (const int*)(F.ws + WS_MISC + MI_ROW1); const int* row2 = (const int*)(F.ws + WS_MISC + MI_ROW2);
    float* rtg = (float*)(F.ws + WS_MISC + MI_RTG); int* rte = (int*)(F.ws + WS_MISC + MI_RTE); int* rtr1 = (int*)(F.ws + WS_MISC + MI_RTR1); int* rtr2 = (int*)(F.ws + WS_MISC + MI_RTR2);
    float* fl = (float*)(F.ws + WS_MISC + MI_FL);
    if (proj != 0) { for (int i8 = F.tid; i8 < 8192; i8 += NTHR) { const int i = i8 >> 3, e = i8 & 7; const float w = (proj == 1) ? pw[i8] : pw[(size_t)i * W_CD + 1536 + e];
            const int slot = (4 * (i >> 8) + (i & 3)) * 64 + ((i & 255) >> 2); W8[(e >> 2) * 4096 + slot * 4 + (e & 3)] = w; } }
    WG_BAR();
    const int lane = F.lane;
    for (int slab = blockIdx.x; slab < M / 64; slab += F.G) {
        const int mw = slab * 64 + F.wave * 8;
        int r1v = 0, r2v = 0; float g1v = 0.f, g2v = 0.f;
        if (ymode != 0) { const int mm = mw + (lane & 7); r1v = row1[mm]; r2v = row2[mm]; g1v = rtg[2 * mm]; g2v = rtg[2 * mm + 1]; }
        f32x4 xn[4]; v2u an[4], cn[4];
#define LN_LOAD(rr_) do { const int m_ = mw + (rr_); const GAS f32x4* xr_ = (const GAS f32x4*)(xres + (size_t)m_ * DM) + lane; \
            if (ymode == 0) { const GAS v2u* yr_ = (const GAS v2u*)(Y + (size_t)m_ * DM) + lane; \
                _Pragma("unroll") for (int j = 0; j < 4; ++j) { xn[j] = xr_[64 * j]; an[j] = yr_[64 * j]; cn[j] = (v2u){0u, 0u}; } } \
            else { const int r1_ = __shfl(r1v, (rr_)), r2_ = __shfl(r2v, (rr_)); const GAS v2u* y1_ = (const GAS v2u*)(Y + (size_t)r1_ * DM) + lane; const GAS v2u* y2_ = (const GAS v2u*)(Y + (size_t)r2_ * DM) + lane; \
                _Pragma("unroll") for (int j = 0; j < 4; ++j) { xn[j] = xr_[64 * j]; an[j] = y1_[64 * j]; cn[j] = y2_[64 * j]; } } } while (0)
        LN_LOAD(0);
        for (int rr = 0; rr < 8; ++rr) {
            const int m = mw + rr;
            f32x4 xc[4]; v2u ac[4], cc[4];
#pragma unroll
            for (int j = 0; j < 4; ++j) { xc[j] = xn[j]; ac[j] = an[j]; cc[j] = cn[j]; }
            if (rr + 1 < 8) LN_LOAD(rr + 1);
            f32x4 v[4];
            if (ymode == 0) {
#pragma unroll
                for (int j = 0; j < 4; ++j) { const f32x4 xv = xc[j]; const v2u yw = ac[j];
                    v[j].x = ALPHA * xv.x + bflo(yw.x); v[j].y = ALPHA * xv.y + bfhi(yw.x); v[j].z = ALPHA * xv.z + bflo(yw.y); v[j].w = ALPHA * xv.w + bfhi(yw.y); }
            } else {
                const float g1 = __shfl(g1v, rr), g2 = __shfl(g2v, rr);
#pragma unroll
                for (int j = 0; j < 4; ++j) { const f32x4 xv = xc[j]; const v2u a = ac[j], c = cc[j];
                    v[j].x = ALPHA * xv.x + (g1 * bflo(a.x) + g2 * bflo(c.x)); v[j].y = ALPHA * xv.y + (g1 * bfhi(a.x) + g2 * bfhi(c.x));
                    v[j].z = ALPHA * xv.z + (g1 * bflo(a.y) + g2 * bflo(c.y)); v[j].w = ALPHA * xv.w + (g1 * bfhi(a.y) + g2 * bfhi(c.y)); }
            }
            float s = 0.f;
#pragma unroll
            for (int j = 0; j < 4; ++j) s += (v[j].x + v[j].y) + (v[j].z + v[j].w);
            const float mean = wave_sum(s) * (1.f / DM); float s2 = 0.f;
#pragma unroll
            for (int j = 0; j < 4; ++j) { v[j] = v[j] - mean; s2 += (v[j].x * v[j].x + v[j].y * v[j].y) + (v[j].z * v[j].z + v[j].w * v[j].w); }
            const float rstd = 1.f / sqrtf(wave_sum(s2) * (1.f / DM) + LN_EPS);
            GAS f32x4* xo = (GAS f32x4*)(xout + (size_t)m * DM) + lane; GAS v2u* bo = (GAS v2u*)(xbout + (size_t)m * DM) + lane;
#pragma unroll
            for (int j = 0; j < 4; ++j) { const f32x4 gg = ((const GAS f32x4*)g)[lane + 64 * j], bb = ((const GAS f32x4*)bvec)[lane + 64 * j];
                v[j] = v[j] * rstd * gg + bb; xo[64 * j] = v[j]; v2u w; w.x = pk2(v[j].x, v[j].y); w.y = pk2(v[j].z, v[j].w); bo[64 * j] = w; }
            if (proj != 0) {
                float a8[8];
#pragma unroll
                for (int e = 0; e < 8; ++e) a8[e] = 0.f;
#pragma unroll
                for (int j = 0; j < 4; ++j)
#pragma unroll
                    for (int c = 0; c < 4; ++c) { const int slot = (4 * j + c) * 64 + lane; const f32x4 w0 = *(const LAS f32x4*)(W8 + slot * 4), w1 = *(const LAS f32x4*)(W8 + 4096 + slot * 4); const float xv = v[j][c];
                        a8[0] += xv * w0.x; a8[1] += xv * w0.y; a8[2] += xv * w0.z; a8[3] += xv * w0.w; a8[4] += xv * w1.x; a8[5] += xv * w1.y; a8[6] += xv * w1.z; a8[7] += xv * w1.w; }
#pragma unroll
                for (int e = 0; e < 8; ++e) a8[e] = wave_sum(a8[e]);
                if (proj == 2) {
                    const int e8 = lane & 7; float z = a8[0]; z = e8 == 1 ? a8[1] : z; z = e8 == 2 ? a8[2] : z; z = e8 == 3 ? a8[3] : z; z = e8 == 4 ? a8[4] : z; z = e8 == 5 ? a8[5] : z; z = e8 == 6 ? a8[6] : z; z = e8 == 7 ? a8[7] : z; z += pb[e8];
                    if (lane < 8) fl[(size_t)m * 8 + lane] = log_sigmoid(z);
                } else {
                    int e1 = 0; float v1 = a8[0];
#pragma unroll
                    for (int e = 1; e < 8; ++e) if (a8[e] > v1) { v1 = a8[e]; e1 = e; }
                    int e2 = -1; float v2 = -INFINITY;
#pragma unroll
                    for (int e = 0; e < 8; ++e) if (e != e1 && (e2 < 0 || a8[e] > v2)) { v2 = a8[e]; e2 = e; }
                    const float ex = __expf(v2 - v1); const float g1 = 1.f / (1.f + ex), g2 = ex / (1.f + ex);
                    if (lane == 0) { rtg[2 * m] = g1; rtg[2 * m + 1] = g2; tokE[F.wave * 8 + rr] = e1 | (e2 << 8); }
                }
            }
        }
        if (proj == 1) {
            LDS_BAR();
            if (F.wave == 0) {
                const int ee = tokE[lane]; const int e1 = ee & 255, e2 = ee >> 8; int r1 = 0, r2 = 0;
                const unsigned long long lt = (1ull << lane) - 1ull;
                int mycnt = 0, p1 = 0, p2 = 0;
#pragma unroll
                for (int e = 0; e < 8; ++e) {
                    const unsigned long long b1 = __ballot(e1 == e), b2 = __ballot(e2 == e);
                    const int c = __popcll(b1) + __popcll(b2), pos = __popcll(b1 & lt) + __popcll(b2 & lt);
                    mycnt = (lane == e) ? c : mycnt; p1 = (e1 == e) ? pos : p1; p2 = (e2 == e) ? pos : p2;
                }
                if (lane < 8) ((int*)(F.ws + WS_MISC + MI_SLC))[slab * 8 + lane] = mycnt;
                r1 = p1; r2 = p2;
                const int m = slab * 64 + lane; rte[m] = ee; rtr1[m] = r1; rtr2[m] = r2;
            }
            LDS_BAR();
        }
    }
}
#undef LN_LOAD
__device__ __forceinline__ void moe_tiles(const gu32* cnt, int (&ts)[9]) {
    ts[0] = 0;
#pragma unroll
    for (int e = 0; e < 8; ++e) { const int c = (int)__hip_atomic_load(cnt + 64 * e, RLX_AGENT); ts[e + 1] = ts[e] + ((c + 255) >> 8); }
}
__device__ __forceinline__ void scatter_phase(Frame& F, const bf16* xb, bf16* xg, gu32* cnt) {
    LAS int* base = (LAS int*)(F.lds); LAS int* wtot = (LAS int*)(F.lds + 8192);
    const int* slc = (const int*)(F.ws + WS_MISC + MI_SLC);
    { const int e = F.tid & 7, sg = F.tid >> 3;
      int c0 = slc[(4 * sg + 0) * 8 + e], c1 = slc[(4 * sg + 1) * 8 + e], c2 = slc[(4 * sg + 2) * 8 + e], c3 = slc[(4 * sg + 3) * 8 + e];
      int incl = c0 + c1 + c2 + c3; const int own = incl;
#pragma unroll
      for (int o = 8; o < 64; o <<= 1) { const int t = __shfl_up(incl, o); if (F.lane >= o) incl += t; }
      if (F.lane >= 56) wtot[F.wave * 8 + e] = incl;
      LDS_BAR();
      int pre = incl - own;
#pragma unroll
      for (int w = 0; w < 8; ++w) if (w < F.wave) pre += wtot[w * 8 + e];
      base[(4 * sg + 0) * 8 + e] = pre; base[(4 * sg + 1) * 8 + e] = pre + c0; base[(4 * sg + 2) * 8 + e] = pre + c0 + c1; base[(4 * sg + 3) * 8 + e] = pre + c0 + c1 + c2;
      LDS_BAR(); }
    int ts[9]; ts[0] = 0;
#pragma unroll
    for (int e = 0; e < 8; ++e) { int tot = 0;
#pragma unroll
        for (int w = 0; w < 8; ++w) tot += wtot[w * 8 + e];
        ts[e + 1] = ts[e] + ((tot + 255) >> 8);
        if (blockIdx.x == 0 && F.tid == 0) __hip_atomic_store(cnt + 64 * e, (unsigned)tot, RLX_AGENT); }
    const int* rte = (const int*)(F.ws + WS_MISC + MI_RTE); const int* rtr1 = (const int*)(F.ws + WS_MISC + MI_RTR1); const int* rtr2 = (const int*)(F.ws + WS_MISC + MI_RTR2);
    int* row1 = (int*)(F.ws + WS_MISC + MI_ROW1); int* row2 = (int*)(F.ws + WS_MISC + MI_ROW2);
    const int gw = F.vcu * NWAVES + F.wave, NGW = F.G * NWAVES;
    for (int m = gw; m < M; m += NGW) {
        const int ee = rte[m]; const int e1 = ee & 255, e2 = ee >> 8; const int slab = m >> 6;
        const int ra = 256 * sel8i(e1, ts[0], ts[1], ts[2], ts[3], ts[4], ts[5], ts[6], ts[7]) + base[slab * 8 + e1] + rtr1[m];
        const int rb = 256 * sel8i(e2, ts[0], ts[1], ts[2], ts[3], ts[4], ts[5], ts[6], ts[7]) + base[slab * 8 + e2] + rtr2[m];
        const GAS v4u* src = (const GAS v4u*)(xb + (size_t)m * DM) + F.lane;
        const v4u a = src[0], b = src[64];
        GAS v4u* d1 = (GAS v4u*)(xg + (size_t)ra * DM) + F.lane; GAS v4u* d2 = (GAS v4u*)(xg + (size_t)rb * DM) + F.lane;
        d1[0] = a; d1[64] = b; d2[0] = a; d2[64] = b;
        if (F.lane == 0) { row1[m] = ra; row2[m] = rb; }
    }
}
namespace att {
constexpr int SLOTB = 8192, NSLOT = 3;
constexpr int L_K = 0, L_V = NSLOT * SLOTB, L_WS = 2 * NSLOT * SLOTB, L_OST = L_WS + 8 * 256, L_END = L_OST + 8 * 4096;
constexpr int L_WMIN = L_END;
constexpr int L_TAB = L_END + 64;
constexpr int PITCH = 512;
__device__ __forceinline__ int crow(int r, int hi) { return (r & 3) + 8 * (r >> 2) + 4 * hi; }
__device__ __forceinline__ void glds16(const void* gsrc, unsigned lds_dst) { unsigned keep;
    asm volatile("s_mov_b32 %0, m0\n\ts_mov_b32 m0, %2\n\ts_nop 0\n\tglobal_load_lds_dwordx4 %1, off\n\ts_mov_b32 m0, %0" : "=&s"(keep) : "v"(gsrc), "s"(lds_dst) : "memory"); }
__device__ __forceinline__ float max3f(float a, float b, float c) { return __builtin_fmaxf(__builtin_fmaxf(a, b), c); }
typedef __bf16 bf16x2_t __attribute__((ext_vector_type(2)));
__device__ __forceinline__ unsigned cvtpk_s(float lo, float hi) { f32x2 v = {lo, hi}; bf16x2_t b = __builtin_convertvector(v, bf16x2_t); return __builtin_bit_cast(unsigned, b); }
#define ATT_WAIT_BAR(N) asm volatile("s_waitcnt vmcnt(" #N ") lgkmcnt(0)\n\ts_barrier" ::: "memory")
__device__ __forceinline__ void qkt(f32x16& p0, f32x16& p1, const LAS unsigned char* Kslot, const bf16x8* qr, int r32, int hi) {
    const LAS unsigned char* kb = Kslot + hi * 1024 + r32 * 16;
    const f32x16 z = {};
    bf16x8 kf[8];
#pragma unroll
    for (int d0 = 0; d0 < 4; ++d0) { kf[2 * d0] = *(const LAS bf16x8*)(kb + d0 * 2048); kf[2 * d0 + 1] = *(const LAS bf16x8*)(kb + d0 * 2048 + 512); }
    __builtin_amdgcn_sched_barrier(0);
    p0 = __builtin_amdgcn_mfma_f32_32x32x16_bf16(kf[0], qr[0], z, 0, 0, 0); p1 = __builtin_amdgcn_mfma_f32_32x32x16_bf16(kf[1], qr[0], z, 0, 0, 0);
#pragma unroll
    for (int d0 = 1; d0 < 4; ++d0) { p0 = __builtin_amdgcn_mfma_f32_32x32x16_bf16(kf[2 * d0], qr[d0], p0, 0, 0, 0); p1 = __builtin_amdgcn_mfma_f32_32x32x16_bf16(kf[2 * d0 + 1], qr[d0], p1, 0, 0, 0); }
}
__device__ __forceinline__ float rowmax(const f32x16& p0, const f32x16& p1) {
    float a = max3f(p0[0], p0[1], p1[0]), b = max3f(p0[2], p0[3], p1[1]); a = max3f(a, p1[2], p1[3]);
#pragma unroll
    for (int r = 4; r < 16; r += 4) { a = max3f(a, p0[r], p0[r + 1]); b = max3f(b, p0[r + 2], p0[r + 3]); a = max3f(a, p1[r], p1[r + 1]); b = max3f(b, p1[r + 2], p1[r + 3]); }
    const float m = __builtin_fmaxf(a, b);
    auto rr = __builtin_amdgcn_permlane32_swap(__float_as_uint(m), __float_as_uint(m), false, false);
    return __builtin_fmaxf(__uint_as_float(rr[0]), __uint_as_float(rr[1]));
}
__device__ __forceinline__ void pv(f32x16* o, int vb, bf16x8 pa0, bf16x8 pa1, bf16x8 pa2, bf16x8 pa3) {
#pragma unroll
    for (int d0 = 0; d0 < 2; ++d0) { s16x4 lo[4], hi[4];
#pragma unroll
        for (int ks = 0; ks < 4; ++ks) {
            asm volatile("ds_read_b64_tr_b16 %0,%1 offset:%c2" : "=&v"(lo[ks]) : "v"(vb), "i"(d0 * 4096 + ks * 1024) : "memory");
            asm volatile("ds_read_b64_tr_b16 %0,%1 offset:%c2" : "=&v"(hi[ks]) : "v"(vb), "i"(d0 * 4096 + ks * 1024 + 512) : "memory"); }
        asm volatile("s_waitcnt lgkmcnt(0)" ::: "memory"); __builtin_amdgcn_sched_barrier(0);
#define ATT_PK(k) (bf16x8){lo[k][0], lo[k][1], lo[k][2], lo[k][3], hi[k][0], hi[k][1], hi[k][2], hi[k][3]}
        o[d0] = __builtin_amdgcn_mfma_f32_32x32x16_bf16(pa0, ATT_PK(0), o[d0], 0, 0, 0);
        o[d0] = __builtin_amdgcn_mfma_f32_32x32x16_bf16(pa1, ATT_PK(1), o[d0], 0, 0, 0);
        o[d0] = __builtin_amdgcn_mfma_f32_32x32x16_bf16(pa2, ATT_PK(2), o[d0], 0, 0, 0);
        o[d0] = __builtin_amdgcn_mfma_f32_32x32x16_bf16(pa3, ATT_PK(3), o[d0], 0, 0, 0);
#undef ATT_PK
    }
}
typedef __attribute__((address_space(3))) const char* lds_cptr;
typedef short v4i16_t __attribute__((ext_vector_type(4)));
__device__ __forceinline__ void kload2(bf16x8* kf, lds_cptr kp, int j) { kf[2 * j] = *(const LAS bf16x8*)(kp + j * 2048); kf[2 * j + 1] = *(const LAS bf16x8*)(kp + j * 2048 + 512); }
__device__ __forceinline__ s16x4 vtr(lds_cptr p) { return __builtin_bit_cast(s16x4, __builtin_amdgcn_ds_read_tr16_b64_v4i16((LAS v4i16_t*)p)); }
#define SBAR() __builtin_amdgcn_sched_barrier(0)
#define PIN(x) asm volatile("" : "+v"(x))
#define MFMA(a, b, c) __builtin_amdgcn_mfma_f32_32x32x16_bf16(a, b, c, 0, 0, 0)
template <class Hook>
__device__ __forceinline__ void attn_unit(Hook& hk, const bf16* Qh, const bf16* Kh, const bf16* Vh, bf16* Oh, long qrow0, int NT, LAS unsigned char* shm, int opitch) {
    int tid_ = threadIdx.x; asm volatile("" : "+v"(tid_)); const int tid = tid_, lane = tid & 63, r32 = lane & 31, hi = lane >> 5; const int wid = __builtin_amdgcn_readfirstlane(tid >> 6);
    const unsigned lds0 = (unsigned)(size_t)shm;
    LAS float* wsf = (LAS float*)(shm + L_WS) + wid * 64;
    const bf16* Qw = Qh + (qrow0 + wid * 32) * PITCH;
    const bf16* ksrc = Kh + (long)lane * PITCH + wid * 8;
    const bf16* vsrc = Vh + (long)(16 * (wid & 3) + (lane >> 2)) * PITCH + (wid >> 2) * 32 + (lane & 3) * 8;
    const unsigned kdst = lds0 + L_K + wid * 1024, vdst = lds0 + L_V + wid * 1024;
#define DMA_K(t, slot) glds16(ksrc + hk.tile_row(t) * PITCH, (unsigned)__builtin_amdgcn_readfirstlane(kdst + (slot)))
#define DMA_V(t, slot) glds16(vsrc + hk.tile_row(t) * PITCH, (unsigned)__builtin_amdgcn_readfirstlane(vdst + (slot)))
    const lds_cptr vp0 = (lds_cptr)shm + L_V + ((lane >> 4) & 1) * 32 + (lane & 3) * 8 + (4 * hi + ((lane & 15) >> 2)) * 64;
    const lds_cptr kp0 = (lds_cptr)shm + L_K + hi * 1024 + r32 * 16;
    DMA_K(0, 0); DMA_V(0, 0); DMA_K(1, SLOTB);
    bf16x8 qr[4];
#pragma unroll
    for (int d0 = 0; d0 < 4; ++d0) qr[d0] = *(const bf16x8*)(Qw + (long)r32 * PITCH + d0 * 16 + hi * 8);
    float mhat = 0.f, l_reg = 0.f; f32x16 o[2]; o[0] = f32x16{}; o[1] = f32x16{};
    f32x16 negm = f32x16{}; PIN(negm);
    bool resc = false;
    f32x16 pA0, pA1, pB0, pB1; bf16x8 kf[8]; s16x4 vlo[8], vhi[8]; v4u pw0, pw1, pw2, pw3;
    int sl_prev = 0, sl_cur = 0, sl_next = SLOTB;
#define ROT() do { sl_prev = sl_cur; sl_cur = sl_next; sl_next = (sl_next == 2 * SLOTB) ? 0 : sl_next + SLOTB; } while (0)
#define EX(v) __builtin_amdgcn_exp2f(v)
#define RESC() do { if (resc) { _Pragma("unroll") for (int d_ = 0; d_ < 2; ++d_) _Pragma("unroll") for (int r = 0; r < 16; ++r) o[d_][r] *= wsf[crow(r, hi)]; } } while (0)
    DMA_K(2, 2 * SLOTB);
    hk.prefetch(0, wid);
    ATT_WAIT_BAR(3);
    _Pragma("unroll") for (int d0 = 0; d0 < 4; ++d0) kload2(kf, kp0, d0);
    pA0 = MFMA(kf[0], qr[0], negm); pA1 = MFMA(kf[1], qr[0], negm); pA0 = MFMA(kf[2], qr[1], pA0); pA1 = MFMA(kf[3], qr[1], pA1);
    pA0 = MFMA(kf[4], qr[2], pA0); pA1 = MFMA(kf[5], qr[2], pA1); pA0 = MFMA(kf[6], qr[3], pA0); pA1 = MFMA(kf[7], qr[3], pA1);
    hk.apply(pA0, pA1, 0, r32, hi, wid);
    { const float rm = rowmax(pA0, pA1); mhat = __builtin_fmaxf(rm, -1000.0f);
#pragma unroll
      for (int r = 0; r < 16; ++r) { pA0[r] = EX(pA0[r] - mhat); pA1[r] = EX(pA1[r] - mhat); negm[r] = -mhat; }
      PIN(negm); }
    hk.prefetch(1, wid);
    ATT_WAIT_BAR(0);
    DMA_K(3, 0); DMA_V(1, SLOTB); ROT();
    _Pragma("unroll") for (int d0 = 0; d0 < 4; ++d0) kload2(kf, kp0 + sl_cur, d0);
    ATT_WAIT_BAR(2);
#define PKW(P, i) cvtpk_s(P[i], P[i + 1])
#define PAF(k) __builtin_bit_cast(bf16x8, pw##k)
#define VFR(i) (bf16x8){vlo[i][0], vlo[i][1], vlo[i][2], vlo[i][3], vhi[i][0], vhi[i][1], vhi[i][2], vhi[i][3]}
#define VRD(i) do { vlo[i] = vtr(vp_ + (((i) >> 2) * 4096 + ((i) & 3) * 1024)); vhi[i] = vtr(vp_ + (((i) >> 2) * 4096 + ((i) & 3) * 1024 + 512)); } while (0)
#define KRD(G, d0) do { if (G) { kload2(kf, kp0 + sl_next, d0); SBAR(); } } while (0)
#define GAPA(MF, a0, a1, a2, a3, W0, W1, PW) do { MF; sacc += a0; sacc += a1; sacc += a2; sacc += a3; W0; W1; PIN(PW); PIN(sacc); SBAR(); } while (0)
#define GAPB(MF, X, i) do { MF; X[i] = EX(X[i]); X[i + 1] = EX(X[i + 1]); X[i + 2] = EX(X[i + 2]); X[i + 3] = EX(X[i + 3]); PIN(X); SBAR(); } while (0)
#define STEP(C0, C1, P0, P1, t, GK, GV, GL) do { SBAR(); \
    const lds_cptr vp_ = vp0 + sl_prev; \
    VRD(0); SBAR(); float sacc = P0[0] + P0[1]; \
                    GAPA(C0 = MFMA(kf[0], qr[0], negm), P0[2], P0[3], P0[4], P0[5],     pw0[0] = PKW(P0, 0),  pw0[1] = PKW(P0, 2),  pw0); \
    VRD(4); SBAR(); GAPA(C1 = MFMA(kf[1], qr[0], negm), P0[6], P0[7], P0[8], P0[9],     pw0[2] = PKW(P0, 4),  pw0[3] = PKW(P0, 6),  pw0); \
    VRD(1); SBAR(); GAPA(C0 = MFMA(kf[2], qr[1], C0),    P0[10], P0[11], P0[12], P0[13], pw1[0] = PKW(P0, 8),  pw1[1] = PKW(P0, 10), pw1); \
    VRD(5); SBAR(); GAPA(C1 = MFMA(kf[3], qr[1], C1),    P0[14], P0[15], P1[0], P1[1],   pw1[2] = PKW(P0, 12), pw1[3] = PKW(P0, 14), pw1); \
    VRD(2); SBAR(); GAPA(C0 = MFMA(kf[4], qr[2], C0),    P1[2], P1[3], P1[4], P1[5],     pw2[0] = PKW(P1, 0),  pw2[1] = PKW(P1, 2),  pw2); \
    VRD(6); SBAR(); GAPA(C1 = MFMA(kf[5], qr[2], C1),    P1[6], P1[7], P1[8], P1[9],     pw2[2] = PKW(P1, 4),  pw2[3] = PKW(P1, 6),  pw2); \
    VRD(3); SBAR(); GAPA(C0 = MFMA(kf[6], qr[3], C0),    P1[10], P1[11], P1[12], P1[13], pw3[0] = PKW(P1, 8),  pw3[1] = PKW(P1, 10), pw3); \
    VRD(7); SBAR(); GAPA(C1 = MFMA(kf[7], qr[3], C1),    P1[14], P1[15], 0.f, 0.f,       pw3[2] = PKW(P1, 12), pw3[3] = PKW(P1, 14), pw3); \
    l_reg += sacc; \
    if (GK) DMA_K((t) + 3, sl_cur); if (GV) DMA_V((t) + 1, sl_next); \
    hk.apply(C0, C1, (t), r32, hi, wid); \
    if ((t) + 1 < NT) hk.prefetch_issue((t) + 1, wid); \
    { const float rm = rowmax(C0, C1); resc = false; \
      if (__builtin_expect(__any(rm > 8.0f), 0)) { const float dl = __builtin_fmaxf(rm, 0.f); mhat += dl; \
          _Pragma("unroll") for (int r = 0; r < 16; ++r) { C0[r] -= dl; C1[r] -= dl; negm[r] = -mhat; } PIN(negm); \
          const float f = __builtin_amdgcn_exp2f(-dl); l_reg *= f; if (hi == 0) wsf[r32] = f; resc = true; } } \
    SBAR(); \
    GAPB(o[0] = MFMA(PAF(0), VFR(0), o[0]), C0, 0);              GAPB(o[1] = MFMA(PAF(0), VFR(4), o[1]), C0, 4); \
    KRD(GL, 0); GAPB(o[0] = MFMA(PAF(1), VFR(1), o[0]), C0, 8);  KRD(GL, 1); GAPB(o[1] = MFMA(PAF(1), VFR(5), o[1]), C0, 12); \
    KRD(GL, 2); GAPB(o[0] = MFMA(PAF(2), VFR(2), o[0]), C1, 0);  KRD(GL, 3); GAPB(o[1] = MFMA(PAF(2), VFR(6), o[1]), C1, 4); \
    GAPB(o[0] = MFMA(PAF(3), VFR(3), o[0]), C1, 8);              GAPB(o[1] = MFMA(PAF(3), VFR(7), o[1]), C1, 12); \
    if ((t) + 1 < NT) hk.prefetch_wait(); \
    } while (0)
    int t = 1;
    for (; t + 5 < NT; t += 2) {
        STEP(pB0, pB1, pA0, pA1, t, true, true, true);     ATT_WAIT_BAR(2); RESC(); ROT();
        STEP(pA0, pA1, pB0, pB1, t + 1, true, true, true);
        if constexpr (Hook::TRIM) {
            if ((t & 3) == 3) { float mw = mhat;
#pragma unroll
                for (int o_ = 1; o_ < 64; o_ <<= 1) mw = __builtin_fminf(mw, __shfl_xor(mw, o_));
                if (lane == 0) ((LAS float*)(shm + L_WMIN))[wid] = mw; } }
        ATT_WAIT_BAR(2); RESC(); ROT();
        if constexpr (Hook::TRIM) { if ((t & 3) == 3) NT = hk.eff_tiles(NT, (const LAS float*)(shm + L_WMIN), lane, t + 5); }
    }
#define ENDW(tt) do { if ((tt) + 3 < NT) { ATT_WAIT_BAR(2); } else if ((tt) + 2 < NT) { ATT_WAIT_BAR(1); } else { ATT_WAIT_BAR(0); } } while (0)
    for (; t + 1 < NT; t += 2) {
        STEP(pB0, pB1, pA0, pA1, t, (t + 3 < NT), (t + 1 < NT), (t + 1 < NT));         ENDW(t);     RESC(); ROT();
        STEP(pA0, pA1, pB0, pB1, t + 1, (t + 4 < NT), (t + 2 < NT), (t + 2 < NT));     ENDW(t + 1); RESC(); ROT();
    }
    STEP(pB0, pB1, pA0, pA1, NT - 1, false, false, false); RESC();
    { float sacc = pB0[0] + pB0[1];
#pragma unroll
      for (int r = 2; r < 16; ++r) sacc += pB0[r];
#pragma unroll
      for (int r = 0; r < 16; ++r) sacc += pB1[r];
      l_reg += sacc;
      pw0 = (v4u){PKW(pB0, 0), PKW(pB0, 2), PKW(pB0, 4), PKW(pB0, 6)}; pw1 = (v4u){PKW(pB0, 8), PKW(pB0, 10), PKW(pB0, 12), PKW(pB0, 14)};
      pw2 = (v4u){PKW(pB1, 0), PKW(pB1, 2), PKW(pB1, 4), PKW(pB1, 6)}; pw3 = (v4u){PKW(pB1, 8), PKW(pB1, 10), PKW(pB1, 12), PKW(pB1, 14)};
      const lds_cptr vp_ = vp0 + sl_cur; _Pragma("unroll") for (int i = 0; i < 8; ++i) VRD(i);
      o[0] = MFMA(PAF(0), VFR(0), o[0]); o[1] = MFMA(PAF(0), VFR(4), o[1]); o[0] = MFMA(PAF(1), VFR(1), o[0]); o[1] = MFMA(PAF(1), VFR(5), o[1]);
      o[0] = MFMA(PAF(2), VFR(2), o[0]); o[1] = MFMA(PAF(2), VFR(6), o[1]); o[0] = MFMA(PAF(3), VFR(3), o[0]); o[1] = MFMA(PAF(3), VFR(7), o[1]); }
    { auto rr = __builtin_amdgcn_permlane32_swap(__float_as_uint(l_reg), __float_as_uint(l_reg), false, false); l_reg = __uint_as_float(rr[0]) + __uint_as_float(rr[1]); }
    if (hi == 0) wsf[32 + r32] = l_reg;
    LDS_WAIT();
    float rli[16];
#pragma unroll
    for (int r = 0; r < 16; ++r) rli[r] = __builtin_amdgcn_rcpf(wsf[32 + crow(r, hi)]);
    bf16* Ow = Oh + (qrow0 + wid * 32) * opitch;
    { LAS bf16* stg = (LAS bf16*)(shm + L_OST) + wid * 2048;
#pragma unroll
        for (int r = 0; r < 16; ++r) { const int orow = crow(r, hi);
#pragma unroll
            for (int d0 = 0; d0 < 2; ++d0) stg[orow * 64 + d0 * 32 + r32] = (bf16)f2bf(o[d0][r] * rli[r]); }
        LDS_WAIT();
#pragma unroll
        for (int i = 0; i < 4; ++i) { const int row = i * 8 + (lane >> 3), ch = lane & 7; const v4u v = *(const LAS v4u*)(stg + row * 64 + ch * 8); *(v4u*)(Ow + (long)row * opitch + ch * 8) = v; } }
    asm volatile("s_waitcnt lgkmcnt(0)\n\ts_barrier" ::: "memory");
#undef DMA_K
#undef DMA_V
#undef ROT
#undef EX
#undef RESC
#undef PKW
#undef PAF
#undef VFR
#undef VRD
#undef KRD
#undef ENDW
#undef GAPA
#undef GAPB
#undef STEP
}
#undef SBAR
#undef PIN
#undef MFMA
template <class Hook>
__device__ __forceinline__ void attn_unit_pipe(Hook& hk, const bf16* Qh, const bf16* Kh, const bf16* Vh, bf16* Oh, long qrow0, int NT, LAS unsigned char* shm, int opitch) {
    int tid_ = threadIdx.x; asm volatile("" : "+v"(tid_)); const int tid = tid_, lane = tid & 63, r32 = lane & 31, hi = lane >> 5; const int wid = __builtin_amdgcn_readfirstlane(tid >> 6);
    const unsigned lds0 = (unsigned)(size_t)shm;
    LAS float* wsf = (LAS float*)(shm + L_WS) + wid * 64;
    volatile LAS float* wmin = (volatile LAS float*)(shm + L_WMIN);
    const bf16* Qw = Qh + (qrow0 + wid * 32) * PITCH;
    const bf16* ksrc = Kh + (long)lane * PITCH + wid * 8;
    const bf16* vsrc = Vh + (long)(16 * (wid & 3) + (lane >> 2)) * PITCH + (wid >> 2) * 32 + (lane & 3) * 8;
    const unsigned kdst = lds0 + L_K + wid * 1024, vdst = lds0 + L_V + wid * 1024;
#define ATT_DMAK(t, slot) glds16(ksrc + hk.tile_row(t) * PITCH, (unsigned)__builtin_amdgcn_readfirstlane(kdst + (slot)))
#define ATT_DMAV(t, slot) glds16(vsrc + hk.tile_row(t) * PITCH, (unsigned)__builtin_amdgcn_readfirstlane(vdst + (slot)))
    const int vb0 = (int)(lds0 + L_V) + ((lane >> 4) & 1) * 32 + (lane & 3) * 8 + (4 * hi + ((lane & 15) >> 2)) * 64;
    bf16x8 qr[4];
#pragma unroll
    for (int d0 = 0; d0 < 4; ++d0) qr[d0] = *(const bf16x8*)(Qw + (long)r32 * PITCH + d0 * 16 + hi * 8);
    ATT_DMAK(0, 0);
    if (NT > 1) ATT_DMAK(1, SLOTB);
    ATT_DMAV(0, 0);
    if (NT > 2) ATT_DMAK(2, 2 * SLOTB);
    if (NT > 1) ATT_DMAV(1, SLOTB);
    float mhat = -1e30f, l_reg = 0.f; f32x16 o[2]; o[0] = f32x16{}; o[1] = f32x16{};
    f32x16 pA0, pA1, pB0, pB1;
    if (NT > 2) { ATT_WAIT_BAR(4); } else { ATT_WAIT_BAR(0); }
    qkt(pA0, pA1, shm + L_K, qr, r32, hi);
    hk.prefetch(0, wid);
    int slc = 0, sln = SLOTB, sl2 = 2 * SLOTB;
#define ATT_ROT() do { const int t_ = slc; slc = sln; sln = sl2; sl2 = t_; } while (0)
#define ATT_STEP(C0, C1, N0, N1, t) do { \
        if ((t) + 2 < NT) { ATT_WAIT_BAR(2); } else if ((t) + 1 < NT) { ATT_WAIT_BAR(1); } else { ATT_WAIT_BAR(0); } \
        if (Hook::EARLY && (t) >= 4) { const int wb_ = (((t) - 1) & 1) * 8; \
            const float mm_ = __builtin_fminf(__builtin_fminf(__builtin_fminf(wmin[wb_ + 0], wmin[wb_ + 1]), __builtin_fminf(wmin[wb_ + 2], wmin[wb_ + 3])), \
                                              __builtin_fminf(__builtin_fminf(wmin[wb_ + 4], wmin[wb_ + 5]), __builtin_fminf(wmin[wb_ + 6], wmin[wb_ + 7]))); \
            if (hk.stop((t), mm_)) { asm volatile("s_waitcnt vmcnt(0)" ::: "memory"); goto att_done; } } \
        if ((t) + 3 < NT) ATT_DMAK((t) + 3, slc); \
        if ((t) + 2 < NT) ATT_DMAV((t) + 2, sl2); \
        __builtin_amdgcn_sched_barrier(0); \
        if ((t) + 1 < NT) qkt(N0, N1, shm + L_K + sln, qr, r32, hi); \
        __builtin_amdgcn_sched_barrier(0); \
        hk.apply(C0, C1, (t), r32, hi, wid); \
        if ((t) + 1 < NT) hk.prefetch_issue((t) + 1, wid); \
        { const float rm = rowmax(C0, C1); bool resc = false; \
          if (__any(rm > mhat + 8.0f)) { const float mn = __builtin_fmaxf(mhat, rm); const float f = __builtin_amdgcn_exp2f(mhat - mn); l_reg *= f; mhat = mn; if (hi == 0) wsf[r32] = f; resc = true; } \
          float sacc = 0.f; \
          _Pragma("unroll") for (int r = 0; r < 16; ++r) { C0[r] = __builtin_amdgcn_exp2f(C0[r] - mhat); C1[r] = __builtin_amdgcn_exp2f(C1[r] - mhat); sacc += C0[r] + C1[r]; } \
          l_reg += sacc; \
          if (Hook::EARLY) { float mw = mhat; \
              _Pragma("unroll") for (int o_ = 1; o_ < 64; o_ <<= 1) mw = __builtin_fminf(mw, __shfl_xor(mw, o_)); \
              if (lane == 0) wmin[((t) & 1) * 8 + wid] = mw; } \
          const v4u pw0 = (v4u){cvtpk_s(C0[0], C0[1]), cvtpk_s(C0[2], C0[3]), cvtpk_s(C0[4], C0[5]), cvtpk_s(C0[6], C0[7])}; \
          const v4u pw1 = (v4u){cvtpk_s(C0[8], C0[9]), cvtpk_s(C0[10], C0[11]), cvtpk_s(C0[12], C0[13]), cvtpk_s(C0[14], C0[15])}; \
          const v4u pw2 = (v4u){cvtpk_s(C1[0], C1[1]), cvtpk_s(C1[2], C1[3]), cvtpk_s(C1[4], C1[5]), cvtpk_s(C1[6], C1[7])}; \
          const v4u pw3 = (v4u){cvtpk_s(C1[8], C1[9]), cvtpk_s(C1[10], C1[11]), cvtpk_s(C1[12], C1[13]), cvtpk_s(C1[14], C1[15])}; \
          if (resc) { LDS_WAIT(); \
              _Pragma("unroll") for (int r = 0; r < 16; ++r) { const float f = wsf[crow(r, hi)]; o[0][r] *= f; o[1][r] *= f; } } \
          __builtin_amdgcn_sched_barrier(0); \
          pv(o, vb0 + slc, __builtin_bit_cast(bf16x8, pw0), __builtin_bit_cast(bf16x8, pw1), __builtin_bit_cast(bf16x8, pw2), __builtin_bit_cast(bf16x8, pw3)); } \
        if ((t) + 1 < NT) hk.prefetch_wait(); \
        ATT_ROT(); \
    } while (0)
    {
        int t = 0;
        for (; t + 1 < NT; t += 2) { ATT_STEP(pA0, pA1, pB0, pB1, t); ATT_STEP(pB0, pB1, pA0, pA1, t + 1); }
        if (t < NT) { ATT_STEP(pA0, pA1, pB0, pB1, t); }
    }
att_done:
    { auto rr = __builtin_amdgcn_permlane32_swap(__float_as_uint(l_reg), __float_as_uint(l_reg), false, false); l_reg = __uint_as_float(rr[0]) + __uint_as_float(rr[1]); }
    if (hi == 0) wsf[32 + r32] = l_reg;
    LDS_WAIT();
    float rli[16];
#pragma unroll
    for (int r = 0; r < 16; ++r) rli[r] = __builtin_amdgcn_rcpf(wsf[32 + crow(r, hi)]);
    bf16* Ow = Oh + (qrow0 + wid * 32) * opitch;
    { LAS bf16* stg = (LAS bf16*)(shm + L_OST) + wid * 2048;
#pragma unroll
        for (int r = 0; r < 16; ++r) { const int orow = crow(r, hi);
#pragma unroll
            for (int d0 = 0; d0 < 2; ++d0) stg[orow * 64 + d0 * 32 + r32] = (bf16)f2bf(o[d0][r] * rli[r]); }
        LDS_WAIT();
#pragma unroll
        for (int i = 0; i < 4; ++i) { const int row = i * 8 + (lane >> 3), ch = lane & 7; const v4u v = *(const LAS v4u*)(stg + row * 64 + ch * 8); *(v4u*)(Ow + (long)row * opitch + ch * 8) = v; } }
    asm volatile("s_waitcnt lgkmcnt(0)\n\ts_barrier" ::: "memory");
#undef ATT_DMAK
#undef ATT_DMAV
#undef ATT_ROT
#undef ATT_STEP
}
__device__ __forceinline__ int t5_bucket(int d) {
    if (d < 16) return d < 0 ? 0 : d;
    return 16 + (d >= 22) + (d >= 30) + (d >= 40) + (d >= 54) + (d >= 73) + (d >= 99) + (d >= 134) + (d >= 182) + (d >= 246) + (d >= 332) + (d >= 450) + (d >= 609) + (d >= 825) + (d >= 1117) + (d >= 1513);
}
struct FoxHook {
    static constexpr bool EARLY = true, TRIM = false;
    __device__ __forceinline__ void prefetch(int, int) {}
    __device__ __forceinline__ void prefetch_issue(int, int) {}
    __device__ __forceinline__ void prefetch_wait() {}
    long rowbase; int NT, q0; const LAS float* Ft; const LAS float* knp; float qmax;
    __device__ __forceinline__ bool stop(int t, float mm) const { const int kt = NT - 1 - t; const float bound = qmax * knp[kt] * 1.001f + 0.01f + (Ft[q0] - Ft[64 * kt + 63]); return bound < mm - 48.0f; }
    __device__ __forceinline__ long tile_row(int t) const { return rowbase + 64 * (NT - 1 - t); }
    __device__ __forceinline__ void apply(f32x16& p0, f32x16& p1, int t, int r32, int hi, int wid) const {
        const int kb = 64 * (NT - 1 - t); const int tq = q0 + wid * 32 + r32; const float Fq = Ft[tq];
#pragma unroll
        for (int g = 0; g < 4; ++g) { const f32x4 f0 = *(const LAS f32x4*)(Ft + kb + 8 * g + 4 * hi), f1 = *(const LAS f32x4*)(Ft + kb + 32 + 8 * g + 4 * hi);
#pragma unroll
            for (int i = 0; i < 4; ++i) { p0[4 * g + i] += Fq - f0[i]; p1[4 * g + i] += Fq - f1[i]; }
            __builtin_amdgcn_sched_barrier(0); }
        if (kb + 63 > q0 + wid * 32) {
#pragma unroll
            for (int r = 0; r < 16; ++r) { const int key = kb + crow(r, hi); if (key > tq) p0[r] = -INFINITY; if (key + 32 > tq) p1[r] = -INFINITY; }
        }
    }
};
struct FoxHook2 {
    static constexpr bool EARLY = false, TRIM = true;
    __device__ __forceinline__ void prefetch(int, int) {}
    __device__ __forceinline__ void prefetch_issue(int, int) {}
    __device__ __forceinline__ void prefetch_wait() {}
    long rowbase; int NT, q0; const LAS float* Ft; const LAS float* knp; float qmax;
    __device__ __forceinline__ long tile_row(int t) const { return rowbase + 64 * (NT - 1 - t); }
    __device__ __forceinline__ int eff_tiles(int nt, const LAS float* wm, int lane, int tmin) const {
        float mm = __builtin_fminf(__builtin_fminf(__builtin_fminf(wm[0], wm[1]), __builtin_fminf(wm[2], wm[3])), __builtin_fminf(__builtin_fminf(wm[4], wm[5]), __builtin_fminf(wm[6], wm[7]))) - 48.0f;
        const int k0 = lane < NT ? lane : 0, k1 = lane + 64 < NT ? lane + 64 : 0;
        const bool c0 = (lane < NT) && (qmax * knp[k0] * 1.001f + 0.01f - Ft[64 * k0 + 63] < mm);
        const bool c1 = (lane + 64 < NT) && (qmax * knp[k1] * 1.001f + 0.01f - Ft[64 * k1 + 63] < mm);
        const int skip = __popcll(__ballot(c0)) + __popcll(__ballot(c1));
        int ne = ((NT - skip) + 1) & ~1; ne = ne < tmin ? tmin : ne; return ne < nt ? ne : nt; }
    __device__ __forceinline__ void apply(f32x16& p0, f32x16& p1, int t, int r32, int hi, int wid) const {
        const int kb = 64 * (NT - 1 - t); const int tq = q0 + wid * 32 + r32;
        const LAS float* fp = Ft + kb + 4 * hi;
        asm volatile("s_nop 3" : "+v"(p0), "+v"(p1));
#pragma unroll
        for (int g = 0; g < 4; ++g) { const f32x4 f0 = *(const LAS f32x4*)(fp + 8 * g), f1 = *(const LAS f32x4*)(fp + 8 * g + 32);
#pragma unroll
            for (int i = 0; i < 4; ++i) { asm volatile("v_sub_f32 %0, %1, %2" : "=v"(p0[4 * g + i]) : "v"(p0[4 * g + i]), "v"(f0[i])); asm volatile("v_sub_f32 %0, %1, %2" : "=v"(p1[4 * g + i]) : "v"(p1[4 * g + i]), "v"(f1[i])); }
            __builtin_amdgcn_sched_barrier(0); }
        if (kb + 63 > q0 + wid * 32) {
#pragma unroll
            for (int r = 0; r < 16; ++r) { const int key = kb + crow(r, hi); if (key > tq) p0[r] = -INFINITY; if (key + 32 > tq) p1[r] = -INFINITY; }
        }
    }
};
typedef unsigned u32x16 __attribute__((ext_vector_type(16)));
struct DsaHook {
    static constexpr bool EARLY = false, TRIM = false;
    __device__ __forceinline__ bool stop(int, float) const { return false; }
    long rowbase; int q0; const LAS float* tb; float c31; const unsigned long long* maskq;
    u32x16 ma, mb;
    __device__ __forceinline__ long tile_row(int t) const { return rowbase + 64 * t; }
    __device__ __forceinline__ unsigned long long mptr(int t, int wid) const { const unsigned long long* mp = maskq + ((size_t)wid * 128 + t) * 32;
        return ((unsigned long long)(unsigned)__builtin_amdgcn_readfirstlane((int)((unsigned long long)mp & 0xffffffffull))) | ((unsigned long long)(unsigned)__builtin_amdgcn_readfirstlane((int)((unsigned long long)mp >> 32)) << 32); }
    __device__ __forceinline__ void prefetch(int t, int wid) { const unsigned long long mpu = mptr(t, wid); unsigned d0, d1;
        asm volatile("s_load_dwordx16 %0, %4, 0x0\n\ts_load_dwordx16 %1, %4, 0x40\n\ts_load_dword %2, %4, 0x80\n\ts_load_dword %3, %4, 0xc0\n\ts_waitcnt lgkmcnt(0)" : "=&s"(ma), "=&s"(mb), "=&s"(d0), "=&s"(d1) : "s"(mpu) : "memory"); }
    unsigned pd0, pd1;
    __device__ __forceinline__ void prefetch_issue(int t, int wid) { const unsigned long long mpu = mptr(t, wid);
        asm volatile("s_load_dwordx16 %0, %4, 0x0\n\ts_load_dwordx16 %1, %4, 0x40\n\ts_load_dword %2, %4, 0x80\n\ts_load_dword %3, %4, 0xc0" : "=&s"(ma), "=&s"(mb), "=&s"(pd0), "=&s"(pd1) : "s"(mpu) : "memory"); }
    __device__ __forceinline__ void prefetch_wait() { asm volatile("s_waitcnt lgkmcnt(0)" : "+s"(ma), "+s"(mb), "+s"(pd0), "+s"(pd1) :: "memory"); }
    __device__ __forceinline__ void apply(f32x16& p0, f32x16& p1, int t, int r32, int hi, int wid) {
        const int kb = 64 * t; const int q0w = q0 + wid * 32; const int tq = q0w + r32;
        asm volatile("s_nop 3" : "+v"(p0), "+v"(p1));
        const unsigned long long mpu = mptr(t, wid);
        u32x16 a, b;
        asm volatile("s_load_dwordx16 %0, %2, 0x80\n\ts_load_dwordx16 %1, %2, 0xc0" : "=&s"(a), "=&s"(b) : "s"(mpu) : "memory");
        if (q0w - (kb + 63) < 1513) {
            const LAS float* tl = tb + (tq + 256 - kb - 4 * hi);
#pragma unroll
            for (int g = 0; g < 4; ++g) { float t0[4], t1[4];
#pragma unroll
                for (int i = 0; i < 4; ++i) { t0[i] = tl[-(8 * g + i)]; t1[i] = tl[-(8 * g + i) - 32]; }
#pragma unroll
                for (int i = 0; i < 4; ++i) { asm volatile("v_add_f32 %0, %1, %2" : "=v"(p0[4 * g + i]) : "v"(p0[4 * g + i]), "v"(t0[i])); asm volatile("v_add_f32 %0, %1, %2" : "=v"(p1[4 * g + i]) : "v"(p1[4 * g + i]), "v"(t1[i])); }
                __builtin_amdgcn_sched_barrier(0); }
        }
        const float NEG = -INFINITY;
#pragma unroll
        for (int r = 0; r < 8; ++r) { const unsigned long long mk = ((unsigned long long)ma[2 * r + 1] << 32) | ma[2 * r]; asm volatile("v_cndmask_b32_e64 %0, %1, %2, %3" : "=v"(p0[r]) : "v"(NEG), "v"(p0[r]), "s"(mk)); }
#pragma unroll
        for (int r = 0; r < 8; ++r) { const unsigned long long mk = ((unsigned long long)mb[2 * r + 1] << 32) | mb[2 * r]; asm volatile("v_cndmask_b32_e64 %0, %1, %2, %3" : "=v"(p0[8 + r]) : "v"(NEG), "v"(p0[8 + r]), "s"(mk)); }
        asm volatile("s_waitcnt lgkmcnt(0)" : "+s"(a), "+s"(b) :: "memory");
#pragma unroll
        for (int r = 0; r < 8; ++r) { const unsigned long long mk = ((unsigned long long)a[2 * r + 1] << 32) | a[2 * r]; asm volatile("v_cndmask_b32_e64 %0, %1, %2, %3" : "=v"(p1[r]) : "v"(NEG), "v"(p1[r]), "s"(mk)); }
#pragma unroll
        for (int r = 0; r < 8; ++r) { const unsigned long long mk = ((unsigned long long)b[2 * r + 1] << 32) | b[2 * r]; asm volatile("v_cndmask_b32_e64 %0, %1, %2, %3" : "=v"(p1[8 + r]) : "v"(NEG), "v"(p1[8 + r]), "s"(mk)); }
    }
};
struct DilHook {
    static constexpr bool EARLY = false, TRIM = false;
    __device__ __forceinline__ void prefetch(int, int) {}
    __device__ __forceinline__ void prefetch_issue(int, int) {}
    __device__ __forceinline__ void prefetch_wait() {}
    __device__ __forceinline__ bool stop(int, float) const { return false; }
    long rowbase; int q0, kt0; const LAS float* tb;
    __device__ __forceinline__ long tile_row(int t) const { return rowbase + 64 * (kt0 + t); }
    __device__ __forceinline__ void apply(f32x16& p0, f32x16& p1, int t, int r32, int hi, int wid) const {
        const int kb = 64 * (kt0 + t); const int tq = q0 + wid * 32 + r32;
        const LAS float* tl = tb + (tq + 256 - kb - 4 * hi);
        asm volatile("s_nop 3" : "+v"(p0), "+v"(p1));
#pragma unroll
        for (int g = 0; g < 4; ++g) { float t0[4], t1[4];
#pragma unroll
            for (int i = 0; i < 4; ++i) { t0[i] = tl[-(8 * g + i)]; t1[i] = tl[-(8 * g + i) - 32]; }
#pragma unroll
            for (int i = 0; i < 4; ++i) { asm volatile("v_add_f32 %0, %1, %2" : "=v"(p0[4 * g + i]) : "v"(p0[4 * g + i]), "v"(t0[i])); asm volatile("v_add_f32 %0, %1, %2" : "=v"(p1[4 * g + i]) : "v"(p1[4 * g + i]), "v"(t1[i])); }
            __builtin_amdgcn_sched_barrier(0); }
    }
};
}
namespace gla {
constexpr int LS = 72;
constexpr int O_QT = 0, O_KT = 9216, O_KHT = 18432, O_VT = 27648, O_AT = 46080, O_GA = 55296, O_WG = 59392, O_TOT = 63488, O_END = 65536;
__device__ __forceinline__ bf16x8 frag(const LAS bf16* base, int row, int k0) { return *(const LAS bf16x8*)(base + row * LS + k0); }
__device__ __forceinline__ int swz(int row, int k) { return row * LS + ((((k >> 3) ^ (row >> 3)) & 7) << 3) + (k & 7); }
__device__ __forceinline__ bf16x8 frag_sw(const LAS bf16* base, int row, int k0) { return *(const LAS bf16x8*)(base + swz(row, k0)); }
#define GLA_MFMA(x, y, c) __builtin_amdgcn_mfma_f32_16x16x32_bf16(x, y, c, 0, 0, 0)
__device__ __forceinline__ void chunk_unit(Frame& F, int b, int h, int c, const float* w_gate, const float* b_gate) {
    unsigned char* act = F.ws + WS_ACT; unsigned char* big = F.ws + WS_BIG;
    const bf16* QA = (const bf16*)(act + pg8::A_QA); const bf16* KA = (const bf16*)(act + pg8::A_KA); const bf16* VA = (const bf16*)(act + pg8::A_VA);
    const float* SM = (const float*)(act + pg8::A_SMALL);
    float* DS = (float*)(big + BG_DS); float* OI = (float*)(F.ws + WS_Y); bf16* QS = (bf16*)(big + BG_QS); float* DEC = (float*)(big + BG_DEC);
    LAS bf16* QT = (LAS bf16*)(F.lds + O_QT); LAS bf16* KT = (LAS bf16*)(F.lds + O_KT); LAS bf16* KHT = (LAS bf16*)(F.lds + O_KHT); LAS bf16* VT = (LAS bf16*)(F.lds + O_VT); LAS bf16* AT = (LAS bf16*)(F.lds + O_AT);
    LAS float* GA = (LAS float*)(F.lds + O_GA); LAS float* WG = (LAS float*)(F.lds + O_WG); LAS float* TOT = (LAS float*)(F.lds + O_TOT);
    int tidl_ = threadIdx.x; asm volatile("" : "+v"(tidl_));
    const int tid = tidl_, lane = tid & 63, wave = __builtin_amdgcn_readfirstlane(tid >> 6); const size_t m0 = (size_t)b * SEQ + 64 * c; const int bh = b * 4 + h;
    unsigned short qraw[8], kraw[8];
#pragma unroll
    for (int a = 0; a < 8; ++a) { const size_t o_ = (m0 + 8 * wave + a) * 256 + 64 * h + (tid & 63); qraw[a] = QA[o_]; kraw[a] = KA[o_]; }
    for (int i = tid; i < 1024; i += NTHR) { GA[i] = SM[(m0 + (i >> 4)) * 32 + (i & 15)]; WG[i] = w_gate[(i >> 6) * 256 + 64 * h + (i & 63)]; }
    for (int ch = tid; ch < 1024; ch += NTHR) { const int j = ch >> 4, v0 = (ch & 15) * 8; const v4u w = *(const GAS v4u*)(VA + (m0 + j) * 512 + 128 * h + v0);
        LAS bf16* pv_ = VT + swz(v0, j);
        pv_[0 * LS] = (bf16)(w.x & 0xffff); pv_[1 * LS] = (bf16)(w.x >> 16); pv_[2 * LS] = (bf16)(w.y & 0xffff); pv_[3 * LS] = (bf16)(w.y >> 16);
        pv_[4 * LS] = (bf16)(w.z & 0xffff); pv_[5 * LS] = (bf16)(w.z >> 16); pv_[6 * LS] = (bf16)(w.w & 0xffff); pv_[7 * LS] = (bf16)(w.w >> 16); }
    LDS_BAR();
    const int kap = tid & 63, part = wave;
    float cg[8];
    { const float bg = b_gate[64 * h + kap]; float run = 0.f;
#pragma unroll
      for (int a = 0; a < 8; ++a) { float z = bg;
#pragma unroll
          for (int r = 0; r < 16; ++r) z += GA[(8 * part + a) * 16 + r] * WG[r * 64 + kap];
          run += log_sigmoid(z) * (1.0f / 16.0f); cg[a] = run; }
      TOT[part * 64 + kap] = run; }
    LDS_BAR();
    float offs = 0.f, gmid = 0.f, glast = 0.f;
#pragma unroll
    for (int p = 0; p < 8; ++p) { const float tv = TOT[p * 64 + kap]; if (p < part) offs += tv; if (p < 4) gmid += tv; glast += tv; }
#pragma unroll
    for (int a = 0; a < 8; ++a) { const int i = 8 * part + a; const float G = offs + cg[a];
        const float q = bf2f(qraw[a]), k = bf2f(kraw[a]);
        QT[i * LS + kap] = (bf16)f2bf(q * __expf(G - gmid)); KT[i * LS + kap] = (bf16)f2bf(k * __expf(gmid - G)); KHT[kap * LS + i] = (bf16)f2bf(k * __expf(glast - G));
        QS[(m0 + i) * 256 + 64 * h + kap] = (bf16)f2bf(q * __expf(G)); }
    if (part == 7) DEC[((size_t)bh * 128 + c) * 64 + kap] = __expf(glast);
    LDS_BAR();
    const int fr = lane & 15, fq = lane >> 4;
#pragma unroll
    for (int tt = 0; tt < 2; ++tt) { const int tile = 2 * wave + tt, it = tile >> 2, jt = tile & 3; f32x4 acc = {0.f, 0.f, 0.f, 0.f};
        if (jt <= it) {
#pragma unroll
            for (int ks = 0; ks < 2; ++ks) acc = GLA_MFMA(frag(QT, 16 * it + fr, 32 * ks + 8 * fq), frag(KT, 16 * jt + fr, 32 * ks + 8 * fq), acc); }
#pragma unroll
        for (int r = 0; r < 4; ++r) { const int i = 16 * it + 4 * fq + r, j = 16 * jt + fr; AT[i * LS + j] = (bf16)f2bf(j <= i ? acc[r] : 0.f); } }
    LDS_BAR();
    { const int it = wave & 3;
#pragma unroll
      for (int vv = 0; vv < 4; ++vv) { const int vt = 4 * (wave >> 2) + vv; f32x4 ao = {0.f, 0.f, 0.f, 0.f}, ad = {0.f, 0.f, 0.f, 0.f};
#pragma unroll
          for (int ks = 0; ks < 2; ++ks) { const bf16x8 y = frag_sw(VT, 16 * vt + fr, 32 * ks + 8 * fq);
              ao = GLA_MFMA(frag(AT, 16 * it + fr, 32 * ks + 8 * fq), y, ao); ad = GLA_MFMA(frag(KHT, 16 * it + fr, 32 * ks + 8 * fq), y, ad); }
#pragma unroll
          for (int r = 0; r < 4; ++r) { const int i = 16 * it + 4 * fq + r, v = 16 * vt + fr;
              OI[(m0 + i) * 512 + 128 * h + v] = ao[r]; DS[(((size_t)bh * 128 + c) * 64 + i) * 128 + v] = ad[r]; } } }
}
__device__ __forceinline__ void scan_unit(Frame& F, int u) {
    unsigned char* big = F.ws + WS_BIG;
    const float* DS = (const float*)(big + BG_DS); const float* DEC = (const float*)(big + BG_DEC); bf16* SP = (bf16*)(big + BG_SP);
    int tidl_ = threadIdx.x; asm volatile("" : "+v"(tidl_));
    const int bh = u >> 4, e = (u & 15) * 512 + tidl_, kap = e >> 7;
    const float* ds = DS + (size_t)bh * 128 * 8192 + e; const float* dc = DEC + (size_t)bh * 128 * 64 + kap; bf16* sp = SP + (size_t)bh * 128 * 8192 + e;
    float S = 0.f;
    for (int c0 = 0; c0 < 128; c0 += 8) { float d[8], g[8];
#pragma unroll
        for (int k = 0; k < 8; ++k) { d[k] = ds[(size_t)(c0 + k) * 8192]; g[k] = dc[(c0 + k) * 64]; }
#pragma unroll
        for (int k = 0; k < 8; ++k) { sp[(size_t)(c0 + k) * 8192] = (bf16)f2bf(S); S = g[k] * S + d[k]; } }
}
__device__ __forceinline__ void out_unit(Frame& F, int b, int h, int c, const float* g_norm) {
    unsigned char* act = F.ws + WS_ACT; unsigned char* big = F.ws + WS_BIG;
    const bf16* RA = (const bf16*)(act + pg8::A_RA); const float* OI = (const float*)(F.ws + WS_Y); const bf16* QS = (const bf16*)(big + BG_QS); const bf16* SP = (const bf16*)(big + BG_SP);
    bf16* MIX = (bf16*)(F.ws + WS_MIX);
    LAS bf16* QL = (LAS bf16*)(F.lds + 0); LAS bf16* ST = (LAS bf16*)(F.lds + 9216); LAS float* SS = (LAS float*)(F.lds + 27648);
    int tidl_ = threadIdx.x; asm volatile("" : "+v"(tidl_));
    const int tid = tidl_, lane = tid & 63, wave = __builtin_amdgcn_readfirstlane(tid >> 6); const size_t m0 = (size_t)b * SEQ + 64 * c; const int bh = b * 4 + h;
    float oi[4][4]; unsigned short rr_[4][4];
    { const int fr_ = lane & 15, fq_ = lane >> 4, it_ = wave & 3, vh_ = wave >> 2;
#pragma unroll
      for (int vv = 0; vv < 4; ++vv)
#pragma unroll
          for (int r = 0; r < 4; ++r) { const size_t o_ = (m0 + 16 * it_ + 4 * fq_ + r) * 512 + 128 * h + 16 * (4 * vh_ + vv) + fr_; oi[vv][r] = OI[o_]; rr_[vv][r] = RA[o_]; } }
    { const int i = tid >> 3, k0 = (tid & 7) * 8; *(LAS v4u*)(QL + i * LS + k0) = *(const GAS v4u*)(QS + (m0 + i) * 256 + 64 * h + k0); }
    const bf16* sp = SP + ((size_t)bh * 128 + c) * 8192;
    for (int ch = tid; ch < 1024; ch += NTHR) { const int kap = ch >> 4, v0 = (ch & 15) * 8; const v4u w = *(const GAS v4u*)(sp + kap * 128 + v0);
        LAS bf16* ps_ = ST + swz(v0, kap);
        ps_[0 * LS] = (bf16)(w.x & 0xffff); ps_[1 * LS] = (bf16)(w.x >> 16); ps_[2 * LS] = (bf16)(w.y & 0xffff); ps_[3 * LS] = (bf16)(w.y >> 16);
        ps_[4 * LS] = (bf16)(w.z & 0xffff); ps_[5 * LS] = (bf16)(w.z >> 16); ps_[6 * LS] = (bf16)(w.w & 0xffff); ps_[7 * LS] = (bf16)(w.w >> 16); }
    LDS_BAR();
    const int fr = lane & 15, fq = lane >> 4, it = wave & 3, vh = wave >> 2;
    f32x4 o[4]; float ss[4] = {0.f, 0.f, 0.f, 0.f};
#pragma unroll
    for (int vv = 0; vv < 4; ++vv) { const int vt = 4 * vh + vv; f32x4 a = {0.f, 0.f, 0.f, 0.f};
#pragma unroll
        for (int ks = 0; ks < 2; ++ks) a = GLA_MFMA(frag(QL, 16 * it + fr, 32 * ks + 8 * fq), frag_sw(ST, 16 * vt + fr, 32 * ks + 8 * fq), a);
#pragma unroll
        for (int r = 0; r < 4; ++r) { const int i = 16 * it + 4 * fq + r, v = 16 * vt + fr; const float x = a[r] + oi[vv][r]; a[r] = x; ss[r] += x * x; }
        o[vv] = a; }
#pragma unroll
    for (int r = 0; r < 4; ++r) { float s = ss[r]; s += __shfl_xor(s, 1); s += __shfl_xor(s, 2); s += __shfl_xor(s, 4); s += __shfl_xor(s, 8); ss[r] = s; }
    if (fr == 0) {
#pragma unroll
        for (int r = 0; r < 4; ++r) SS[vh * 64 + 16 * it + 4 * fq + r] = ss[r]; }
    LDS_BAR();
#pragma unroll
    for (int r = 0; r < 4; ++r) { const int i = 16 * it + 4 * fq + r; const float tot = SS[i] + SS[64 + i]; const float rinv = 1.0f / sqrtf(tot * (1.0f / 128.0f) + LN_EPS);
#pragma unroll
        for (int vv = 0; vv < 4; ++vv) { const int v = 16 * (4 * vh + vv) + fr; const float rr = bf2f(rr_[vv][r]);
            const float of = o[vv][r] * rinv * g_norm[v]; const float sg = rr / (1.0f + __expf(-rr));
            MIX[(m0 + i) * 1024 + 128 * h + v] = (bf16)f2bf(of * sg); } }
}
}

namespace dsa {
__device__ __forceinline__ size_t sc_base(int b, int tq) { const size_t J = (size_t)(tq >> 6); return (size_t)b * SCB + 4096 * (J * (J + 1) / 2) + (size_t)(tq & 63) * 64 * (J + 1); }
__device__ __forceinline__ void score_unit(Frame& F, int b, int qb32) {
    unsigned char* act = F.ws + WS_ACT;
    const bf16* QI = (const bf16*)(act + pg8::A_QI); const bf16* KI = (const bf16*)(act + pg8::A_KI); const float* SM = (const float*)(act + pg8::A_SMALL);
    float* SC = (float*)(F.ws + WS_BIG + BG_SC);
    int tidl_ = threadIdx.x; asm volatile("" : "+v"(tidl_));
    const int lane = tidl_ & 63, wv_ = __builtin_amdgcn_readfirstlane(tidl_ >> 6), fr = lane & 15, fq = lane >> 4, qs = wv_ & 1, kp = wv_ >> 1;
    const int tq = 32 * qb32 + 16 * qs + fr; const size_t m = (size_t)b * SEQ + tq;
    bf16x8 qf[8][2]; float wv[8];
#pragma unroll
    for (int h = 0; h < 8; ++h) { wv[h] = SM[m * 32 + 16 + h];
#pragma unroll
        for (int ks = 0; ks < 2; ++ks) qf[h][ks] = *(const bf16x8*)(QI + m * 512 + 64 * h + 32 * ks + 8 * fq); }
    float* srow = SC + sc_base(b, tq);
    const int ntile = (qb32 >> 1) + 1;
    const bf16* kbase = KI + ((size_t)b * SEQ + fr) * 64 + 8 * fq;
    bf16x8 kn[4][2];
    if (kp < ntile) {
#pragma unroll
        for (int s4 = 0; s4 < 4; ++s4) { kn[s4][0] = *(const bf16x8*)(kbase + (size_t)(64 * kp + 16 * s4) * 64); kn[s4][1] = *(const bf16x8*)(kbase + (size_t)(64 * kp + 16 * s4) * 64 + 32); } }
    for (int kt = kp; kt < ntile; kt += 4) {
        bf16x8 kc[4][2];
#pragma unroll
        for (int s4 = 0; s4 < 4; ++s4) { kc[s4][0] = kn[s4][0]; kc[s4][1] = kn[s4][1]; }
        if (kt + 4 < ntile) {
#pragma unroll
            for (int s4 = 0; s4 < 4; ++s4) { kn[s4][0] = *(const bf16x8*)(kbase + (size_t)(64 * (kt + 4) + 16 * s4) * 64); kn[s4][1] = *(const bf16x8*)(kbase + (size_t)(64 * (kt + 4) + 16 * s4) * 64 + 32); } }
#pragma unroll
        for (int s4 = 0; s4 < 4; ++s4) {
            f32x4 acc = {0.f, 0.f, 0.f, 0.f};
#pragma unroll
            for (int h = 0; h < 8; ++h) { f32x4 d = {0.f, 0.f, 0.f, 0.f}; d = GLA_MFMA(kc[s4][0], qf[h][0], d); d = GLA_MFMA(kc[s4][1], qf[h][1], d);
#pragma unroll
                for (int r = 0; r < 4; ++r) acc[r] += wv[h] * __builtin_fmaxf(d[r], 0.f); }
            *(f32x4*)(srow + 64 * kt + 16 * s4 + 4 * fq) = acc; }
    }
}
__device__ __forceinline__ unsigned okey(float v) { const unsigned u = __float_as_uint(v + 0.0f); return u ^ ((u >> 31) ? 0xffffffffu : 0x80000000u); }
__device__ __forceinline__ void hadd(LAS unsigned* hist, unsigned bin) { __hip_atomic_fetch_add(&hist[bin >> 1], 1u << ((bin & 1u) * 16u), __ATOMIC_RELAXED, __HIP_MEMORY_SCOPE_WORKGROUP); }
__device__ __forceinline__ int hget(const LAS unsigned* hist, int bin) { return (int)((hist[bin >> 1] >> ((bin & 1) * 16)) & 0xffffu); }
__device__ __forceinline__ void find_bin(const LAS unsigned* hist, int wpl, int need, int lane, int& bin, int& above) {
    int cnt = 0;
#pragma unroll 1
    for (int i = 0; i < wpl; i += 4) { const v4u w = *(const LAS v4u*)(hist + lane * wpl + i);
        cnt += (int)(w.x & 0xffffu) + (int)(w.x >> 16) + (int)(w.y & 0xffffu) + (int)(w.y >> 16) + (int)(w.z & 0xffffu) + (int)(w.z >> 16) + (int)(w.w & 0xffffu) + (int)(w.w >> 16); }
    int incl = cnt;
#pragma unroll
    for (int o = 1; o < 64; o <<= 1) { const int t = __shfl_down(incl, o); if (lane + o < 64) incl += t; }
    const int sfx = incl - cnt; const bool mine = (sfx < need) && (sfx + cnt >= need);
    const unsigned long long bal = __ballot(mine); const int tl = __ffsll((long long)bal) - 1;
    const int sfx_t = __shfl(sfx, tl), nb = 2 * wpl, base_bin = tl * nb;
    const int hv = (lane < nb) ? hget(hist, base_bin + lane) : 0;
    int inc = hv;
#pragma unroll
    for (int o = 1; o < 32; o <<= 1) { const int t = __shfl_down(inc, o); if (lane + o < 64) inc += t; }
    const bool hit = (lane < nb) && (sfx_t + inc - hv < need) && (sfx_t + inc >= need);
    const unsigned long long bal2 = __ballot(hit); const int bl = __ffsll((long long)bal2) - 1;
    bin = base_bin + bl; above = sfx_t + __shfl(inc - hv, bl);
}
constexpr int SEL_CAP = 1024;
__device__ __forceinline__ void select_unit(Frame& F, int b, int qb32, unsigned long long* maskp) {
    const float* SC = (const float*)(F.ws + WS_BIG + BG_SC);
    LAS unsigned* W = (LAS unsigned*)(F.lds);
    LAS unsigned* hist = (LAS unsigned*)(F.lds + 32768 + __builtin_amdgcn_readfirstlane((int)threadIdx.x >> 6) * 10240); LAS unsigned* ckey = hist + 1024; LAS unsigned short* cidx = (LAS unsigned short*)(ckey + 1024);
    int tidl_ = threadIdx.x; asm volatile("" : "+v"(tidl_));
    const int tid = tidl_, lane = tid & 63; const unsigned long long lt = (1ull << lane) - 1ull;
    for (int i = tid; i < 8192; i += NTHR) W[i] = 0u;
    LDS_BAR();
#define SEL_OR(s_) __hip_atomic_fetch_or(&W[s_], qbit, __ATOMIC_RELAXED, __HIP_MEMORY_SCOPE_WORKGROUP)
#define SEL_ZERO(nw_) do { LDS_WAIT(); for (int i_ = lane; i_ < (nw_); i_ += 64) hist[i_] = 0u; LDS_WAIT(); } while (0)
    for (int qi = 0; qi < 4; ++qi) {
        const int q = 4 * __builtin_amdgcn_readfirstlane((int)threadIdx.x >> 6) + qi, tq = 32 * qb32 + q, n = tq + 1; const unsigned qbit = 1u << q;
        const float* row = SC + sc_base(b, tq);
        if (n <= 256) { for (int s = lane; s < n; s += 64) SEL_OR(s); continue; }
        const int nch = (n + 255) >> 8;
        int B1, B2, B3, ab1, ab2, ab3;
        SEL_ZERO(1024);
        { f32x4 vn[4];
#define SEL_LOADG(c0_) do { _Pragma("unroll") for (int u = 0; u < 4; ++u) { const int s0 = ((c0_) + u) * 256 + lane * 4; vn[u] = (s0 < n) ? *(const GAS f32x4*)(row + s0) : (f32x4){0.f, 0.f, 0.f, 0.f}; } } while (0)
          SEL_LOADG(0);
          for (int c0 = 0; c0 < nch; c0 += 4) { f32x4 v[4];
#pragma unroll
            for (int u = 0; u < 4; ++u) v[u] = vn[u];
            if (c0 + 4 < nch) SEL_LOADG(c0 + 4);
#pragma unroll
            for (int u = 0; u < 4; ++u) { const int s0 = (c0 + u) * 256 + lane * 4;
#pragma unroll
                for (int c = 0; c < 4; ++c) if (s0 + c < n) hadd(hist, okey(v[u][c]) >> 21); } } }
        LDS_WAIT(); find_bin(hist, 16, 256, lane, B1, ab1);
        const int need1 = 256 - ab1, cnt1 = hget(hist, B1);
        if (cnt1 <= SEL_CAP) {
            int cbase = 0;
            { f32x4 vn[4];
              SEL_LOADG(0);
              for (int c0 = 0; c0 < nch; c0 += 4) { f32x4 v[4];
#pragma unroll
                for (int u = 0; u < 4; ++u) v[u] = vn[u];
                if (c0 + 4 < nch) SEL_LOADG(c0 + 4);
#pragma unroll
                for (int u = 0; u < 4; ++u) { const int s0 = (c0 + u) * 256 + lane * 4;
#pragma unroll
                    for (int c = 0; c < 4; ++c) { const unsigned k = okey(v[u][c]); const int bin = (int)(k >> 21); const bool valid = s0 + c < n;
                        if (valid && bin > B1) SEL_OR(s0 + c);
                        const bool isc = valid && bin == B1; const unsigned long long bal = __ballot(isc);
                        if (isc) { const int pos = cbase + __popcll(bal & lt); ckey[pos] = k; cidx[pos] = (unsigned short)(s0 + c); }
                        cbase += __popcll(bal); } } } }
#undef SEL_LOADG
            const int C = cbase;
            SEL_ZERO(1024);
            for (int i = lane; i < C; i += 64) hadd(hist, (ckey[i] >> 10) & 2047u);
            LDS_WAIT(); find_bin(hist, 16, need1, lane, B2, ab2);
            const int need2 = need1 - ab2;
            SEL_ZERO(512);
            for (int i = lane; i < C; i += 64) { const unsigned k = ckey[i]; if ((int)((k >> 10) & 2047u) == B2) hadd(hist, k & 1023u); }
            LDS_WAIT(); find_bin(hist, 8, need2, lane, B3, ab3);
            const int need3 = need2 - ab3, cnt3 = hget(hist, B3);
            const unsigned T = ((unsigned)B1 << 21) | ((unsigned)B2 << 10) | (unsigned)B3;
            if (need3 >= cnt3) { for (int i = lane; i < C; i += 64) if (ckey[i] >= T) SEL_OR((int)cidx[i]); }
            else { for (int i0 = 0; i0 < C; i0 += 64) { const int i = i0 + lane; const bool valid = i < C; const unsigned k = valid ? ckey[i] : 0u; const int id = valid ? (int)cidx[i] : 0;
                       bool sel = valid && k > T;
                       if (__any(valid && k == T)) { int rank = 0; for (int jj = 0; jj < C; ++jj) rank += (ckey[jj] == T && (int)cidx[jj] < id) ? 1 : 0; if (valid && k == T && rank < need3) sel = true; }
                       if (sel) SEL_OR(id); } }
        } else {
            SEL_ZERO(1024);
            for (int ci = 0; ci < nch; ++ci) { const int s0 = ci * 256 + lane * 4; if (s0 < n) { const f32x4 v = *(const GAS f32x4*)(row + s0);
#pragma unroll
                for (int c = 0; c < 4; ++c) { const unsigned k = okey(v[c]); if (s0 + c < n && (int)(k >> 21) == B1) hadd(hist, (k >> 10) & 2047u); } } }
            LDS_WAIT(); find_bin(hist, 16, need1, lane, B2, ab2);
            const unsigned pre2 = ((unsigned)B1 << 11) | (unsigned)B2; const int need2 = need1 - ab2;
            SEL_ZERO(512);
            for (int ci = 0; ci < nch; ++ci) { const int s0 = ci * 256 + lane * 4; if (s0 < n) { const f32x4 v = *(const GAS f32x4*)(row + s0);
#pragma unroll
                for (int c = 0; c < 4; ++c) { const unsigned k = okey(v[c]); if (s0 + c < n && (k >> 10) == pre2) hadd(hist, k & 1023u); } } }
            LDS_WAIT(); find_bin(hist, 8, need2, lane, B3, ab3);
            const unsigned T = (pre2 << 10) | (unsigned)B3; const int need_eq = need2 - ab3, cnt_eq = hget(hist, B3);
            if (need_eq >= cnt_eq) {
                for (int ci = 0; ci < nch; ++ci) { const int s0 = ci * 256 + lane * 4; if (s0 < n) { const f32x4 v = *(const GAS f32x4*)(row + s0);
#pragma unroll
                    for (int c = 0; c < 4; ++c) if (s0 + c < n && okey(v[c]) >= T) SEL_OR(s0 + c); } }
            } else {
                int running = 0;
                for (int s0 = 0; s0 < n; s0 += 64) { const int s = s0 + lane; const bool valid = s < n; const unsigned k = valid ? okey(row[s]) : 0u;
                    const bool eq = valid && k == T, gt = valid && k > T; const unsigned long long bal = __ballot(eq);
                    const int rank = running + __popcll(bal & lt); if (gt || (eq && rank < need_eq)) SEL_OR(s); running += __popcll(bal); }
            }
        }
        LDS_WAIT();
    }
#undef SEL_OR
#undef SEL_ZERO
    LDS_BAR();
    const int ntile = 4 * (qb32 >> 3) + 4;
    for (int idx = tid; idx < ntile * 32; idx += NTHR) { const int kt = idx >> 5, j = idx & 31, p = j >> 4, r = j & 15; const int klo = 64 * kt + 32 * p + (r & 3) + 8 * (r >> 2);
        maskp[(size_t)kt * 32 + j] = (unsigned long long)W[klo] | ((unsigned long long)W[klo + 4] << 32); }
}
}
__device__ __forceinline__ void dsa_attn_unit(Frame& F, int b, int h, int qb, const float* rel, const unsigned long long* mask_layer) {
    unsigned char* act = F.ws + WS_ACT;
    LAS float* tb = (LAS float*)(F.lds + att::L_TAB);
    const float b31 = rel[31 * 8 + h];
    for (int i = F.tid; i < 1920; i += NTHR) { const int d = i - 256; tb[i] = (rel[att::t5_bucket(d) * 8 + h] - b31) * LOG2E; }
    att::DsaHook hk; hk.rowbase = (long)b * SEQ; hk.q0 = 256 * qb; hk.tb = tb; hk.c31 = rel[31 * 8 + h] * LOG2E;
    hk.maskq = mask_layer + ((size_t)(b * 256 + 8 * qb) * 128) * 32;
    att::attn_unit(hk, (const bf16*)(act + pg8::A_QB) + 64 * h, (const bf16*)(act + pg8::A_KB) + 64 * h, (const bf16*)(act + pg8::A_VB) + 64 * h,
                   (bf16*)(F.ws + WS_MIX) + 512 + 64 * h, (long)b * SEQ + 256 * qb, 4 * (qb + 1), F.lds, 1024);
}
__device__ __forceinline__ void dil_attn_unit(Frame& F, int b, int h, int qb, const float* rel) {
    unsigned char* act = F.ws + WS_ACT;
    LAS float* tb = (LAS float*)(F.lds + att::L_TAB);
    for (int i = F.tid; i < 2560; i += NTHR) { const int d = i - 256; float v = -INFINITY;
        if (d >= 0 && d <= 2048) { const int mult = (d <= 128 ? 1 : 0) + (((d & 3) == 0 && d <= 512) ? 1 : 0) + (((d & 15) == 0) ? 1 : 0);
            if (mult > 0) v = (rel[att::t5_bucket(d) * 8 + h] + (mult == 1 ? 0.f : (mult == 2 ? 0.6931471805599453f : 1.0986122886681098f))) * LOG2E; }
        tb[i] = v; }
    att::DilHook hk; hk.rowbase = (long)b * SEQ; hk.q0 = 256 * qb; hk.kt0 = (4 * qb - 32) > 0 ? (4 * qb - 32) : 0; hk.tb = tb;
    att::attn_unit(hk, (const bf16*)(act + pg8::A_QD) + 64 * h, (const bf16*)(act + pg8::A_KD) + 64 * h, (const bf16*)(act + pg8::A_VD) + 64 * h,
                   (bf16*)(F.ws + WS_MIX) + 512 + 64 * h, (long)b * SEQ + 256 * qb, 4 * (qb + 1) - hk.kt0, F.lds, 1024);
}
constexpr size_t MI_FG = 2 * MiB, MI_KNT = MI_FG + 2 * 8 * SEQ * 4;
__device__ __forceinline__ void fox_fscan_unit(Frame& F, int bh) {
    const int b = bh >> 3, h = bh & 7;
    const float* fl = (const float*)(F.ws + WS_MISC + MI_FL) + (size_t)b * SEQ * 8 + h; float* FG = (float*)(F.ws + WS_MISC + MI_FG) + (size_t)bh * SEQ;
    LAS float* wt = (LAS float*)(F.lds);
    const int s0 = 16 * F.tid; float v[16]; float run = 0.f;
#pragma unroll
    for (int k = 0; k < 16; ++k) { run += fl[(size_t)(s0 + k) * 8]; v[k] = run; }
    float incl = run;
#pragma unroll
    for (int o = 1; o < 64; o <<= 1) { const float t = __shfl_up(incl, o); if (F.lane >= o) incl += t; }
    if (F.lane == 63) wt[F.wave] = incl;
    LDS_BAR();
    float base = incl - run;
#pragma unroll
    for (int w = 0; w < 8; ++w) if (w < F.wave) base += wt[w];
#pragma unroll
    for (int k = 0; k < 16; k += 4) *(GAS f32x4*)(FG + s0 + k) = (f32x4){(base + v[k]) * LOG2E, (base + v[k + 1]) * LOG2E, (base + v[k + 2]) * LOG2E, (base + v[k + 3]) * LOG2E};
}
__device__ __forceinline__ void knorm_unit(Frame& F, int u) {
    const int item = 8 * u + F.wave, bh = item >> 7, tile = item & 127, b = bh >> 3, h = bh & 7;
    const bf16* KC = (const bf16*)(F.ws + WS_ACT + pg8::A_KC) + ((size_t)b * SEQ + 64 * tile + F.lane) * 512 + 64 * h;
    float ss = 0.f;
#pragma unroll
    for (int c = 0; c < 8; ++c) { const v4u w = *(const GAS v4u*)(KC + 8 * c);
        ss += bflo(w.x) * bflo(w.x) + bfhi(w.x) * bfhi(w.x) + bflo(w.y) * bflo(w.y) + bfhi(w.y) * bfhi(w.y) + bflo(w.z) * bflo(w.z) + bfhi(w.z) * bfhi(w.z) + bflo(w.w) * bflo(w.w) + bfhi(w.w) * bfhi(w.w); }
#pragma unroll
    for (int o = 1; o < 64; o <<= 1) ss = __builtin_fmaxf(ss, __shfl_xor(ss, o));
    if (F.lane == 0) ((float*)(F.ws + WS_MISC + MI_KNT))[item] = sqrtf(ss);
}
__device__ __forceinline__ void fox_attn_unit(Frame& F, int b, int h, int qb) {
    unsigned char* act = F.ws + WS_ACT;
    LAS float* Ft = (LAS float*)(F.lds + att::L_TAB); LAS float* knp = (LAS float*)(F.lds + att::L_TAB + 32768); LAS float* red = knp + 128;
    int tidl = threadIdx.x; asm volatile("" : "+v"(tidl));
    const int bh = b * 8 + h; const int n = 256 * (qb + 1), NT = 4 * (qb + 1);
    const float* FG = (const float*)(F.ws + WS_MISC + MI_FG) + (size_t)bh * SEQ; const float* KNT = (const float*)(F.ws + WS_MISC + MI_KNT) + bh * 128;
    { const int s0 = 16 * tidl; if (s0 < n) {
#pragma unroll
          for (int k = 0; k < 16; k += 4) *(LAS f32x4*)(Ft + s0 + k) = *(const GAS f32x4*)(FG + s0 + k); } }
    if (tidl < 128) { float m = tidl < NT ? KNT[tidl] : 0.f;
#pragma unroll
        for (int o = 1; o < 64; o <<= 1) { const float t = __shfl_up(m, o); if (F.lane >= o) m = __builtin_fmaxf(m, t); }
        if (tidl == 63) red[8] = m; knp[tidl] = m; }
    { const bf16* qp = (const bf16*)(act + pg8::A_QC) + ((size_t)b * SEQ + 256 * qb + (tidl >> 1)) * 512 + 64 * h + 32 * (tidl & 1); float ss = 0.f;
#pragma unroll
      for (int c = 0; c < 4; ++c) { const v4u w = *(const GAS v4u*)(qp + 8 * c);
          ss += bflo(w.x) * bflo(w.x) + bfhi(w.x) * bfhi(w.x) + bflo(w.y) * bflo(w.y) + bfhi(w.y) * bfhi(w.y) + bflo(w.z) * bflo(w.z) + bfhi(w.z) * bfhi(w.z) + bflo(w.w) * bflo(w.w) + bfhi(w.w) * bfhi(w.w); }
      ss += __shfl_xor(ss, 1);
#pragma unroll
      for (int o = 2; o < 64; o <<= 1) ss = __builtin_fmaxf(ss, __shfl_xor(ss, o));
      if (F.lane == 0) red[F.wave] = ss; }
    LDS_BAR();
    if (tidl >= 64 && tidl < 128) knp[tidl] = __builtin_fmaxf(knp[tidl], red[8]);
    LDS_BAR();
    float qm = red[0];
#pragma unroll
    for (int w = 1; w < 8; ++w) qm = __builtin_fmaxf(qm, red[w]);
    att::FoxHook2 hk; hk.rowbase = (long)b * SEQ; hk.NT = NT; hk.q0 = 256 * qb; hk.Ft = Ft; hk.knp = knp; hk.qmax = sqrtf(qm);
    att::attn_unit(hk, (const bf16*)(act + pg8::A_QC) + 64 * h, (const bf16*)(act + pg8::A_KC) + 64 * h, (const bf16*)(act + pg8::A_VC) + 64 * h,
                   (bf16*)(F.ws + WS_MIX) + 64 * h, (long)b * SEQ + 256 * qb, NT, F.lds, 1024);
}

struct Args {
    const float *x, *ln_g, *ln_b, *rel, *w_in_ab, *w_gate, *b_gate, *g_norm, *w_out_ab, *w_in_cd, *b_forget, *w_out_cd, *w1d, *w3d, *w2d, *w_router, *w1m, *w3m, *w2m;
    float* out; unsigned char* ws; int ph_lo, ph_hi;
};
#ifndef PH_MASK
#define PH_MASK 0x7ff
#endif
#define PH_EN(k) (((PH_MASK) >> (k)) & 1)
#ifndef REP_K
#define REP_K (-1)
#endif
#ifndef REP_PAR
#define REP_PAR 2
#endif
#ifndef REP_SUB
#define REP_SUB 0
#endif
#define SUBSKIP(first) (rep == 1 && ((REP_SUB == 1 && !(first)) || (REP_SUB == 2 && (first))))
#define NREP(k) ((REP_K == (k) && (REP_PAR == 2 || REP_PAR == (ly & 1))) ? 2 : 1)
constexpr int PH_PER_LAYER = 11, PH_TOTAL = DEPTH * PH_PER_LAYER;
__global__ void __launch_bounds__(NTHR, 2) hyb_fwd(Args args) {
    extern __shared__ __attribute__((aligned(16))) unsigned char lds_raw[];
    Frame F;
    F.lds = (LAS unsigned char*)lds_raw;
    F.MISC = (volatile LAS unsigned*)(F.lds + MISC_OFF);
    F.tid = threadIdx.x; F.lane = F.tid & 63; F.wave = __builtin_amdgcn_readfirstlane(F.tid >> 6);
    F.G = gridDim.x; { const int bx = blockIdx.x; F.vcu = (F.G % 8 == 0) ? (bx % 8) * (F.G / 8) + bx / 8 : bx; }
    F.ws = args.ws; F.ctl = (gu32*)(args.ws + WS_CTL);
    for (int u = F.tid; u < (LDS_BYTES - LDSCTL_OFF) / 4; u += NTHR) ((LAS unsigned*)(F.lds + LDSCTL_OFF))[u] = 0u;
    __syncthreads();
    const int lo = args.ph_lo, hi = args.ph_hi;
    const bool use_bar = (hi - lo) > 1;
    XcdBarrier bar; bar.bar = (unsigned*)(F.ctl + CW_BAR); bar.x = 0; bar.st = nullptr;
    if (use_bar) bar = xcd_barrier_post((unsigned*)(F.ctl + CW_BAR), F.MISC + 8);
#define RUN(g) (lo <= (g) && (g) < hi)
#if defined(PROF_A)
    volatile LAS unsigned long long* pstamp = (volatile LAS unsigned long long*)(F.lds + LDSCTL_OFF + 512);
    if (blockIdx.x == 0 && F.tid == 0) { for (int i_ = 0; i_ <= PH_TOTAL; ++i_) pstamp[i_] = 0ull; pstamp[0] = __builtin_amdgcn_s_memrealtime(); }
#define STAMP(g) do { if (blockIdx.x == 0 && threadIdx.x == 0) pstamp[(g) + 1] = __builtin_amdgcn_s_memrealtime(); } while (0)
#else
#define STAMP(g) do { } while (0)
#endif
#define PHASE_BEGIN() do { int t_ = threadIdx.x; asm volatile("" : "+v"(t_)); F.tid = t_; F.lane = t_ & 63; F.wave = __builtin_amdgcn_readfirstlane(t_ >> 6); \
        GAS unsigned char* wg_ = (GAS unsigned char*)args.ws; asm volatile("" : "+s"(wg_)); unsigned char* w_ = (unsigned char*)wg_; F.ws = w_; F.ctl = (gu32*)(w_ + WS_CTL); ws = w_; act = w_ + WS_ACT; big = w_ + WS_BIG; \
        X = (float*)(w_ + WS_X); XB = (bf16*)(w_ + WS_XB); MIX = (bf16*)(w_ + WS_MIX); Y = (bf16*)(w_ + WS_Y); Hb = (bf16*)(w_ + WS_BIG + BG_H); XG = (bf16*)(w_ + WS_BIG + BG_XG); } while (0)
#define BAR_AFTER(g) do { if ((g) + 1 < hi) { xcd_barrier(bar); } } while (0)
    unsigned char* ws = args.ws; unsigned char* act = ws + WS_ACT; unsigned char* big = ws + WS_BIG;
    float* X = (float*)(ws + WS_X); bf16* XB = (bf16*)(ws + WS_XB); bf16* MIX = (bf16*)(ws + WS_MIX); bf16* Y = (bf16*)(ws + WS_Y);
    bf16* Hb = (bf16*)(big + BG_H); bf16* XG = (bf16*)(big + BG_XG);

    for (int ly = 0; ly < DEPTH; ++ly) {
        const int j = ly >> 1; const bool even = (ly & 1) == 0; const int g0 = ly * PH_PER_LAYER;
        gu32* qh = F.ctl + CW_Q + (ly * 8) * 64; gu32* cnt = F.ctl + CW_CNT + (j * 8) * 64;
        unsigned long long* mask_layer = (unsigned long long*)(ws + WS_MASK + (size_t)j * 16 * MiB);
        if (ly == 0 && RUN(g0 + 0) && PH_EN(0)) for (int rep = 0; rep < NREP(0); ++rep) { PHASE_BEGIN();
            if (even) {
                conv_matrix(F, 1, args.w_in_ab + (size_t)j * DM * W_AB, nullptr, W_AB, DM, (bf16*)(ws + WS_EVW + EV_WAB), NAB);
                rows_to_bf16(F, args.x, XB);
            }
            BAR_AFTER(g0 + 0); STAMP(g0 + 0);
        }
        if (RUN(g0 + 1) && PH_EN(1)) for (int rep = 0; rep < NREP(1); ++rep) { PHASE_BEGIN();
            pg8::Gemm g{XB, even ? (const bf16*)(ws + WS_EVW + EV_WAB) : (const bf16*)(big + BG_WCD), M, even ? NAB : NCD, DM};
            pg8::StaticOrder S; S.init(M, even ? NAB : NCD, F.G, (int)blockIdx.x);
            pg8::EpiProj E{act, even ? 0 : 1};
            pg8::gemm_phase<pg8::EpiProj, pg8::StaticOrder, true, true>(F.lds, g, S, E);
            BAR_AFTER(g0 + 1); STAMP(g0 + 1);
        }
        if (RUN(g0 + 2) && PH_EN(2)) for (int rep = 0; rep < NREP(2); ++rep) { PHASE_BEGIN();
            if (even) {
                for (;;) { const int u = q_share(F, q_issue(F, qh + (0 + 4 * rep) * 64)); if (u >= 1536) break;
                    if (SUBSKIP(u < 512)) continue;
                    if (u < 512) dsa::score_unit(F, u & 1, 255 - (u >> 1));
                    else { const int v = u - 512; gla::chunk_unit(F, v >> 9, (v >> 7) & 3, v & 127, args.w_gate + (size_t)j * 16 * 256, args.b_gate + (size_t)j * 256); } }
            } else {
                for (int u = F.vcu; u < 272; u += F.G) { if (u < 16) fox_fscan_unit(F, u); else knorm_unit(F, u - 16); }
            }
            BAR_AFTER(g0 + 2); STAMP(g0 + 2);
        }
        if (RUN(g0 + 3) && PH_EN(3)) for (int rep = 0; rep < NREP(3); ++rep) { PHASE_BEGIN();
            if (even) {
                for (;;) { const int u = q_share(F, q_issue(F, qh + (1 + 4 * rep) * 64)); if (u >= 640) break;
                    if (SUBSKIP(u < 128)) continue;
                    if (u < 128) gla::scan_unit(F, u);
                    else { const int v = u - 128; const int b = v & 1, qb32 = 255 - (v >> 1); dsa::select_unit(F, b, qb32, mask_layer + ((size_t)(b * 256 + qb32) * 128) * 32); } }
            } else {
                const int nconv = (ly + 1 < DEPTH) ? 26 : 0;
                for (;;) { const int u0 = q_share(F, q_issue(F, qh + (1 + 4 * rep) * 64)); if (u0 >= 1024 + nconv) break;
                    if (u0 >= 64 && u0 < 64 + nconv) { const int c = u0 - 64; int jn = j + 1; asm volatile("" : "+s"(jn)); int ln_ = threadIdx.x & 63; asm volatile("" : "+v"(ln_));
#pragma unroll 1
                        for (int i = 0; i < 16; ++i) conv_even_item(F, ln_, c * 128 + i * 8 + F.wave, args.w_in_ab + (size_t)jn * DM * W_AB, args.w_out_ab + (size_t)jn * DM * DM,
                                                                   args.w1d + (size_t)jn * DM * FFD, args.w3d + (size_t)jn * DM * FFD, args.w2d + (size_t)jn * FFD * DM, ws + WS_EVW);
                        continue; }
                    const int u = u0 < 64 ? u0 : u0 - nconv;
                    if (SUBSKIP(u < 384 || u >= 896)) continue;
                    if (u < 384) { dil_attn_unit(F, (u >> 3) & 1, u & 7, 31 - (u >> 4), args.rel); }
                    else if (u < 896) { const int v = u - 384; fox_attn_unit(F, (v >> 3) & 1, v & 7, 31 - (v >> 4)); }
                    else { const int v = u - 896; dil_attn_unit(F, (v >> 3) & 1, v & 7, 7 - (v >> 4), args.rel); } }
            }
            BAR_AFTER(g0 + 3); STAMP(g0 + 3);
        }
        if (even && RUN(g0 + 4) && PH_EN(4)) for (int rep = 0; rep < NREP(4); ++rep) { PHASE_BEGIN();
            const float* w1m_ = args.w1m + (size_t)j * NEXP * DM * FFE; const float* w3m_ = args.w3m + (size_t)j * NEXP * DM * FFE; const float* w2m_ = args.w2m + (size_t)j * NEXP * DM * FFE;
            const int nce = (ly == 0) ? 19 : 0;
            for (;;) { const int u0 = q_share(F, q_issue(F, qh + (2 + 4 * rep) * 64)); if (u0 >= 1792 + nce) break;
                if (u0 >= 32 && u0 < 32 + nce) { const int c = u0 - 32; int ln_ = threadIdx.x & 63; asm volatile("" : "+v"(ln_));
#pragma unroll 1
                    for (int i = 0; i < 16; ++i) conv_even_item(F, ln_, 960 + c * 128 + i * 8 + F.wave, args.w_in_ab, args.w_out_ab, args.w1d, args.w3d, args.w2d, ws + WS_EVW);
                    continue; }
                const int u = u0 < 32 ? u0 : u0 - nce;
                if (u < 768) { const int g3 = u / 3, r3 = u - 3 * g3;
                    if (r3 < 2) { if (SUBSKIP(true)) continue; const int d = 2 * g3 + r3; dsa_attn_unit(F, (d >> 3) & 1, d & 7, 31 - (d >> 4), args.rel, mask_layer); }
                    else { if (rep == 1 && REP_SUB != 3 && REP_SUB != 0) continue; int ln_ = threadIdx.x & 63; asm volatile("" : "+v"(ln_));
#pragma unroll 1
                        for (int i = 0; i < 11; ++i) conv_odd_item(F, ln_, g3 * 88 + i * 8 + F.wave, w1m_, w3m_, w2m_, args.w_in_cd + (size_t)j * DM * W_CD, args.w_out_cd + (size_t)j * DM * DM, big); } }
                else { if (SUBSKIP(false)) continue; const int v = u - 768; gla::out_unit(F, v >> 9, (v >> 7) & 3, v & 127, args.g_norm + (size_t)j * 128); } }
            BAR_AFTER(g0 + 4); STAMP(g0 + 4);
        }
        if (RUN(g0 + 5) && PH_EN(5)) for (int rep = 0; rep < NREP(5); ++rep) { PHASE_BEGIN();
            pg8::Gemm g{MIX, even ? (const bf16*)(ws + WS_EVW + EV_WO) : (const bf16*)(big + BG_WOD), M, DM, DM};
            pg8::StaticOrder S; S.init(M, DM, F.G, (int)blockIdx.x);
            pg8::EpiPlain E{Y, DM, 4};
            pg8::gemm_phase<pg8::EpiPlain, pg8::StaticOrder, true, true>(F.lds, g, S, E);
            BAR_AFTER(g0 + 5); STAMP(g0 + 5);
        }
        if (RUN(g0 + 6) && PH_EN(6)) for (int rep = 0; rep < NREP(6); ++rep) { PHASE_BEGIN();
            const bool dry = (NREP(6) == 2 && rep == 0);
            ln_phase(F, ly == 0 ? args.x : X, Y, 0, args.ln_g + (size_t)(ly * 2) * DM, args.ln_b + (size_t)(ly * 2) * DM, dry ? (float*)(act) : X, dry ? (bf16*)(act + 64 * MiB) : XB,
                     even ? 0 : 1, args.w_router + (size_t)j * DM * NEXP, nullptr, dry ? cnt + 4096 : cnt);
            BAR_AFTER(g0 + 6); STAMP(g0 + 6);
        }
        if (!even && RUN(g0 + 7) && PH_EN(7)) for (int rep = 0; rep < NREP(7); ++rep) { PHASE_BEGIN(); scatter_phase(F, XB, XG, cnt); BAR_AFTER(g0 + 7); STAMP(g0 + 7); }
        int ts[9];
        if (even) { ts[0] = 0;
#pragma unroll
            for (int e = 1; e < 9; ++e) ts[e] = M / 256; }
        else moe_tiles(cnt, ts);
        if (RUN(g0 + 8) && PH_EN(8)) for (int rep = 0; rep < NREP(8); ++rep) { PHASE_BEGIN();
            pg8::Gemm g{even ? XB : XG, even ? (const bf16*)(ws + WS_EVW + EV_W13) : (const bf16*)(big + BG_W13M), M, 0, DM};
            pg8::GroupOrder S; S.init(ts, even ? 22 : 28, F.G, (int)blockIdx.x);
            pg8::EpiSwiGLU E{Hb, even ? FFD : FFE, even ? 22 : 28};
            pg8::gemm_phase<pg8::EpiSwiGLU, pg8::GroupOrder, true, true>(F.lds, g, S, E);
            BAR_AFTER(g0 + 8); STAMP(g0 + 8);
        }
        if (RUN(g0 + 9) && PH_EN(9)) for (int rep = 0; rep < NREP(9); ++rep) { PHASE_BEGIN();
            pg8::Gemm g{Hb, even ? (const bf16*)(ws + WS_EVW + EV_W2) : (const bf16*)(big + BG_W2M), M, 0, even ? FFD : FFE};
            pg8::GroupOrder S; S.init(ts, 4, F.G, (int)blockIdx.x);
            pg8::EpiPlain E{even ? Y : XG, DM, 4};
            pg8::gemm_phase<pg8::EpiPlain, pg8::GroupOrder, true, true>(F.lds, g, S, E);
            BAR_AFTER(g0 + 9); STAMP(g0 + 9);
        }
        if (RUN(g0 + 10) && PH_EN(10)) for (int rep = 0; rep < NREP(10); ++rep) { PHASE_BEGIN();
            const bool dry10 = (NREP(10) == 2 && rep == 0);
            ln_phase(F, X, even ? Y : XG, even ? 0 : 1, args.ln_g + (size_t)(ly * 2 + 1) * DM, args.ln_b + (size_t)(ly * 2 + 1) * DM, dry10 ? (float*)(act) : (ly == DEPTH - 1 ? args.out : X), dry10 ? (bf16*)(act + 64 * MiB) : XB,
                     even ? 2 : 0, args.w_in_cd + (size_t)j * DM * W_CD, args.b_forget + (size_t)j * 8, cnt);
            BAR_AFTER(g0 + 10); STAMP(g0 + 10);
        }
    }
#if defined(PROF_A)
    {
        xcd_barrier(bar);
        if (blockIdx.x == 0 && threadIdx.x == 0) {
            unsigned long long prev = pstamp[0]; float dA = 0.f, dB = 0.f;
            for (int g_ = 0; g_ < PH_TOTAL; ++g_) { const unsigned long long t_ = pstamp[g_ + 1]; if (t_ == 0ull) continue; const float d_ = (float)(t_ - prev) * 0.01f; prev = t_;
                const int code_ = ((g_ / PH_PER_LAYER) & 1) * 16 + (g_ % PH_PER_LAYER);
                if (code_ == (PROF_A) || (PROF_A) == 99) dA += d_; if (code_ == (PROF_B)) dB += d_; }
            float* pw_ = (float*)(args.ws + WS_CTL + 65536 * 4); pw_[0] = dA; pw_[1] = dB; }
        xcd_barrier(bar);
        const float* pr_ = (const float*)(args.ws + WS_CTL + 65536 * 4); const float cA = sqrtf(__hip_atomic_load(pr_, RLX_AGENT)), cB = __hip_atomic_load(pr_ + 1, RLX_AGENT);
        for (size_t i_ = (size_t)blockIdx.x * NTHR + threadIdx.x; i_ < (size_t)M * DM; i_ += (size_t)gridDim.x * NTHR) args.out[i_] = (i_ == 0) ? 100.0f * cB : cA;
    }
#endif
#undef RUN
#undef BAR_AFTER
}

#ifndef HYB_N_LAUNCHES
#define HYB_N_LAUNCHES 1
#endif
extern "C" void kernel_launch(void* const* d_in, const int* in_sizes, int n_in, void* d_out, int out_size, void* d_ws, size_t ws_size, hipStream_t stream) {
    static int grid = 0;
    if (grid == 0) {
        if (n_in != 19 || in_sizes[0] != M * DM || out_size != M * DM || ws_size < WS_END) { fprintf(stderr, "kernel_launch: unexpected shapes / workspace (n_in %d, ws %zu, need %zu)\n", n_in, ws_size, (size_t)WS_END); grid = -1; return; }
        { const long exp_sz[19] = {(long)M * DM, (long)DEPTH * 2 * DM, (long)DEPTH * 2 * DM, 32 * 8, 2L * DM * W_AB, 2L * 16 * 256, 2L * 256, 2L * 128, 2L * DM * DM, 2L * DM * W_CD, 2L * 8, 2L * DM * DM,
              2L * DM * FFD, 2L * DM * FFD, 2L * FFD * DM, 2L * DM * NEXP, 2L * NEXP * DM * FFE, 2L * NEXP * DM * FFE, 2L * NEXP * FFE * DM};
          for (int i = 0; i < 19; ++i) if ((long)in_sizes[i] != exp_sz[i]) { fprintf(stderr, "kernel_launch: input %d has %d elements, expected %ld\n", i, in_sizes[i], exp_sz[i]); grid = -1; return; } }
        int dev = 0, cus = 0, per_cu = 0;
        if (hipGetDevice(&dev) != hipSuccess || hipDeviceGetAttribute(&cus, hipDeviceAttributeMultiprocessorCount, dev) != hipSuccess) { grid = -1; return; }
        if (hipFuncSetAttribute((const void*)hyb_fwd, hipFuncAttributeMaxDynamicSharedMemorySize, LDS_BYTES) != hipSuccess) { fprintf(stderr, "kernel_launch: hipFuncSetAttribute failed\n"); grid = -1; return; }
        if (hipOccupancyMaxActiveBlocksPerMultiprocessor(&per_cu, (const void*)hyb_fwd, NTHR, LDS_BYTES) != hipSuccess || per_cu < 1) fprintf(stderr, "kernel_launch: occupancy query reports %d\n", per_cu);
        (void)hipGetLastError();
        grid = cus;
    }
    if (grid < 0) return;
    if (hipMemsetAsync((char*)d_ws + WS_CTL, 0, CTL_ZERO_BYTES, stream) != hipSuccess) { fprintf(stderr, "kernel_launch: memset failed\n"); return; }
    Args a{};
    a.x = (const float*)d_in[0]; a.ln_g = (const float*)d_in[1]; a.ln_b = (const float*)d_in[2]; a.rel = (const float*)d_in[3]; a.w_in_ab = (const float*)d_in[4]; a.w_gate = (const float*)d_in[5];
    a.b_gate = (const float*)d_in[6]; a.g_norm = (const float*)d_in[7]; a.w_out_ab = (const float*)d_in[8]; a.w_in_cd = (const float*)d_in[9]; a.b_forget = (const float*)d_in[10]; a.w_out_cd = (const float*)d_in[11];
    a.w1d = (const float*)d_in[12]; a.w3d = (const float*)d_in[13]; a.w2d = (const float*)d_in[14]; a.w_router = (const float*)d_in[15]; a.w1m = (const float*)d_in[16]; a.w3m = (const float*)d_in[17]; a.w2m = (const float*)d_in[18];
    a.out = (float*)d_out; a.ws = (unsigned char*)d_ws;
#if HYB_N_LAUNCHES == 1
#ifndef HYB_PH_HI
#define HYB_PH_HI PH_TOTAL
#endif
#ifndef HYB_PH_LO
#define HYB_PH_LO 0
#endif
    a.ph_lo = HYB_PH_LO; a.ph_hi = HYB_PH_HI;
    hipLaunchKernelGGL(hyb_fwd, dim3(grid), dim3(NTHR), LDS_BYTES, stream, a);
#else
    for (int ph = 0; ph < PH_TOTAL; ++ph) {
        const int ly = ph / PH_PER_LAYER, k = ph % PH_PER_LAYER; const bool even = (ly & 1) == 0;
        if (even && k == 7) continue; if (!even && k == 4) continue; if (ly > 0 && k == 0) continue;
        a.ph_lo = ph; a.ph_hi = ph + 1;
        hipLaunchKernelGGL(hyb_fwd, dim3(grid), dim3(NTHR), LDS_BYTES, stream, a);
    }
#endif
    const hipError_t le = hipPeekAtLastError();
    if (le != hipSuccess) fprintf(stderr, "kernel_launch: launch failed: %s\n", hipGetErrorName(le));
}
```

```cpp
#include <hip/hip_runtime.h>
#include <cstdio>
#include <cstdint>
#include <cmath>
namespace pg8 {
#define PG8_LAS __attribute__((address_space(3)))
typedef unsigned short bf16_t;
typedef short bf16x8 __attribute__((ext_vector_type(8)));
typedef float f32x4 __attribute__((ext_vector_type(4)));
typedef unsigned u32x4 __attribute__((ext_vector_type(4)));
constexpr int BM = 256, BK = 64, HALF = 128, HTB = HALF * BK * 2  , STAGE_BYTES = 8 * HTB, NXCD = 8, WGM = 8;

__host__ __device__ __forceinline__ int lds_byte(int r, int c) { const int st = (r >> 4) * 2 + (c >> 5), rr = r & 15, cc = c & 31, ob = rr * 64 + cc * 2; return st * 1024 + (ob ^ (((ob >> 9) & 1) << 5)); }
__host__ __device__ __forceinline__ void stage_rc(int b, int& R, int& C) { const int st = b / 1024, sb = b % 1024, swz = sb ^ (((sb >> 9) & 1) << 5); R = (st >> 1) * 16 + swz / 64; C = (st & 1) * 32 + (swz % 64) / 2; }
__host__ __device__ __forceinline__ int perm32(int rho) { const int n = rho >> 4, i = rho & 15; return 8 * (i >> 2) + 4 * n + (i & 3); }

struct Unit { int pm, pn; };
struct Gemm { const bf16_t* A; const bf16_t* Bt; int M, N, K; };

struct StaticOrder {
    int nM, nN, nwg, G, c;
    __host__ __device__ void init(int M, int N, int G_, int c_) { nM = M / BM; nN = N / BM; nwg = nM * nN; G = G_; c = c_; }
    __host__ __device__ bool next(int i, Unit& u) const {
        const long L = (long)i * G + c; if (L >= nwg) return false;
        int wgid = (int)L; { const int q = nwg / NXCD, r = nwg % NXCD, xcd = wgid % NXCD, off = wgid / NXCD; wgid = (xcd < r ? xcd * (q + 1) : r * (q + 1) + (xcd - r) * q) + off; }
        const int nig = WGM * nN, gid = wgid / nig, fm = gid * WGM, gsz = (nM - fm) < WGM ? (nM - fm) : WGM;
        u.pm = fm + ((wgid % nig) % gsz); u.pn = (wgid % nig) / gsz; return true;
    }
    __device__ __forceinline__ void a_ready(const Unit&) const {}
    __device__ __forceinline__ void done(const Unit&) const {}
};

__device__ __forceinline__ unsigned cvt_pk_bf16(float lo, float hi) { unsigned r; asm volatile("v_cvt_pk_bf16_f32 %0, %1, %2" : "=v"(r) : "v"(lo), "v"(hi)); return r; }
typedef float f32x2 __attribute__((ext_vector_type(2)));
constexpr float QC2 = 0.125f * 1.4426950408889634f;

constexpr size_t ACT_MB = 1u << 20;
constexpr size_t A_QA = 0, A_KA = 8 * ACT_MB, A_VA = 16 * ACT_MB, A_RA = 32 * ACT_MB, A_QB = 48 * ACT_MB, A_KB = 64 * ACT_MB, A_VB = 80 * ACT_MB, A_QI = 96 * ACT_MB,
                 A_SMALL = 112 * ACT_MB  , A_KI = 114 * ACT_MB  ;
constexpr size_t A_QC = 0, A_KC = 16 * ACT_MB, A_VC = 32 * ACT_MB, A_QD = 48 * ACT_MB, A_KD = 64 * ACT_MB, A_VD = 80 * ACT_MB;
struct EpiProj {
    static constexpr bool PERM = true, AFTER_DRAIN = false;
    unsigned char* act; int mode;
    __device__ __forceinline__ void operator()(const f32x4 (&acc)[2][2][4][2], const Unit& u, int wr, int wc, int fr, int fq) const {
        const int row0 = u.pm * BM + wr * 64 + fr; const int pn = u.pn;
        if (mode == 0 && pn == 14) {
            float* sm = (float*)(act + A_SMALL); bf16_t* ki = (bf16_t*)(act + A_KI);
            if (wc < 3) {
#pragma unroll
                for (int ai = 0; ai < 2; ++ai)
#pragma unroll
                    for (int m = 0; m < 4; ++m) { const int row = row0 + ai * HALF + m * 16; const f32x4 v0 = acc[ai][0][m][0], v1 = acc[ai][0][m][1];
                        const int cl = wc * 32 + 8 * fq;
                        if (cl < 16) { *(f32x4*)(sm + (size_t)row * 32 + cl) = v0; *(f32x4*)(sm + (size_t)row * 32 + cl + 4) = v1; }
                        else if (cl < 80) { u32x4 w; w.x = cvt_pk_bf16(v0[0], v0[1]); w.y = cvt_pk_bf16(v0[2], v0[3]); w.z = cvt_pk_bf16(v1[0], v1[1]); w.w = cvt_pk_bf16(v1[2], v1[3]);
                            *(u32x4*)(ki + (size_t)row * 64 + (cl - 16)) = w; }
                        else if (cl < 88) { *(f32x4*)(sm + (size_t)row * 32 + 16) = v0; *(f32x4*)(sm + (size_t)row * 32 + 20) = v1; } }
            }
            return;
        }
        size_t off; int ld, colt; float sc = 1.f;
        if (mode == 0) {
            if (pn == 0) { off = A_QA; ld = 256; colt = 0; sc = 0.125f; }
            else if (pn == 1) { off = A_KA; ld = 256; colt = 0; }
            else { const int t = (pn - 2) >> 1; colt = ((pn - 2) & 1) * 256; ld = 512; off = A_VA + (size_t)t * 16 * ACT_MB; if (t == 2) sc = QC2; }
        } else { const int t = pn >> 1; colt = (pn & 1) * 256; ld = 512; off = (size_t)t * 16 * ACT_MB; if (t == 0 || t == 3) sc = QC2; }
        bf16_t* base = (bf16_t*)(act + off);
        const int col0 = colt + wc * 32 + 8 * fq;
#pragma unroll
        for (int ai = 0; ai < 2; ++ai)
#pragma unroll
            for (int m = 0; m < 4; ++m) { bf16_t* rowp = base + (size_t)(row0 + ai * HALF + m * 16) * ld + col0;
#pragma unroll
                for (int bj = 0; bj < 2; ++bj) { const f32x4 v0 = acc[ai][bj][m][0] * sc, v1 = acc[ai][bj][m][1] * sc;
                    u32x4 w; w.x = cvt_pk_bf16(v0[0], v0[1]); w.y = cvt_pk_bf16(v0[2], v0[3]); w.z = cvt_pk_bf16(v1[0], v1[1]); w.w = cvt_pk_bf16(v1[2], v1[3]);
                    *(u32x4*)(rowp + bj * HALF) = w; } }
    }
};
struct EpiPlain {
    static constexpr bool PERM = true, AFTER_DRAIN = false;
    bf16_t* O; int ld, nct;
    __device__ __forceinline__ void operator()(const f32x4 (&acc)[2][2][4][2], const Unit& u, int wr, int wc, int fr, int fq) const {
        const int row0 = u.pm * BM + wr * 64 + fr; const int col0 = (u.pn % nct) * BM + wc * 32 + 8 * fq;
#pragma unroll
        for (int ai = 0; ai < 2; ++ai)
#pragma unroll
            for (int m = 0; m < 4; ++m) { bf16_t* rowp = O + (size_t)(row0 + ai * HALF + m * 16) * ld + col0;
#pragma unroll
                for (int bj = 0; bj < 2; ++bj) { const f32x4 v0 = acc[ai][bj][m][0], v1 = acc[ai][bj][m][1];
                    u32x4 w; w.x = cvt_pk_bf16(v0[0], v0[1]); w.y = cvt_pk_bf16(v0[2], v0[3]); w.z = cvt_pk_bf16(v1[0], v1[1]); w.w = cvt_pk_bf16(v1[2], v1[3]);
                    *(u32x4*)(rowp + bj * HALF) = w; } }
    }
};
__device__ __forceinline__ float silu_mul(float a, float b) { return a * b * __builtin_amdgcn_rcpf(1.0f + __builtin_amdgcn_exp2f(-1.4426950408889634f * a)); }
struct EpiSwiGLU {
    static constexpr bool PERM = true, AFTER_DRAIN = false;
    bf16_t* H; int ld, nct;
    __device__ __forceinline__ void operator()(const f32x4 (&acc)[2][2][4][2], const Unit& u, int wr, int wc, int fr, int fq) const {
        const int row0 = u.pm * BM + wr * 64 + fr; const int col0 = (u.pn % nct) * HALF + wc * 32 + 8 * fq;
#pragma unroll
        for (int ai = 0; ai < 2; ++ai)
#pragma unroll
            for (int m = 0; m < 4; ++m) { bf16_t* rowp = H + (size_t)(row0 + ai * HALF + m * 16) * ld + col0;
                const f32x4 a0 = acc[ai][0][m][0], a1 = acc[ai][0][m][1], b0 = acc[ai][1][m][0], b1 = acc[ai][1][m][1];
                u32x4 w; w.x = cvt_pk_bf16(silu_mul(a0[0], b0[0]), silu_mul(a0[1], b0[1])); w.y = cvt_pk_bf16(silu_mul(a0[2], b0[2]), silu_mul(a0[3], b0[3]));
                w.z = cvt_pk_bf16(silu_mul(a1[0], b1[0]), silu_mul(a1[1], b1[1])); w.w = cvt_pk_bf16(silu_mul(a1[2], b1[2]), silu_mul(a1[3], b1[3]));
                *(u32x4*)rowp = w; }
    }
};
struct GroupOrder {
    int ts0, ts1, ts2, ts3, ts4, ts5, ts6, ts7, ts8; int nct, total, G, c;
    __device__ __forceinline__ void init(const int (&ts)[9], int nct_, int G_, int c_) { ts0 = ts[0]; ts1 = ts[1]; ts2 = ts[2]; ts3 = ts[3]; ts4 = ts[4]; ts5 = ts[5]; ts6 = ts[6]; ts7 = ts[7]; ts8 = ts[8];
        nct = nct_; total = (ts8 - ts0) * nct_; G = G_; c = c_; }
    __device__ __forceinline__ bool next(int i, Unit& u) const {
        const long L = (long)i * G + c; if (L >= total) return false;
        int w = (int)L; { const int q = total / NXCD, r = total % NXCD, xcd = w % NXCD, off = w / NXCD; w = (xcd < r ? xcd * (q + 1) : r * (q + 1) + (xcd - r) * q) + off; }
        int e = 0, first = ts0, T = ts1 - ts0;
#define PG8_GO_STEP(E, A, B) if (e == (E) - 1 && w >= T * nct) { w -= T * nct; e = (E); first = (A); T = (B) - (A); }
        PG8_GO_STEP(1, ts1, ts2) PG8_GO_STEP(2, ts2, ts3) PG8_GO_STEP(3, ts3, ts4) PG8_GO_STEP(4, ts4, ts5) PG8_GO_STEP(5, ts5, ts6) PG8_GO_STEP(6, ts6, ts7) PG8_GO_STEP(7, ts7, ts8)
#undef PG8_GO_STEP
        const int nig = WGM * nct, gid = w / nig, fm = gid * WGM, gsz = (T - fm) < WGM ? (T - fm) : WGM;
        u.pm = first + fm + ((w % nig) % gsz); u.pn = e * nct + (w % nig) / gsz; return true;
    }
    __device__ __forceinline__ void a_ready(const Unit&) const {}
    __device__ __forceinline__ void done(const Unit&) const {}
};
template <class Epi, class Sched, bool ALIGN_EPI = false, bool SP2 = false>
__device__ __forceinline__ void gemm_phase(PG8_LAS unsigned char* lds, const Gemm g, const Sched& S, const Epi& E) {
    int tid_ = threadIdx.x; asm volatile("" : "+v"(tid_)); const int tid = tid_, wid = __builtin_amdgcn_readfirstlane(tid >> 6), lane = tid & 63, wr = wid >> 2, wc = wid & 3, fr = lane & 15, fq = lane >> 4;
    const int K = g.K, nt = K / BK;
    unsigned voffA[2], voffB[2];
#pragma unroll
    for (int i = 0; i < 2; ++i) { int R, C; stage_rc(tid * 16 + i * 8192, R, C); const int Rb = Epi::PERM ? ((R & ~31) + perm32(R & 31)) : R;
        voffA[i] = (unsigned)(R * K + C) * 2u; voffB[i] = (unsigned)(Rb * K + C) * 2u; }
    const size_t kstep = (size_t)(BK * 2);
    const size_t hstep = (size_t)HALF * K * 2;
    const size_t tstep = 2 * hstep;
    const unsigned ldsw = (unsigned)wid * 1024u;
    const int aoff = lds_byte(wr * 64 + fr, fq * 8), boff = lds_byte(wc * 32 + fr, fq * 8);
#define PG8_SA(b, h) (((b) * 2 + (h)) * HTB)
#define PG8_SB(b, h) ((4 + (b) * 2 + (h)) * HTB)
#define PG8_STAGE(bufoff, gbase, voff) do { _Pragma("unroll") for (int _i = 0; _i < 2; ++_i) \
        __builtin_amdgcn_global_load_lds((const unsigned*)((const char*)(gbase) + (voff)[_i]), (PG8_LAS unsigned*)(lds + (bufoff) + ldsw + _i * 8192), 16, 0, 0); } while (0)
#define PG8_LDA(dst, b, h) do { _Pragma("unroll") for (int m = 0; m < 4; ++m) _Pragma("unroll") for (int k = 0; k < 2; ++k) dst[m][k] = *(const PG8_LAS bf16x8*)(lds + PG8_SA(b, h) + aoff + m * 2048 + k * 1024); } while (0)
#define PG8_LDB(dst, b, h) do { _Pragma("unroll") for (int n = 0; n < 2; ++n) _Pragma("unroll") for (int k = 0; k < 2; ++k) dst[n][k] = *(const PG8_LAS bf16x8*)(lds + PG8_SB(b, h) + boff + n * 2048 + k * 1024); } while (0)
#define PG8_MMA(ai, bj, At, Bt) do { __builtin_amdgcn_s_setprio(1); _Pragma("unroll") for (int m = 0; m < 4; ++m) _Pragma("unroll") for (int n = 0; n < 2; ++n) _Pragma("unroll") for (int k = 0; k < 2; ++k) \
        acc[ai][bj][m][n] = __builtin_amdgcn_mfma_f32_16x16x32_bf16(Bt[n][k], At[m][k], acc[ai][bj][m][n], 0, 0, 0); __builtin_amdgcn_s_setprio(0); } while (0)
#define PG8_WAIT_V(n) asm volatile("s_waitcnt vmcnt(" #n ")" ::: "memory")
#define PG8_WAIT_L(n) asm volatile("s_waitcnt lgkmcnt(" #n ")" ::: "memory")
#define PG8_BAR __builtin_amdgcn_s_barrier()
#define PG8_SCHED __builtin_amdgcn_sched_barrier(0)
    Unit cur, nxt; int ui = 0;
    if (!S.next(0, cur)) return;
    f32x4 acc[2][2][4][2];
#pragma unroll
    for (int a = 0; a < 2; ++a)
#pragma unroll
        for (int b = 0; b < 2; ++b)
#pragma unroll
            for (int m = 0; m < 4; ++m)
#pragma unroll
                for (int n = 0; n < 2; ++n) acc[a][b][m][n] = (f32x4){0.f, 0.f, 0.f, 0.f};
    bf16x8 At[4][2], B0[2][2], B1[2][2];
    const char* cA = (const char*)g.A + (size_t)cur.pm * tstep; const char* cB = (const char*)g.Bt + (size_t)cur.pn * tstep;
    S.a_ready(cur);
    if constexpr (SP2) {
        PG8_STAGE(PG8_SB(0, 0), cB, voffB); PG8_STAGE(PG8_SB(0, 1), cB + hstep, voffB); PG8_STAGE(PG8_SA(0, 0), cA, voffA); PG8_STAGE(PG8_SA(0, 1), cA + hstep, voffA);
        if (wr == 1) PG8_BAR;
        PG8_WAIT_V(2); PG8_BAR;
        PG8_STAGE(PG8_SB(1, 0), cB + kstep, voffB); PG8_STAGE(PG8_SA(1, 0), cA + kstep, voffA); PG8_STAGE(PG8_SB(1, 1), cB + hstep + kstep, voffB);
        PG8_WAIT_V(6); PG8_BAR;
    } else {
        PG8_STAGE(PG8_SB(0, 0), cB, voffB); PG8_STAGE(PG8_SA(0, 0), cA, voffA); PG8_STAGE(PG8_SB(0, 1), cB + hstep, voffB); PG8_STAGE(PG8_SA(0, 1), cA + hstep, voffA);
        if (wr == 1) PG8_BAR;
        PG8_WAIT_V(4); PG8_BAR;
        PG8_STAGE(PG8_SB(1, 0), cB + kstep, voffB); PG8_STAGE(PG8_SA(1, 0), cA + kstep, voffA); PG8_STAGE(PG8_SB(1, 1), cB + hstep + kstep, voffB);
        PG8_WAIT_V(6); PG8_BAR;
    }
    for (;;) {
        const bool has_next = S.next(ui + 1, nxt);
        const char* nA = has_next ? (const char*)g.A + (size_t)nxt.pm * tstep : cA; const char* nB = has_next ? (const char*)g.Bt + (size_t)nxt.pn * tstep : cB;
        for (int t = 0; t < nt; t += 2) {
            const bool last = (t == nt - 2);
            const char* a1 = cA + (size_t)(t + 1) * kstep;
            const char* a2 = last ? nA : cA + (size_t)(t + 2) * kstep; const char* b2 = last ? nB : cB + (size_t)(t + 2) * kstep;
            const char* a3 = a2 + kstep; const char* b3 = b2 + kstep;
            if (last && has_next) S.a_ready(nxt);
            if constexpr (SP2) {
            PG8_LDB(B0, 0, 0); PG8_LDB(B1, 0, 1); PG8_SCHED; PG8_LDA(At, 0, 0); PG8_STAGE(PG8_SA(1, 1), a1 + hstep, voffA);
            PG8_WAIT_V(8); PG8_WAIT_L(0); PG8_BAR; PG8_MMA(0, 0, At, B0); PG8_MMA(0, 1, At, B1); PG8_BAR; PG8_SCHED;
            PG8_LDA(At, 0, 1); PG8_STAGE(PG8_SB(0, 0), b2, voffB); PG8_STAGE(PG8_SB(0, 1), b2 + hstep, voffB); PG8_STAGE(PG8_SA(0, 0), a2, voffA);
            PG8_WAIT_V(8); PG8_WAIT_L(0); PG8_BAR; PG8_MMA(1, 0, At, B0); PG8_MMA(1, 1, At, B1); PG8_BAR; PG8_SCHED;
            PG8_LDB(B0, 1, 0); PG8_LDB(B1, 1, 1); PG8_SCHED; PG8_LDA(At, 1, 0); PG8_STAGE(PG8_SA(0, 1), a2 + hstep, voffA);
            PG8_WAIT_V(8); PG8_WAIT_L(0); PG8_BAR; PG8_MMA(0, 0, At, B0); PG8_MMA(0, 1, At, B1); PG8_BAR; PG8_SCHED;
            PG8_LDA(At, 1, 1); PG8_STAGE(PG8_SB(1, 0), b3, voffB); PG8_STAGE(PG8_SB(1, 1), b3 + hstep, voffB); PG8_STAGE(PG8_SA(1, 0), a3, voffA);
            PG8_WAIT_V(8); PG8_WAIT_L(0); PG8_BAR; PG8_MMA(1, 0, At, B0); PG8_MMA(1, 1, At, B1); PG8_BAR; PG8_SCHED;
            } else {
            PG8_LDB(B0, 0, 0); PG8_SCHED; PG8_LDA(At, 0, 0); PG8_STAGE(PG8_SA(1, 1), a1 + hstep, voffA);
            PG8_WAIT_L(8); PG8_BAR; PG8_WAIT_L(0); PG8_MMA(0, 0, At, B0); PG8_BAR; PG8_SCHED;
            PG8_LDB(B1, 0, 1); PG8_STAGE(PG8_SB(0, 0), b2, voffB);
            PG8_BAR; PG8_WAIT_L(0); PG8_MMA(0, 1, At, B1); PG8_BAR;
            PG8_LDA(At, 0, 1); PG8_STAGE(PG8_SA(0, 0), a2, voffA);
            PG8_BAR; PG8_WAIT_L(0); PG8_MMA(1, 0, At, B0); PG8_BAR; PG8_SCHED;
            PG8_STAGE(PG8_SB(0, 1), b2 + hstep, voffB);
            PG8_WAIT_V(6); PG8_BAR; PG8_MMA(1, 1, At, B1); PG8_BAR;
            PG8_LDB(B0, 1, 0); PG8_SCHED; PG8_LDA(At, 1, 0); PG8_STAGE(PG8_SA(0, 1), a2 + hstep, voffA);
            PG8_WAIT_L(8); PG8_BAR; PG8_WAIT_L(0); PG8_MMA(0, 0, At, B0); PG8_BAR; PG8_SCHED;
            PG8_LDB(B1, 1, 1); PG8_STAGE(PG8_SB(1, 0), b3, voffB);
            PG8_BAR; PG8_WAIT_L(0); PG8_MMA(0, 1, At, B1); PG8_BAR;
            PG8_LDA(At, 1, 1); PG8_STAGE(PG8_SA(1, 0), a3, voffA);
            PG8_BAR; PG8_WAIT_L(0); PG8_MMA(1, 0, At, B0); PG8_BAR; PG8_SCHED;
            PG8_STAGE(PG8_SB(1, 1), b3 + hstep, voffB);
            PG8_WAIT_V(6); PG8_BAR; PG8_MMA(1, 1, At, B1); PG8_BAR;
            }
        }
        if constexpr (ALIGN_EPI) { if (wr == 0) PG8_BAR; }
        if constexpr (!Epi::AFTER_DRAIN) { E(acc, cur, wr, wc, fr, fq); S.done(cur); }
        if (!has_next) break;
#pragma unroll
        for (int a = 0; a < 2; ++a)
#pragma unroll
            for (int b = 0; b < 2; ++b)
#pragma unroll
                for (int m = 0; m < 4; ++m)
#pragma unroll
                    for (int n = 0; n < 2; ++n) acc[a][b][m][n] = (f32x4){0.f, 0.f, 0.f, 0.f};
        cur = nxt; cA = nA; cB = nB; ++ui;
        if constexpr (ALIGN_EPI) { if (wr == 1) PG8_BAR; }
    }
    PG8_WAIT_V(0);
    if constexpr (!ALIGN_EPI) { if (wr == 0) PG8_BAR; }
    PG8_BAR;
    if constexpr (Epi::AFTER_DRAIN) { E.fused(acc, cur, wr, wc, fr, fq, lds, wid, lane); S.done(cur); }
#undef PG8_SA
#undef PG8_SB
#undef PG8_STAGE
#undef PG8_LDA
#undef PG8_LDB
#undef PG8_MMA
#undef PG8_WAIT_V
#undef PG8_WAIT_L
#undef PG8_BAR
#undef PG8_SCHED
}
}
#define GAS __attribute__((address_space(1)))
#define LAS __attribute__((address_space(3)))
typedef unsigned short bf16;
typedef unsigned v4u __attribute__((ext_vector_type(4)));
typedef unsigned v2u __attribute__((ext_vector_type(2)));
typedef float f32x4 __attribute__((ext_vector_type(4)));
typedef float f32x2 __attribute__((ext_vector_type(2)));
typedef float f32x16 __attribute__((ext_vector_type(16)));
typedef short bf16x8 __attribute__((ext_vector_type(8)));
typedef short s16x4 __attribute__((ext_vector_type(4)));
typedef GAS unsigned gu32;
typedef GAS unsigned long long gu64;
#define RLX_AGENT __ATOMIC_RELAXED, __HIP_MEMORY_SCOPE_AGENT
#define LDS_WAIT() asm volatile("s_waitcnt lgkmcnt(0)" ::: "memory")
#define VM_WAIT() asm volatile("s_waitcnt vmcnt(0)" ::: "memory")
#define WG_BAR() asm volatile("s_waitcnt vmcnt(0) lgkmcnt(0)\n\ts_barrier" ::: "memory")
#define LDS_BAR() asm volatile("s_waitcnt lgkmcnt(0)\n\ts_barrier" ::: "memory")
__device__ __forceinline__ unsigned f2bf(float f) { unsigned u = __builtin_bit_cast(unsigned, f); return (u + 0x7fffu + ((u >> 16) & 1u)) >> 16; }
__device__ __forceinline__ unsigned pk2(float lo, float hi) { return f2bf(lo) | (f2bf(hi) << 16); }
__device__ __forceinline__ float bf2f(unsigned short b) { return __builtin_bit_cast(float, (unsigned)b << 16); }
__device__ __forceinline__ float bflo(unsigned w) { return __builtin_bit_cast(float, w << 16); }
__device__ __forceinline__ float bfhi(unsigned w) { return __builtin_bit_cast(float, w & 0xffff0000u); }
__device__ __forceinline__ float wave_sum(float v) {
#pragma unroll
    for (int o = 1; o < 64; o <<= 1) v += __shfl_xor(v, o);
    return v;
}
constexpr float LOG2E = 1.4426950408889634f;
__device__ __forceinline__ float fast_exp(float x) { return __builtin_amdgcn_exp2f(x * LOG2E); }
__device__ __forceinline__ float log_sigmoid(float z) { return fminf(z, 0.f) - log1pf(expf(-fabsf(z))); }
#define XB_TMO      128
#define XB_XCNT(j)  (256  + 64 * (j))
#define XB_XSUB(j)  (1280 + 64 * (j))
#define XB_XGEN(j)  (2304 + 64 * (j))
#define XB_TOP      3328
#define XB_TOPGEN   3392
#define XCD_BAR_WORDS 3456
#define XB_SPIN_CAP (1u << 18)

__device__ __forceinline__ unsigned xb_ld(unsigned* p)              { return __hip_atomic_load(p, __ATOMIC_RELAXED, __HIP_MEMORY_SCOPE_AGENT); }
__device__ __forceinline__ unsigned xb_add(unsigned* p, unsigned v) { return __hip_atomic_fetch_add(p, v, __ATOMIC_RELAXED, __HIP_MEMORY_SCOPE_AGENT); }
__device__ __forceinline__ unsigned xb_xcc_id() { return (unsigned)__builtin_amdgcn_s_getreg((3 << 11) | 20) & 0xFu; }
#define XB_SPIN(cond, bar) do { unsigned _sp = 0; while (cond) { __builtin_amdgcn_s_sleep(1); \
    if ((++_sp & 255u) == 0u) { if (xb_ld(&(bar)[XB_TMO])) break; if (_sp > XB_SPIN_CAP) { atomicAdd(&(bar)[XB_TMO], 1u); break; } } } } while (0)

struct XcdBarrier {
    unsigned* bar; unsigned x;
    volatile LAS unsigned* st;
};

__device__ __forceinline__ XcdBarrier xcd_barrier_post(unsigned* bar, volatile LAS unsigned* st) {
    XcdBarrier b; b.bar = bar; b.x = xb_xcc_id(); b.st = st;
    if (threadIdx.x == 0) (void)xb_add(&bar[XB_XCNT(b.x)], 1u);
    return b;
}
__device__ __forceinline__ void xcd_barrier_complete(unsigned* bar, unsigned x, unsigned& nloc, unsigned& nx) {
    const unsigned G = gridDim.x * gridDim.y * gridDim.z;
    unsigned sum, cnt, mine, sp = 0u;
    for (;;) {
        sum = 0u; cnt = 0u; mine = 0u;
#pragma unroll
        for (unsigned j = 0; j < 16; ++j) { const unsigned c = xb_ld(&bar[XB_XCNT(j)]); sum += c; cnt += (c > 0u) ? 1u : 0u; mine = (j == x) ? c : mine; }
        if (sum == G) break;
        __builtin_amdgcn_s_sleep(1);
        if ((++sp & 255u) == 0u) { if (xb_ld(&bar[XB_TMO])) break; if (sp > XB_SPIN_CAP) { atomicAdd(&bar[XB_TMO], 1u); break; } }
    }
    nloc = mine > 0u ? mine : 1u; nx = cnt > 0u ? cnt : 1u;
}

__device__ __forceinline__ void xcd_barrier(const XcdBarrier& b) {
    asm volatile("s_waitcnt vmcnt(0)" ::: "memory");
    __syncthreads();
    if (threadIdx.x == 0) {
        unsigned* bar = b.bar;
        __builtin_amdgcn_s_waitcnt(0);
        unsigned nloc = b.st[0], nx = b.st[1];
        if (nloc == 0u) { xcd_barrier_complete(bar, b.x, nloc, nx); b.st[0] = nloc; b.st[1] = nx; }
        const unsigned old = xb_add(&bar[XB_XSUB(b.x)], 1u);
        const unsigned gen = old / nloc;
        if (old + 1u == (gen + 1u) * nloc) {
            __builtin_amdgcn_fence(__ATOMIC_RELEASE, "agent");
            asm volatile("s_waitcnt vmcnt(0)" ::: "memory");
            const unsigned og = xb_add(&bar[XB_TOP], 1u);
            const unsigned tg = og / nx;
            if (og + 1u == (tg + 1u) * nx) xb_add(&bar[XB_TOPGEN], 1u);
            else XB_SPIN(xb_ld(&bar[XB_TOPGEN]) == tg, bar);
            __builtin_amdgcn_fence(__ATOMIC_ACQUIRE, "agent");
            xb_add(&bar[XB_XGEN(b.x)], 1u);
            asm volatile("s_waitcnt vmcnt(0)" ::: "memory");
        } else {
            XB_SPIN(xb_ld(&bar[XB_XGEN(b.x)]) == gen, bar);
            __builtin_amdgcn_fence(__ATOMIC_ACQUIRE, "agent");
            asm volatile("s_waitcnt vmcnt(0)" ::: "memory");
        }
    }
    __syncthreads();
}
constexpr int NWAVES = 8, NTHR = 512;
constexpr int BATCH = 2, SEQ = 8192, DM = 1024, M = BATCH * SEQ, DEPTH = 4;
constexpr int W_AB = 3672, W_CD = 3080, FFD = 2816, FFE = 3584, NEXP = 8;
constexpr int NAB = 3840, NCD = 3072;
constexpr float ALPHA = 1.6817928305074290f, LN_EPS = 1e-5f;
constexpr int MOE_ROWS = 34816;
constexpr size_t MiB = 1u << 20;
constexpr size_t WS_CTL = 0, CTL_ZERO_BYTES = 1 * MiB;
constexpr size_t WS_X = 1 * MiB, WS_XB = 65 * MiB, WS_MIX = 97 * MiB, WS_Y = 129 * MiB, WS_ACT = 161 * MiB;
constexpr size_t WS_EVW = 289 * MiB, EV_WAB = 0, EV_WO = 8 * MiB, EV_W13 = 10 * MiB, EV_W2 = 21 * MiB;
constexpr size_t WS_MASK = 317 * MiB;
constexpr size_t WS_MISC = 349 * MiB, MI_FL = 0, MI_RTE = 1 * MiB, MI_RTR1 = MI_RTE + 65536, MI_RTR2 = MI_RTR1 + 65536, MI_RTG = MI_RTR2 + 65536, MI_ROW1 = MI_RTG + 131072, MI_ROW2 = MI_ROW1 + 65536, MI_SLC = MI_ROW2 + 65536  ;
constexpr size_t WS_BIG = 353 * MiB;
constexpr size_t BG_WCD = 0, BG_WOD = 6 * MiB, BG_W13M = 8 * MiB, BG_W2M = 120 * MiB, BG_H = 176 * MiB, BG_XG = 414 * MiB, BG_END = 482 * MiB;
constexpr size_t BG_SC = 176 * MiB;
constexpr size_t BG_DS = BG_END, BG_DEC = BG_END + 32 * MiB, BG_QS = 434 * MiB, BG_SP = 442 * MiB;
constexpr size_t WS_END = WS_BIG + BG_END + 33 * MiB;
constexpr size_t SCB = (size_t)4096 * 128 * 129 / 2;
static_assert(BG_SC + 2 * SCB * 4 <= BG_END, "scores fit");
constexpr int CW_TMO = 0, CW_BAR = 4096, CW_Q = 8192, CW_CNT = 12288;
constexpr int RING_BYTES = 131072;
constexpr int LDSCTL_OFF = RING_BYTES, MISC_OFF = LDSCTL_OFF + 320;
constexpr int LDS_BYTES = 147456;
struct Frame {
    LAS unsigned char* lds;
    volatile LAS unsigned* MISC;
    gu32* ctl;
    unsigned char* ws;
    int tid, lane, wave;
    int vcu, G;
};
__device__ __forceinline__ int sel8i(int e, int a0, int a1, int a2, int a3, int a4, int a5, int a6, int a7) {
    int r = a0; r = e == 1 ? a1 : r; r = e == 2 ? a2 : r; r = e == 3 ? a3 : r; r = e == 4 ? a4 : r; r = e == 5 ? a5 : r; r = e == 6 ? a6 : r; r = e == 7 ? a7 : r; return r; }
__device__ __forceinline__ float sel8f(int e, const float (&a)[8]) {
    float r = a[0]; r = e == 1 ? a[1] : r; r = e == 2 ? a[2] : r; r = e == 3 ? a[3] : r; r = e == 4 ? a[4] : r; r = e == 5 ? a[5] : r; r = e == 6 ? a[6] : r; r = e == 7 ? a[7] : r; return r; }
__device__ __forceinline__ int q_issue(Frame& F, gu32* head) { unsigned v = 0u; if (F.tid == 0) v = __hip_atomic_fetch_add(head, 1u, RLX_AGENT); return (int)v; }
__device__ __forceinline__ int q_share(Frame& F, int v) {
    volatile LAS int* slot = (volatile LAS int*)(F.lds + LDSCTL_OFF + 64);
    WG_BAR();
    if (F.tid == 0) *slot = v;
    WG_BAR();
    return *slot;
}
__device__ __forceinline__ void conv_item(const float* __restrict__ W, int ldw, int k0, int sc4, bf16* WT, int ldt, int drow0, LAS unsigned* P, int lane) {
    const int n4 = (lane & 15) * 4, kq = lane >> 4;
    f32x4 a[8], b[8];
    if (sc4 >= 0) {
#pragma unroll
        for (int i = 0; i < 8; ++i) { const float* p = W + (size_t)(k0 + 8 * i + 2 * kq) * ldw + sc4; a[i] = *(const GAS f32x4*)p; b[i] = *(const GAS f32x4*)(p + ldw); }
    } else {
#pragma unroll
        for (int i = 0; i < 8; ++i) { a[i] = (f32x4){0.f, 0.f, 0.f, 0.f}; b[i] = a[i]; }
    }
#pragma unroll
    for (int i = 0; i < 8; ++i) { v4u w; w.x = pk2(a[i].x, b[i].x); w.y = pk2(a[i].y, b[i].y); w.z = pk2(a[i].z, b[i].z); w.w = pk2(a[i].w, b[i].w);
        *(LAS v4u*)(P + (4 * i + kq) * 68 + n4) = w; }
    LDS_WAIT();
#pragma unroll
    for (int j = 0; j < 8; ++j) { const int ch = j * 64 + lane, n = ch >> 3, c = ch & 7; const LAS unsigned* s = P + (4 * c) * 68 + n;
        v4u o; o.x = s[0]; o.y = s[68]; o.z = s[136]; o.w = s[204];
        *(GAS v4u*)(WT + (size_t)(drow0 + n) * ldt + k0 + 8 * c) = o; }
    LDS_WAIT();
}
__device__ __forceinline__ void conv_matrix(Frame& F, int kind, const float* W, const float* W3, int ldw, int K, bf16* WT, int nrows) {
    LAS unsigned* scr = (LAS unsigned*)(F.lds + F.wave * 8704);
    const int gw = F.vcu * NWAVES + F.wave, NGW = F.G * NWAVES;
    const int ngrp = nrows / 64, nkb = K / 64, nitems = ngrp * nkb;
    for (int it = gw; it < nitems; it += NGW) {
        const int grp = it % ngrp, kb = it / ngrp; const int r = grp * 64 + (F.lane & 15) * 4;
        int sc = r; const float* src = W;
        if (kind == 1) { sc = r < 1536 ? r : (r < 3584 ? r + 16 : (r < 3600 ? 1536 + (r - 3584) : (r < 3672 ? r : -1))); }
        else if (kind == 2) { sc = r < 1536 ? r : r + 8; }
        else if (kind == 3) { const int j = r >> 8, w = r & 255; sc = 128 * j + (w & 127); src = (w < 128) ? W : W3; }
        conv_item(src, ldw, kb * 64, sc, WT, K, grp * 64, scr, F.lane);
    }
}
__device__ __forceinline__ void conv_odd_item(Frame& F, int lane_, int idx, const float* w1m, const float* w3m, const float* w2m, const float* wcd, const float* wod, unsigned char* big) {
    LAS unsigned* scr = (LAS unsigned*)(F.lds + F.wave * 8704);
    const int l4 = (lane_ & 15) * 4;
    if (idx < 14336) { const int e = idx / 1792, it = idx % 1792, grp = it % 112, kb = it / 112; const int r = grp * 64 + l4; const int jj = r >> 8, w = r & 255;
        const size_t eo = (size_t)e * DM * FFE;
        conv_item((w < 128 ? w1m : w3m) + eo, FFE, kb * 64, 128 * jj + (w & 127), (bf16*)(big + BG_W13M) + (size_t)e * 2 * FFE * DM, DM, grp * 64, scr, lane_); }
    else if (idx < 21504) { const int i2 = idx - 14336, e = i2 / 896, it = i2 % 896, grp = it % 16, kb = it / 16;
        conv_item(w2m + (size_t)e * DM * FFE, DM, kb * 64, grp * 64 + l4, (bf16*)(big + BG_W2M) + (size_t)e * DM * FFE, FFE, grp * 64, scr, lane_); }
    else if (idx < 22272) { const int it = idx - 21504, grp = it % 48, kb = it / 48; const int r = grp * 64 + l4;
        conv_item(wcd, W_CD, kb * 64, r < 1536 ? r : r + 8, (bf16*)(big + BG_WCD), DM, grp * 64, scr, lane_); }
    else { const int it = idx - 22272, grp = it % 16, kb = it / 16;
        conv_item(wod, DM, kb * 64, grp * 64 + l4, (bf16*)(big + BG_WOD), DM, grp * 64, scr, lane_); }
}
__device__ __forceinline__ void conv_even_item(Frame& F, int lane_, int idx, const float* wab, const float* wo, const float* w1, const float* w3, const float* w2, unsigned char* evw) {
    LAS unsigned* scr = (LAS unsigned*)(F.lds + F.wave * 8704);
    const int l4 = (lane_ & 15) * 4;
    if (idx < 960) { const int grp = idx % 60, kb = idx / 60; const int r = grp * 64 + l4;
        const int sc = r < 1536 ? r : (r < 3584 ? r + 16 : (r < 3600 ? 1536 + (r - 3584) : (r < 3672 ? r : -1)));
        conv_item(wab, W_AB, kb * 64, sc, (bf16*)(evw + EV_WAB), DM, grp * 64, scr, lane_); }
    else if (idx < 1216) { const int it = idx - 960, grp = it % 16, kb = it / 16;
        conv_item(wo, DM, kb * 64, grp * 64 + l4, (bf16*)(evw + EV_WO), DM, grp * 64, scr, lane_); }
    else if (idx < 2624) { const int it = idx - 1216, grp = it % 88, kb = it / 88; const int r = grp * 64 + l4; const int jj = r >> 8, w = r & 255;
        conv_item(w < 128 ? w1 : w3, FFD, kb * 64, 128 * jj + (w & 127), (bf16*)(evw + EV_W13), DM, grp * 64, scr, lane_); }
    else if (idx < 3328) { const int it = idx - 2624, grp = it % 16, kb = it / 16;
        conv_item(w2, DM, kb * 64, grp * 64 + l4, (bf16*)(evw + EV_W2), FFD, grp * 64, scr, lane_); }
}
__device__ __forceinline__ void rows_to_bf16(Frame& F, const float* x, bf16* xb) {
    const int gw = F.vcu * NWAVES + F.wave, NGW = F.G * NWAVES;
    for (int m = gw; m < M; m += NGW) {
        const GAS f32x4* xr = (const GAS f32x4*)(x + (size_t)m * DM) + F.lane; GAS v2u* o = (GAS v2u*)(xb + (size_t)m * DM) + F.lane;
#pragma unroll
        for (int j = 0; j < 4; ++j) { const f32x4 v = xr[64 * j]; v2u w; w.x = pk2(v.x, v.y); w.y = pk2(v.z, v.w); o[64 * j] = w; }
    }
}
__device__ __forceinline__ void ln_phase(Frame& F, const float* xres, const bf16* Y, int ymode, const float* g, const float* bvec, float* xout, bf16* xbout,
                                         int proj, const float* pw, const float* pb, gu32* cnt) {
    LAS float* W8 = (LAS float*)(F.lds);
    volatile LAS int* tokE = (volatile LAS int*)(F.lds + 32768);
    const int* row1 = (const int*)(F.ws + WS_MISC + MI_ROW1); const int* row2 = (const int*)(F.ws + WS_MISC + MI_ROW2);
    float* rtg = (float*)(F.ws + WS_MISC + MI_RTG); int* rte = (int*)(F.ws + WS_MISC + MI_RTE); int* rtr1 = (int*)(F.ws + WS_MISC + MI_RTR1); int* rtr2 = (int*)(F.ws + WS_MISC + MI_RTR2);
    float* fl = (float*)(F.ws + WS_MISC + MI_FL);
    if (proj != 0) { for (int i8 = F.tid; i8 < 8192; i8 += NTHR) { const int i = i8 >> 3, e = i8 & 7; const float w = (proj == 1) ? pw[i8] : pw[(size_t)i * W_CD + 1536 + e];
            const int slot = (4 * (i >> 8) + (i & 3)) * 64 + ((i & 255) >> 2); W8[(e >> 2) * 4096 + slot * 4 + (e & 3)] = w; } }
    WG_BAR();
    const int lane = F.lane;
    for (int slab = blockIdx.x; slab < M / 64; slab += F.G) {
        const int mw = slab * 64 + F.wave * 8;
        int r1v = 0, r2v = 0; float g1v = 0.f, g2v = 0.f;
        if (ymode != 0) { const int mm = mw + (lane & 7); r1v = row1[mm]; r2v = row2[mm]; g1v = rtg[2 * mm]; g2v = rtg[2 * mm + 1]; }
        f32x4 xn[4]; v2u an[4], cn[4];
#define LN_LOAD(rr_) do { const int m_ = mw + (rr_); const GAS f32x4* xr_ = (const GAS f32x4*)(xres + (size_t)m_ * DM) + lane; \
            if (ymode == 0) { const GAS v2u* yr_ = (const GAS v2u*)(Y + (size_t)m_ * DM) + lane; \
                _Pragma("unroll") for (int j = 0; j < 4; ++j) { xn[j] = xr_[64 * j]; an[j] = yr_[64 * j]; cn[j] = (v2u){0u, 0u}; } } \
            else { const int r1_ = __shfl(r1v, (rr_)), r2_ = __shfl(r2v, (rr_)); const GAS v2u* y1_ = (const GAS v2u*)(Y + (size_t)r1_ * DM) + lane; const GAS v2u* y2_ = (const GAS v2u*)(Y + (size_t)r2_ * DM) + lane; \
                _Pragma("unroll") for (int j = 0; j < 4; ++j) { xn[j] = xr_[64 * j]; an[j] = y1_[64 * j]; cn[j] = y2_[64 * j]; } } } while (0)
        LN_LOAD(0);
        for (int rr = 0; rr < 8; ++rr) {
            const int m = mw + rr;
            f32x4 xc[4]; v2u ac[4], cc[4];
#pragma unroll
            for (int j = 0; j < 4; ++j) { xc[j] = xn[j]; ac[j] = an[j]; cc[j] = cn[j]; }
            if (rr + 1 < 8) LN_LOAD(rr + 1);
            f32x4 v[4];
            if (ymode == 0) {
#pragma unroll
                for (int j = 0; j < 4; ++j) { const f32x4 xv = xc[j]; const v2u yw = ac[j];
                    v[j].x = ALPHA * xv.x + bflo(yw.x); v[j].y = ALPHA * xv.y + bfhi(yw.x); v[j].z = ALPHA * xv.z + bflo(yw.y); v[j].w = ALPHA * xv.w + bfhi(yw.y); }
            } else {
                const float g1 = __shfl(g1v, rr), g2 = __shfl(g2v, rr);
#pragma unroll
                for (int j = 0; j < 4; ++j) { const f32x4 xv = xc[j]; const v2u a = ac[j], c = cc[j];
                    v[j].x = ALPHA * xv.x + (g1 * bflo(a.x) + g2 * bflo(c.x)); v[j].y = ALPHA * xv.y + (g1 * bfhi(a.x) + g2 * bfhi(c.x));
                    v[j].z = ALPHA * xv.z + (g1 * bflo(a.y) + g2 * bflo(c.y)); v[j].w = ALPHA * xv.w + (g1 * bfhi(a.y) + g2 * bfhi(c.y)); }
            }
            float s = 0.f;
#pragma unroll
            for (int j = 0; j < 4; ++j) s += (v[j].x + v[j].y) + (v[j].z + v[j].w);
            const float mean = wave_sum(s) * (1.f / DM); float s2 = 0.f;
#pragma unroll
            for (int j = 0; j < 4; ++j) { v[j] = v[j] - mean; s2 += (v[j].x * v[j].x + v[j].y * v[j].y) + (v[j].z * v[j].z + v[j].w * v[j].w); }
            const float rstd = 1.f / sqrtf(wave_sum(s2) * (1.f / DM) + LN_EPS);
            GAS f32x4* xo = (GAS f32x4*)(xout + (size_t)m * DM) + lane; GAS v2u* bo = (GAS v2u*)(xbout + (size_t)m * DM) + lane;
#pragma unroll
            for (int j = 0; j < 4; ++j) { const f32x4 gg = ((const GAS f32x4*)g)[lane + 64 * j], bb = ((const GAS f32x4*)bvec)[lane + 64 * j];
                v[j] = v[j] * rstd * gg + bb; xo[64 * j] = v[j]; v2u w; w.x = pk2(v[j].x, v[j].y); w.y = pk2(v[j].z, v[j].w); bo[64 * j] = w; }
            if (proj != 0) {
                float a8[8];
#pragma unroll
                for (int e = 0; e < 8; ++e) a8[e] = 0.f;
#pragma unroll
                for (int j = 0; j < 4; ++j)
#pragma unroll
                    for (int c = 0; c < 4; ++c) { const int slot = (4 * j + c) * 64 + lane; const f32x4 w0 = *(const LAS f32x4*)(W8 + slot * 4), w1 = *(const LAS f32x4*)(W8 + 4096 + slot * 4); const float xv = v[j][c];
                        a8[0] += xv * w0.x; a8[1] += xv * w0.y; a8[2] += xv * w0.z; a8[3] += xv * w0.w; a8[4] += xv * w1.x; a8[5] += xv * w1.y; a8[6] += xv * w1.z; a8[7] += xv * w1.w; }
#pragma unroll
                for (int e = 0; e < 8; ++e) a8[e] = wave_sum(a8[e]);
                if (proj == 2) {
                    const int e8 = lane & 7; float z = a8[0]; z = e8 == 1 ? a8[1] : z; z = e8 == 2 ? a8[2] : z; z = e8 == 3 ? a8[3] : z; z = e8 == 4 ? a8[4] : z; z = e8 == 5 ? a8[5] : z; z = e8 == 6 ? a8[6] : z; z = e8 == 7 ? a8[7] : z; z += pb[e8];
                    if (lane < 8) fl[(size_t)m * 8 + lane] = log_sigmoid(z);
                } else {
                    int e1 = 0; float v1 = a8[0];
#pragma unroll
                    for (int e = 1; e < 8; ++e) if (a8[e] > v1) { v1 = a8[e]; e1 = e; }
                    int e2 = -1; float v2 = -INFINITY;
#pragma unroll
                    for (int e = 0; e < 8; ++e) if (e != e1 && (e2 < 0 || a8[e] > v2)) { v2 = a8[e]; e2 = e; }
                    const float ex = __expf(v2 - v1); const float g1 = 1.f / (1.f + ex), g2 = ex / (1.f + ex);
                    if (lane == 0) { rtg[2 * m] = g1; rtg[2 * m + 1] = g2; tokE[F.wave * 8 + rr] = e1 | (e2 << 8); }
                }
            }
        }
        if (proj == 1) {
            LDS_BAR();
            if (F.wave == 0) {
                const int ee = tokE[lane]; const int e1 = ee & 255, e2 = ee >> 8; int r1 = 0, r2 = 0;
                const unsigned long long lt = (1ull << lane) - 1ull;
                int mycnt = 0, p1 = 0, p2 = 0;
#pragma unroll
                for (int e = 0; e < 8; ++e) {
                    const unsigned long long b1 = __ballot(e1 == e), b2 = __ballot(e2 == e);
                    const int c = __popcll(b1) + __popcll(b2), pos = __popcll(b1 & lt) + __popcll(b2 & lt);
                    mycnt = (lane == e) ? c : mycnt; p1 = (e1 == e) ? pos : p1; p2 = (e2 == e) ? pos : p2;
                }
                if (lane < 8) ((int*)(F.ws + WS_MISC + MI_SLC))[slab * 8 + lane] = mycnt;
                r1 = p1; r2 = p2;
                const int m = slab * 64 + lane; rte[m] = ee; rtr1[m] = r1; rtr2[m] = r2;
            }
            LDS_BAR();
        }
    }
}
#undef LN_LOAD
__device__ __forceinline__ void moe_tiles(const gu32* cnt, int (&ts)[9]) {
    ts[0] = 0;
#pragma unroll
    for (int e = 0; e < 8; ++e) { const int c = (int)__hip_atomic_load(cnt + 64 * e, RLX_AGENT); ts[e + 1] = ts[e] + ((c + 255) >> 8); }
}
__device__ __forceinline__ void scatter_phase(Frame& F, const bf16* xb, bf16* xg, gu32* cnt) {
    LAS int* base = (LAS int*)(F.lds); LAS int* wtot = (LAS int*)(F.lds + 8192);
    const int* slc = (const int*)(F.ws + WS_MISC + MI_SLC);
    { const int e = F.tid & 7, sg = F.tid >> 3;
      int c0 = slc[(4 * sg + 0) * 8 + e], c1 = slc[(4 * sg + 1) * 8 + e], c2 = slc[(4 * sg + 2) * 8 + e], c3 = slc[(4 * sg + 3) * 8 + e];
      int incl = c0 + c1 + c2 + c3; const int own = incl;
#pragma unroll
      for (int o = 8; o < 64; o <<= 1) { const int t = __shfl_up(incl, o); if (F.lane >= o) incl += t; }
      if (F.lane >= 56) wtot[F.wave * 8 + e] = incl;
      LDS_BAR();
      int pre = incl - own;
#pragma unroll
      for (int w = 0; w < 8; ++w) if (w < F.wave) pre += wtot[w * 8 + e];
      base[(4 * sg + 0) * 8 + e] = pre; base[(4 * sg + 1) * 8 + e] = pre + c0; base[(4 * sg + 2) * 8 + e] = pre + c0 + c1; base[(4 * sg + 3) * 8 + e] = pre + c0 + c1 + c2;
      LDS_BAR(); }
    int ts[9]; ts[0] = 0;
#pragma unroll
    for (int e = 0; e < 8; ++e) { int tot = 0;
#pragma unroll
        for (int w = 0; w < 8; ++w) tot += wtot[w * 8 + e];
        ts[e + 1] = ts[e] + ((tot + 255) >> 8);
        if (blockIdx.x == 0 && F.tid == 0) __hip_atomic_store(cnt + 64 * e, (unsigned)tot, RLX_AGENT); }
    const int* rte = (const int*)(F.ws + WS_MISC + MI_RTE); const int* rtr1 = (const int*)(F.ws + WS_MISC + MI_RTR1); const int* rtr2 = (const int*)(F.ws + WS_MISC + MI_RTR2);
    int* row1 = (int*)(F.ws + WS_MISC + MI_ROW1); int* row2 = (int*)(F.ws + WS_MISC + MI_ROW2);
    const int gw = F.vcu * NWAVES + F.wave, NGW = F.G * NWAVES;
    for (int m = gw; m < M; m += NGW) {
        const int ee = rte[m]; const int e1 = ee & 255, e2 = ee >> 8; const int slab = m >> 6;
        const int ra = 256 * sel8i(e1, ts[0], ts[1], ts[2], ts[3], ts[4], ts[5], ts[6], ts[7]) + base[slab * 8 + e1] + rtr1[m];
        const int rb = 256 * sel8i(e2, ts[0], ts[1], ts[2], ts[3], ts[4], ts[5], ts[6], ts[7]) + base[slab * 8 + e2] + rtr2[m];
        const GAS v4u* src = (const GAS v4u*)(xb + (size_t)m * DM) + F.lane;
        const v4u a = src[0], b = src[64];
        GAS v4u* d1 = (GAS v4u*)(xg + (size_t)ra * DM) + F.lane; GAS v4u* d2 = (GAS v4u*)(xg + (size_t)rb * DM) + F.lane;
        d1[0] = a; d1[64] = b; d2[0] = a; d2[64] = b;
        if (F.lane == 0) { row1[m] = ra; row2[m] = rb; }
    }
}
namespace att {
constexpr int SLOTB = 8192, NSLOT = 3;
constexpr int L_K = 0, L_V = NSLOT * SLOTB, L_WS = 2 * NSLOT * SLOTB, L_OST = L_WS + 8 * 256, L_END = L_OST + 8 * 4096;
constexpr int L_WMIN = L_END;
constexpr int L_TAB = L_END + 64;
constexpr int PITCH = 512;
constexpr int PSTRIDE = 8 * 72;
__device__ __forceinline__ int crow(int r, int hi) { return (r & 3) + 8 * (r >> 2) + 4 * hi; }
__device__ __forceinline__ void glds16(const void* gsrc, unsigned lds_dst) { unsigned keep;
    asm volatile("s_mov_b32 %0, m0\n\ts_mov_b32 m0, %2\n\ts_nop 0\n\tglobal_load_lds_dwordx4 %1, off\n\ts_mov_b32 m0, %0" : "=&s"(keep) : "v"(gsrc), "s"(lds_dst) : "memory"); }
__device__ __forceinline__ float max3f(float a, float b, float c) { return __builtin_fmaxf(__builtin_fmaxf(a, b), c); }
typedef __bf16 bf16x2_t __attribute__((ext_vector_type(2)));
__device__ __forceinline__ unsigned cvtpk_s(float lo, float hi) { f32x2 v = {lo, hi}; bf16x2_t b = __builtin_convertvector(v, bf16x2_t); return __builtin_bit_cast(unsigned, b); }
#define ATT_WAIT_BAR(N) asm volatile("s_waitcnt vmcnt(" #N ") lgkmcnt(0)\n\ts_barrier" ::: "memory")
__device__ __forceinline__ void qkt(f32x16& p0, f32x16& p1, const LAS unsigned char* Kslot, const bf16x8* qr, int r32, int hi) {
    const LAS unsigned char* kb = Kslot + hi * 1024 + r32 * 16;
    const f32x16 z = {};
    bf16x8 kf[8];
#pragma unroll
    for (int d0 = 0; d0 < 4; ++d0) { kf[2 * d0] = *(const LAS bf16x8*)(kb + d0 * 2048); kf[2 * d0 + 1] = *(const LAS bf16x8*)(kb + d0 * 2048 + 512); }
    __builtin_amdgcn_sched_barrier(0);
    p0 = __builtin_amdgcn_mfma_f32_32x32x16_bf16(kf[0], qr[0], z, 0, 0, 0); p1 = __builtin_amdgcn_mfma_f32_32x32x16_bf16(kf[1], qr[0], z, 0, 0, 0);
#pragma unroll
    for (int d0 = 1; d0 < 4; ++d0) { p0 = __builtin_amdgcn_mfma_f32_32x32x16_bf16(kf[2 * d0], qr[d0], p0, 0, 0, 0); p1 = __builtin_amdgcn_mfma_f32_32x32x16_bf16(kf[2 * d0 + 1], qr[d0], p1, 0, 0, 0); }
}
__device__ __forceinline__ float rowmax(const f32x16& p0, const f32x16& p1) {
    float a = max3f(p0[0], p0[1], p1[0]), b = max3f(p0[2], p0[3], p1[1]); a = max3f(a, p1[2], p1[3]);
#pragma unroll
    for (int r = 4; r < 16; r += 4) { a = max3f(a, p0[r], p0[r + 1]); b = max3f(b, p0[r + 2], p0[r + 3]); a = max3f(a, p1[r], p1[r + 1]); b = max3f(b, p1[r + 2], p1[r + 3]); }
    const float m = __builtin_fmaxf(a, b);
    auto rr = __builtin_amdgcn_permlane32_swap(__float_as_uint(m), __float_as_uint(m), false, false);
    return __builtin_fmaxf(__uint_as_float(rr[0]), __uint_as_float(rr[1]));
}
__device__ __forceinline__ void pv(f32x16* o, int vb, bf16x8 pa0, bf16x8 pa1, bf16x8 pa2, bf16x8 pa3) {
#pragma unroll
    for (int d0 = 0; d0 < 2; ++d0) { s16x4 lo[4], hi[4];
#pragma unroll
        for (int ks = 0; ks < 4; ++ks) {
            asm volatile("ds_read_b64_tr_b16 %0,%1 offset:%c2" : "=&v"(lo[ks]) : "v"(vb), "i"(d0 * 4096 + ks * 1024) : "memory");
            asm volatile("ds_read_b64_tr_b16 %0,%1 offset:%c2" : "=&v"(hi[ks]) : "v"(vb), "i"(d0 * 4096 + ks * 1024 + 512) : "memory"); }
        asm volatile("s_waitcnt lgkmcnt(0)" ::: "memory"); __builtin_amdgcn_sched_barrier(0);
#define ATT_PK(k) (bf16x8){lo[k][0], lo[k][1], lo[k][2], lo[k][3], hi[k][0], hi[k][1], hi[k][2], hi[k][3]}
        o[d0] = __builtin_amdgcn_mfma_f32_32x32x16_bf16(pa0, ATT_PK(0), o[d0], 0, 0, 0);
        o[d0] = __builtin_amdgcn_mfma_f32_32x32x16_bf16(pa1, ATT_PK(1), o[d0], 0, 0, 0);
        o[d0] = __builtin_amdgcn_mfma_f32_32x32x16_bf16(pa2, ATT_PK(2), o[d0], 0, 0, 0);
        o[d0] = __builtin_amdgcn_mfma_f32_32x32x16_bf16(pa3, ATT_PK(3), o[d0], 0, 0, 0);
#undef ATT_PK
    }
}
typedef __attribute__((address_space(3))) const char* lds_cptr;
typedef short v4i16_t __attribute__((ext_vector_type(4)));
__device__ __forceinline__ void kload2(bf16x8* kf, lds_cptr kp, int j) { kf[2 * j] = *(const LAS bf16x8*)(kp + j * 2048); kf[2 * j + 1] = *(const LAS bf16x8*)(kp + j * 2048 + 512); }
__device__ __forceinline__ s16x4 vtr(lds_cptr p) { return __builtin_bit_cast(s16x4, __builtin_amdgcn_ds_read_tr16_b64_v4i16((LAS v4i16_t*)p)); }
#define SBAR() __builtin_amdgcn_sched_barrier(0)
#define PIN(x) asm volatile("" : "+v"(x))
#define MFMA(a, b, c) __builtin_amdgcn_mfma_f32_32x32x16_bf16(a, b, c, 0, 0, 0)
template <class Hook>
__device__ __forceinline__ void attn_unit(Hook& hk, const bf16* Qh, const bf16* Kh, const bf16* Vh, bf16* Oh, long qrow0, int NT, LAS unsigned char* shm, int opitch) {
    int tid_ = threadIdx.x; asm volatile("" : "+v"(tid_)); const int tid = tid_, lane = tid & 63, r32 = lane & 31, hi = lane >> 5; const int wid = __builtin_amdgcn_readfirstlane(tid >> 6);
    const unsigned lds0 = (unsigned)(size_t)shm;
    LAS float* wsf = (LAS float*)(shm + L_WS) + wid * 64;
    constexpr long RSP = (long)Hook::RS * PITCH;
    const bf16* Qw = Qh + qrow0 * PITCH + (long)(wid * 32) * RSP;
    const bf16* ksrc = Kh + (long)lane * RSP + wid * 8;
    const bf16* vsrc = Vh + (long)(16 * (wid & 3) + (lane >> 2)) * RSP + (wid >> 2) * 32 + (lane & 3) * 8;
    const unsigned kdst = lds0 + L_K + wid * 1024, vdst = lds0 + L_V + wid * 1024;
#define DMA_K(t, slot) glds16(ksrc + hk.tile_row(t) * PITCH, (unsigned)__builtin_amdgcn_readfirstlane(kdst + (slot)))
#define DMA_V(t, slot) glds16(vsrc + hk.tile_row(t) * PITCH, (unsigned)__builtin_amdgcn_readfirstlane(vdst + (slot)))
    const lds_cptr vp0 = (lds_cptr)shm + L_V + ((lane >> 4) & 1) * 32 + (lane & 3) * 8 + (4 * hi + ((lane & 15) >> 2)) * 64;
    const lds_cptr kp0 = (lds_cptr)shm + L_K + hi * 1024 + r32 * 16;
    DMA_K(0, 0); DMA_V(0, 0); DMA_K(1, SLOTB);
    bf16x8 qr[4];
#pragma unroll
    for (int d0 = 0; d0 < 4; ++d0) qr[d0] = *(const bf16x8*)(Qw + (long)r32 * RSP + d0 * 16 + hi * 8);
    float mhat = 0.f, l_reg = 0.f; f32x16 o[2]; o[0] = f32x16{}; o[1] = f32x16{};
    f32x16 negm = f32x16{};
    if constexpr (Hook::PART_IN) {
        const float* pp = hk.part + (size_t)(wid * 32) * Hook::RS * PSTRIDE;
        mhat = pp[(size_t)r32 * Hook::RS * PSTRIDE]; l_reg = hi == 0 ? pp[(size_t)r32 * Hook::RS * PSTRIDE + 1] : 0.f;
#pragma unroll
        for (int r = 0; r < 16; ++r) { const float* pr = pp + (size_t)crow(r, hi) * Hook::RS * PSTRIDE + 8 + r32; o[0][r] = pr[0]; o[1][r] = pr[32]; negm[r] = -mhat; }
    }
    PIN(negm);
    bool resc = false;
    f32x16 pA0, pA1, pB0, pB1; bf16x8 kf[8]; s16x4 vlo[8], vhi[8]; v4u pw0, pw1, pw2, pw3;
    int sl_prev = 0, sl_cur = 0, sl_next = SLOTB;
#define ROT() do { sl_prev = sl_cur; sl_cur = sl_next; sl_next = (sl_next == 2 * SLOTB) ? 0 : sl_next + SLOTB; } while (0)
#define EX(v) __builtin_amdgcn_exp2f(v)
#define RESC() do { if (resc) { _Pragma("unroll") for (int d_ = 0; d_ < 2; ++d_) _Pragma("unroll") for (int r = 0; r < 16; ++r) o[d_][r] *= wsf[crow(r, hi)]; } } while (0)
    DMA_K(2, 2 * SLOTB);
    hk.prefetch(0, wid);
    ATT_WAIT_BAR(3);
    _Pragma("unroll") for (int d0 = 0; d0 < 4; ++d0) kload2(kf, kp0, d0);
    pA0 = MFMA(kf[0], qr[0], negm); pA1 = MFMA(kf[1], qr[0], negm); pA0 = MFMA(kf[2], qr[1], pA0); pA1 = MFMA(kf[3], qr[1], pA1);
    pA0 = MFMA(kf[4], qr[2], pA0); pA1 = MFMA(kf[5], qr[2], pA1); pA0 = MFMA(kf[6], qr[3], pA0); pA1 = MFMA(kf[7], qr[3], pA1);
    hk.apply(pA0, pA1, 0, r32, hi, wid);
    if constexpr (Hook::PART_IN) {
        const float rm = rowmax(pA0, pA1); const float dl = __builtin_fmaxf(rm, 0.f); mhat += dl; const float f = __builtin_amdgcn_exp2f(-dl); l_reg *= f;
        if (hi == 0) wsf[r32] = f;
        LDS_WAIT();
#pragma unroll
        for (int r = 0; r < 16; ++r) { const float fr_ = wsf[crow(r, hi)]; o[0][r] *= fr_; o[1][r] *= fr_; pA0[r] = EX(pA0[r] - dl); pA1[r] = EX(pA1[r] - dl); negm[r] = -mhat; }
        PIN(negm);
    } else { const float rm = rowmax(pA0, pA1); mhat = __builtin_fmaxf(rm, -1000.0f);
#pragma unroll
      for (int r = 0; r < 16; ++r) { pA0[r] = EX(pA0[r] - mhat); pA1[r] = EX(pA1[r] - mhat); negm[r] = -mhat; }
      PIN(negm); }
    hk.prefetch(1, wid);
    ATT_WAIT_BAR(0);
    DMA_K(3, 0); DMA_V(1, SLOTB); ROT();
    _Pragma("unroll") for (int d0 = 0; d0 < 4; ++d0) kload2(kf, kp0 + sl_cur, d0);
    ATT_WAIT_BAR(2);
#define PKW(P, i) cvtpk_s(P[i], P[i + 1])
#define PAF(k) __builtin_bit_cast(bf16x8, pw##k)
#define VFR(i) (bf16x8){vlo[i][0], vlo[i][1], vlo[i][2], vlo[i][3], vhi[i][0], vhi[i][1], vhi[i][2], vhi[i][3]}
#define VRD(i) do { vlo[i] = vtr(vp_ + (((i) >> 2) * 4096 + ((i) & 3) * 1024)); vhi[i] = vtr(vp_ + (((i) >> 2) * 4096 + ((i) & 3) * 1024 + 512)); } while (0)
#define KRD(G, d0) do { if (G) { kload2(kf, kp0 + sl_next, d0); SBAR(); } } while (0)
#define GAPA(MF, a0, a1, a2, a3, W0, W1, PW) do { MF; sacc += a0; sacc += a1; sacc += a2; sacc += a3; W0; W1; PIN(PW); PIN(sacc); SBAR(); } while (0)
#define GAPB(MF, X, i) do { MF; X[i] = EX(X[i]); X[i + 1] = EX(X[i + 1]); X[i + 2] = EX(X[i + 2]); X[i + 3] = EX(X[i + 3]); PIN(X); SBAR(); } while (0)
#define STEP(C0, C1, P0, P1, t, GK, GV, GL) do { SBAR(); \
    const lds_cptr vp_ = vp0 + sl_prev; \
    VRD(0); SBAR(); float sacc = P0[0] + P0[1]; \
                    GAPA(C0 = MFMA(kf[0], qr[0], negm), P0[2], P0[3], P0[4], P0[5],     pw0[0] = PKW(P0, 0),  pw0[1] = PKW(P0, 2),  pw0); \
    VRD(4); SBAR(); GAPA(C1 = MFMA(kf[1], qr[0], negm), P0[6], P0[7], P0[8], P0[9],     pw0[2] = PKW(P0, 4),  pw0[3] = PKW(P0, 6),  pw0); \
    VRD(1); SBAR(); GAPA(C0 = MFMA(kf[2], qr[1], C0),    P0[10], P0[11], P0[12], P0[13], pw1[0] = PKW(P0, 8),  pw1[1] = PKW(P0, 10), pw1); \
    VRD(5); SBAR(); GAPA(C1 = MFMA(kf[3], qr[1], C1),    P0[14], P0[15], P1[0], P1[1],   pw1[2] = PKW(P0, 12), pw1[3] = PKW(P0, 14), pw1); \
    VRD(2); SBAR(); GAPA(C0 = MFMA(kf[4], qr[2], C0),    P1[2], P1[3], P1[4], P1[5],     pw2[0] = PKW(P1, 0),  pw2[1] = PKW(P1, 2),  pw2); \
    VRD(6); SBAR(); GAPA(C1 = MFMA(kf[5], qr[2], C1),    P1[6], P1[7], P1[8], P1[9],     pw2[2] = PKW(P1, 4),  pw2[3] = PKW(P1, 6),  pw2); \
    VRD(3); SBAR(); GAPA(C0 = MFMA(kf[6], qr[3], C0),    P1[10], P1[11], P1[12], P1[13], pw3[0] = PKW(P1, 8),  pw3[1] = PKW(P1, 10), pw3); \
    VRD(7); SBAR(); GAPA(C1 = MFMA(kf[7], qr[3], C1),    P1[14], P1[15], 0.f, 0.f,       pw3[2] = PKW(P1, 12), pw3[3] = PKW(P1, 14), pw3); \
    l_reg += sacc; \
    if (GK) DMA_K((t) + 3, sl_cur); if (GV) DMA_V((t) + 1, sl_next); \
    hk.apply(C0, C1, (t), r32, hi, wid); \
    if ((t) + 1 < NT) hk.prefetch_issue((t) + 1, wid); \
    { const float rm = rowmax(C0, C1); resc = false; \
      if (__builtin_expect(__any(rm > 8.0f), 0)) { const float dl = __builtin_fmaxf(rm, 0.f); mhat += dl; \
          _Pragma("unroll") for (int r = 0; r < 16; ++r) { C0[r] -= dl; C1[r] -= dl; negm[r] = -mhat; } PIN(negm); \
          const float f = __builtin_amdgcn_exp2f(-dl); l_reg *= f; if (hi == 0) wsf[r32] = f; resc = true; } } \
    SBAR(); \
    GAPB(o[0] = MFMA(PAF(0), VFR(0), o[0]), C0, 0);              GAPB(o[1] = MFMA(PAF(0), VFR(4), o[1]), C0, 4); \
    KRD(GL, 0); GAPB(o[0] = MFMA(PAF(1), VFR(1), o[0]), C0, 8);  KRD(GL, 1); GAPB(o[1] = MFMA(PAF(1), VFR(5), o[1]), C0, 12); \
    KRD(GL, 2); GAPB(o[0] = MFMA(PAF(2), VFR(2), o[0]), C1, 0);  KRD(GL, 3); GAPB(o[1] = MFMA(PAF(2), VFR(6), o[1]), C1, 4); \
    GAPB(o[0] = MFMA(PAF(3), VFR(3), o[0]), C1, 8);              GAPB(o[1] = MFMA(PAF(3), VFR(7), o[1]), C1, 12); \
    if ((t) + 1 < NT) hk.prefetch_wait(); \
    } while (0)
    int t = 1;
    for (; t + 5 < NT; t += 2) {
        STEP(pB0, pB1, pA0, pA1, t, true, true, true);     ATT_WAIT_BAR(2); RESC(); ROT();
        STEP(pA0, pA1, pB0, pB1, t + 1, true, true, true); ATT_WAIT_BAR(2); RESC(); ROT();
    }
#define ENDW(tt) do { if ((tt) + 3 < NT) { ATT_WAIT_BAR(2); } else if ((tt) + 2 < NT) { ATT_WAIT_BAR(1); } else { ATT_WAIT_BAR(0); } } while (0)
    for (; t + 1 < NT; t += 2) {
        STEP(pB0, pB1, pA0, pA1, t, (t + 3 < NT), (t + 1 < NT), (t + 1 < NT));         ENDW(t);     RESC(); ROT();
        STEP(pA0, pA1, pB0, pB1, t + 1, (t + 4 < NT), (t + 2 < NT), (t + 2 < NT));     ENDW(t + 1); RESC(); ROT();
    }
    STEP(pB0, pB1, pA0, pA1, NT - 1, false, false, false); RESC();
    { float sacc = pB0[0] + pB0[1];
#pragma unroll
      for (int r = 2; r < 16; ++r) sacc += pB0[r];
#pragma unroll
      for (int r = 0; r < 16; ++r) sacc += pB1[r];
      l_reg += sacc;
      pw0 = (v4u){PKW(pB0, 0), PKW(pB0, 2), PKW(pB0, 4), PKW(pB0, 6)}; pw1 = (v4u){PKW(pB0, 8), PKW(pB0, 10), PKW(pB0, 12), PKW(pB0, 14)};
      pw2 = (v4u){PKW(pB1, 0), PKW(pB1, 2), PKW(pB1, 4), PKW(pB1, 6)}; pw3 = (v4u){PKW(pB1, 8), PKW(pB1, 10), PKW(pB1, 12), PKW(pB1, 14)};
      const lds_cptr vp_ = vp0 + sl_cur; _Pragma("unroll") for (int i = 0; i < 8; ++i) VRD(i);
      o[0] = MFMA(PAF(0), VFR(0), o[0]); o[1] = MFMA(PAF(0), VFR(4), o[1]); o[0] = MFMA(PAF(1), VFR(1), o[0]); o[1] = MFMA(PAF(1), VFR(5), o[1]);
      o[0] = MFMA(PAF(2), VFR(2), o[0]); o[1] = MFMA(PAF(2), VFR(6), o[1]); o[0] = MFMA(PAF(3), VFR(3), o[0]); o[1] = MFMA(PAF(3), VFR(7), o[1]); }
    { auto rr = __builtin_amdgcn_permlane32_swap(__float_as_uint(l_reg), __float_as_uint(l_reg), false, false); l_reg = __uint_as_float(rr[0]) + __uint_as_float(rr[1]); }
    if constexpr (Hook::PART_OUT) {
        float* pp = hk.part + (size_t)(wid * 32) * Hook::RS * PSTRIDE;
        if (hi == 0) { pp[(size_t)r32 * Hook::RS * PSTRIDE] = mhat; pp[(size_t)r32 * Hook::RS * PSTRIDE + 1] = l_reg; }
#pragma unroll
        for (int r = 0; r < 16; ++r) { float* pr = pp + (size_t)crow(r, hi) * Hook::RS * PSTRIDE + 8 + r32; pr[0] = o[0][r]; pr[32] = o[1][r]; }
    } else {
    if (hi == 0) wsf[32 + r32] = l_reg;
    LDS_WAIT();
    float rli[16];
#pragma unroll
    for (int r = 0; r < 16; ++r) rli[r] = __builtin_amdgcn_rcpf(wsf[32 + crow(r, hi)]);
    bf16* Ow = Oh + (qrow0 + (long)(wid * 32) * Hook::RS) * opitch;
    { LAS bf16* stg = (LAS bf16*)(shm + L_OST) + wid * 2048;
#pragma unroll
        for (int r = 0; r < 16; ++r) { const int orow = crow(r, hi);
#pragma unroll
            for (int d0 = 0; d0 < 2; ++d0) stg[orow * 64 + d0 * 32 + r32] = (bf16)f2bf(o[d0][r] * rli[r]); }
        LDS_WAIT();
#pragma unroll
        for (int i = 0; i < 4; ++i) { const int row = i * 8 + (lane >> 3), ch = lane & 7; const v4u v = *(const LAS v4u*)(stg + row * 64 + ch * 8); *(v4u*)(Ow + (long)row * Hook::RS * opitch + ch * 8) = v; } }
    }
    asm volatile("s_waitcnt lgkmcnt(0)\n\ts_barrier" ::: "memory");
#undef DMA_K
#undef DMA_V
#undef ROT
#undef EX
#undef RESC
#undef PKW
#undef PAF
#undef VFR
#undef VRD
#undef KRD
#undef ENDW
#undef GAPA
#undef GAPB
#undef STEP
}
#undef SBAR
#undef PIN
#undef MFMA
template <class Hook>
__device__ __forceinline__ void attn_unit_pipe(Hook& hk, const bf16* Qh, const bf16* Kh, const bf16* Vh, bf16* Oh, long qrow0, int NT, LAS unsigned char* shm, int opitch) {
    int tid_ = threadIdx.x; asm volatile("" : "+v"(tid_)); const int tid = tid_, lane = tid & 63, r32 = lane & 31, hi = lane >> 5; const int wid = __builtin_amdgcn_readfirstlane(tid >> 6);
    const unsigned lds0 = (unsigned)(size_t)shm;
    LAS float* wsf = (LAS float*)(shm + L_WS) + wid * 64;
    volatile LAS float* wmin = (volatile LAS float*)(shm + L_WMIN);
    const bf16* Qw = Qh + (qrow0 + wid * 32) * PITCH;
    const bf16* ksrc = Kh + (long)lane * PITCH + wid * 8;
    const bf16* vsrc = Vh + (long)(16 * (wid & 3) + (lane >> 2)) * PITCH + (wid >> 2) * 32 + (lane & 3) * 8;
    const unsigned kdst = lds0 + L_K + wid * 1024, vdst = lds0 + L_V + wid * 1024;
#define ATT_DMAK(t, slot) glds16(ksrc + hk.tile_row(t) * PITCH, (unsigned)__builtin_amdgcn_readfirstlane(kdst + (slot)))
#define ATT_DMAV(t, slot) glds16(vsrc + hk.tile_row(t) * PITCH, (unsigned)__builtin_amdgcn_readfirstlane(vdst + (slot)))
    const int vb0 = (int)(lds0 + L_V) + ((lane >> 4) & 1) * 32 + (lane & 3) * 8 + (4 * hi + ((lane & 15) >> 2)) * 64;
    bf16x8 qr[4];
#pragma unroll
    for (int d0 = 0; d0 < 4; ++d0) qr[d0] = *(const bf16x8*)(Qw + (long)r32 * PITCH + d0 * 16 + hi * 8);
    ATT_DMAK(0, 0);
    if (NT > 1) ATT_DMAK(1, SLOTB);
    ATT_DMAV(0, 0);
    if (NT > 2) ATT_DMAK(2, 2 * SLOTB);
    if (NT > 1) ATT_DMAV(1, SLOTB);
    float mhat = -1e30f, l_reg = 0.f; f32x16 o[2]; o[0] = f32x16{}; o[1] = f32x16{};
    f32x16 pA0, pA1, pB0, pB1;
    if (NT > 2) { ATT_WAIT_BAR(4); } else { ATT_WAIT_BAR(0); }
    qkt(pA0, pA1, shm + L_K, qr, r32, hi);
    hk.prefetch(0, wid);
    int slc = 0, sln = SLOTB, sl2 = 2 * SLOTB;
#define ATT_ROT() do { const int t_ = slc; slc = sln; sln = sl2; sl2 = t_; } while (0)
#define ATT_STEP(C0, C1, N0, N1, t) do { \
        if ((t) + 2 < NT) { ATT_WAIT_BAR(2); } else if ((t) + 1 < NT) { ATT_WAIT_BAR(1); } else { ATT_WAIT_BAR(0); } \
        if (Hook::EARLY && (t) >= 4) { const int wb_ = (((t) - 1) & 1) * 8; \
            const float mm_ = __builtin_fminf(__builtin_fminf(__builtin_fminf(wmin[wb_ + 0], wmin[wb_ + 1]), __builtin_fminf(wmin[wb_ + 2], wmin[wb_ + 3])), \
                                              __builtin_fminf(__builtin_fminf(wmin[wb_ + 4], wmin[wb_ + 5]), __builtin_fminf(wmin[wb_ + 6], wmin[wb_ + 7]))); \
            if (hk.stop((t), mm_)) { asm volatile("s_waitcnt vmcnt(0)" ::: "memory"); goto att_done; } } \
        if ((t) + 3 < NT) ATT_DMAK((t) + 3, slc); \
        if ((t) + 2 < NT) ATT_DMAV((t) + 2, sl2); \
        __builtin_amdgcn_sched_barrier(0); \
        if ((t) + 1 < NT) qkt(N0, N1, shm + L_K + sln, qr, r32, hi); \
        __builtin_amdgcn_sched_barrier(0); \
        hk.apply(C0, C1, (t), r32, hi, wid); \
        if ((t) + 1 < NT) hk.prefetch_issue((t) + 1, wid); \
        { const float rm = rowmax(C0, C1); bool resc = false; \
          if (__any(rm > mhat + 8.0f)) { const float mn = __builtin_fmaxf(mhat, rm); const float f = __builtin_amdgcn_exp2f(mhat - mn); l_reg *= f; mhat = mn; if (hi == 0) wsf[r32] = f; resc = true; } \
          float sacc = 0.f; \
          _Pragma("unroll") for (int r = 0; r < 16; ++r) { C0[r] = __builtin_amdgcn_exp2f(C0[r] - mhat); C1[r] = __builtin_amdgcn_exp2f(C1[r] - mhat); sacc += C0[r] + C1[r]; } \
          l_reg += sacc; \
          if (Hook::EARLY) { float mw = mhat; \
              _Pragma("unroll") for (int o_ = 1; o_ < 64; o_ <<= 1) mw = __builtin_fminf(mw, __shfl_xor(mw, o_)); \
              if (lane == 0) wmin[((t) & 1) * 8 + wid] = mw; } \
          const v4u pw0 = (v4u){cvtpk_s(C0[0], C0[1]), cvtpk_s(C0[2], C0[3]), cvtpk_s(C0[4], C0[5]), cvtpk_s(C0[6], C0[7])}; \
          const v4u pw1 = (v4u){cvtpk_s(C0[8], C0[9]), cvtpk_s(C0[10], C0[11]), cvtpk_s(C0[12], C0[13]), cvtpk_s(C0[14], C0[15])}; \
          const v4u pw2 = (v4u){cvtpk_s(C1[0], C1[1]), cvtpk_s(C1[2], C1[3]), cvtpk_s(C1[4], C1[5]), cvtpk_s(C1[6], C1[7])}; \
          const v4u pw3 = (v4u){cvtpk_s(C1[8], C1[9]), cvtpk_s(C1[10], C1[11]), cvtpk_s(C1[12], C1[13]), cvtpk_s(C1[14], C1[15])}; \
          if (resc) { LDS_WAIT(); \
              _Pragma("unroll") for (int r = 0; r < 16; ++r) { const float f = wsf[crow(r, hi)]; o[0][r] *= f; o[1][r] *= f; } } \
          __builtin_amdgcn_sched_barrier(0); \
          pv(o, vb0 + slc, __builtin_bit_cast(bf16x8, pw0), __builtin_bit_cast(bf16x8, pw1), __builtin_bit_cast(bf16x8, pw2), __builtin_bit_cast(bf16x8, pw3)); } \
        if ((t) + 1 < NT) hk.prefetch_wait(); \
        ATT_ROT(); \
    } while (0)
    {
        int t = 0;
        for (; t + 1 < NT; t += 2) { ATT_STEP(pA0, pA1, pB0, pB1, t); ATT_STEP(pB0, pB1, pA0, pA1, t + 1); }
        if (t < NT) { ATT_STEP(pA0, pA1, pB0, pB1, t); }
    }
att_done:
    { auto rr = __builtin_amdgcn_permlane32_swap(__float_as_uint(l_reg), __float_as_uint(l_reg), false, false); l_reg = __uint_as_float(rr[0]) + __uint_as_float(rr[1]); }
    if (hi == 0) wsf[32 + r32] = l_reg;
    LDS_WAIT();
    float rli[16];
#pragma unroll
    for (int r = 0; r < 16; ++r) rli[r] = __builtin_amdgcn_rcpf(wsf[32 + crow(r, hi)]);
    bf16* Ow = Oh + (qrow0 + wid * 32) * opitch;
    { LAS bf16* stg = (LAS bf16*)(shm + L_OST) + wid * 2048;
#pragma unroll
        for (int r = 0; r < 16; ++r) { const int orow = crow(r, hi);
#pragma unroll
            for (int d0 = 0; d0 < 2; ++d0) stg[orow * 64 + d0 * 32 + r32] = (bf16)f2bf(o[d0][r] * rli[r]); }
        LDS_WAIT();
#pragma unroll
        for (int i = 0; i < 4; ++i) { const int row = i * 8 + (lane >> 3), ch = lane & 7; const v4u v = *(const LAS v4u*)(stg + row * 64 + ch * 8); *(v4u*)(Ow + (long)row * opitch + ch * 8) = v; } }
    asm volatile("s_waitcnt lgkmcnt(0)\n\ts_barrier" ::: "memory");
#undef ATT_DMAK
#undef ATT_DMAV
#undef ATT_ROT
#undef ATT_STEP
}
__device__ __forceinline__ int t5_bucket(int d) {
    if (d < 16) return d < 0 ? 0 : d;
    return 16 + (d >= 22) + (d >= 30) + (d >= 40) + (d >= 54) + (d >= 73) + (d >= 99) + (d >= 134) + (d >= 182) + (d >= 246) + (d >= 332) + (d >= 450) + (d >= 609) + (d >= 825) + (d >= 1117) + (d >= 1513);
}
struct FoxHook {
    static constexpr bool EARLY = true, PART_IN = false, PART_OUT = false; static constexpr int RS = 1; float* part;
    __device__ __forceinline__ void prefetch(int, int) {}
    __device__ __forceinline__ void prefetch_issue(int, int) {}
    __device__ __forceinline__ void prefetch_wait() {}
    long rowbase; int NT, q0; const LAS float* Ft; const LAS float* knp; float qmax;
    __device__ __forceinline__ bool stop(int t, float mm) const { const int kt = NT - 1 - t; const float bound = qmax * knp[kt] * 1.001f + 0.01f + (Ft[q0] - Ft[64 * kt + 63]); return bound < mm - 48.0f; }
    __device__ __forceinline__ long tile_row(int t) const { return rowbase + 64 * (NT - 1 - t); }
    __device__ __forceinline__ void apply(f32x16& p0, f32x16& p1, int t, int r32, int hi, int wid) const {
        const int kb = 64 * (NT - 1 - t); const int tq = q0 + wid * 32 + r32; const float Fq = Ft[tq];
#pragma unroll
        for (int g = 0; g < 4; ++g) { const f32x4 f0 = *(const LAS f32x4*)(Ft + kb + 8 * g + 4 * hi), f1 = *(const LAS f32x4*)(Ft + kb + 32 + 8 * g + 4 * hi);
#pragma unroll
            for (int i = 0; i < 4; ++i) { p0[4 * g + i] += Fq - f0[i]; p1[4 * g + i] += Fq - f1[i]; }
            __builtin_amdgcn_sched_barrier(0); }
        if (kb + 63 > q0 + wid * 32) {
#pragma unroll
            for (int r = 0; r < 16; ++r) { const int key = kb + crow(r, hi); if (key > tq) p0[r] = -INFINITY; if (key + 32 > tq) p1[r] = -INFINITY; }
        }
    }
};
typedef unsigned u32x16 __attribute__((ext_vector_type(16)));
struct DsaHook {
    static constexpr bool EARLY = false, PART_IN = false, PART_OUT = false; static constexpr int RS = 1; float* part;
    __device__ __forceinline__ bool stop(int, float) const { return false; }
    long rowbase; int q0; const LAS float* tb; float c31; const unsigned long long* maskq;
    u32x16 ma, mb;
    __device__ __forceinline__ long tile_row(int t) const { return rowbase + 64 * t; }
    __device__ __forceinline__ unsigned long long mptr(int t, int wid) const { const unsigned long long* mp = maskq + ((size_t)wid * 128 + t) * 32;
        return ((unsigned long long)(unsigned)__builtin_amdgcn_readfirstlane((int)((unsigned long long)mp & 0xffffffffull))) | ((unsigned long long)(unsigned)__builtin_amdgcn_readfirstlane((int)((unsigned long long)mp >> 32)) << 32); }
    __device__ __forceinline__ void prefetch(int t, int wid) { const unsigned long long mpu = mptr(t, wid); unsigned d0, d1;
        asm volatile("s_load_dwordx16 %0, %4, 0x0\n\ts_load_dwordx16 %1, %4, 0x40\n\ts_load_dword %2, %4, 0x80\n\ts_load_dword %3, %4, 0xc0\n\ts_waitcnt lgkmcnt(0)" : "=&s"(ma), "=&s"(mb), "=&s"(d0), "=&s"(d1) : "s"(mpu) : "memory"); }
    unsigned pd0, pd1;
    __device__ __forceinline__ void prefetch_issue(int t, int wid) { const unsigned long long mpu = mptr(t, wid);
        asm volatile("s_load_dwordx16 %0, %4, 0x0\n\ts_load_dwordx16 %1, %4, 0x40\n\ts_load_dword %2, %4, 0x80\n\ts_load_dword %3, %4, 0xc0" : "=&s"(ma), "=&s"(mb), "=&s"(pd0), "=&s"(pd1) : "s"(mpu) : "memory"); }
    __device__ __forceinline__ void prefetch_wait() { asm volatile("s_waitcnt lgkmcnt(0)" : "+s"(ma), "+s"(mb), "+s"(pd0), "+s"(pd1) :: "memory"); }
    __device__ __forceinline__ void apply(f32x16& p0, f32x16& p1, int t, int r32, int hi, int wid) {
        const int kb = 64 * t; const int q0w = q0 + wid * 32; const int tq = q0w + r32;
        asm volatile("s_nop 3" : "+v"(p0), "+v"(p1));
        const unsigned long long mpu = mptr(t, wid);
        u32x16 a, b;
        asm volatile("s_load_dwordx16 %0, %2, 0x80\n\ts_load_dwordx16 %1, %2, 0xc0" : "=&s"(a), "=&s"(b) : "s"(mpu) : "memory");
        if (q0w - (kb + 63) < 1513) {
            const LAS float* tl = tb + (tq + 256 - kb - 4 * hi);
#pragma unroll
            for (int g = 0; g < 4; ++g) { float t0[4], t1[4];
#pragma unroll
                for (int i = 0; i < 4; ++i) { t0[i] = tl[-(8 * g + i)]; t1[i] = tl[-(8 * g + i) - 32]; }
#pragma unroll
                for (int i = 0; i < 4; ++i) { asm volatile("v_add_f32 %0, %1, %2" : "=v"(p0[4 * g + i]) : "v"(p0[4 * g + i]), "v"(t0[i])); asm volatile("v_add_f32 %0, %1, %2" : "=v"(p1[4 * g + i]) : "v"(p1[4 * g + i]), "v"(t1[i])); }
                __builtin_amdgcn_sched_barrier(0); }
        }
        const float NEG = -INFINITY;
#pragma unroll
        for (int r = 0; r < 8; ++r) { const unsigned long long mk = ((unsigned long long)ma[2 * r + 1] << 32) | ma[2 * r]; asm volatile("v_cndmask_b32_e64 %0, %1, %2, %3" : "=v"(p0[r]) : "v"(NEG), "v"(p0[r]), "s"(mk)); }
#pragma unroll
        for (int r = 0; r < 8; ++r) { const unsigned long long mk = ((unsigned long long)mb[2 * r + 1] << 32) | mb[2 * r]; asm volatile("v_cndmask_b32_e64 %0, %1, %2, %3" : "=v"(p0[8 + r]) : "v"(NEG), "v"(p0[8 + r]), "s"(mk)); }
        asm volatile("s_waitcnt lgkmcnt(0)" : "+s"(a), "+s"(b) :: "memory");
#pragma unroll
        for (int r = 0; r < 8; ++r) { const unsigned long long mk = ((unsigned long long)a[2 * r + 1] << 32) | a[2 * r]; asm volatile("v_cndmask_b32_e64 %0, %1, %2, %3" : "=v"(p1[r]) : "v"(NEG), "v"(p1[r]), "s"(mk)); }
#pragma unroll
        for (int r = 0; r < 8; ++r) { const unsigned long long mk = ((unsigned long long)b[2 * r + 1] << 32) | b[2 * r]; asm volatile("v_cndmask_b32_e64 %0, %1, %2, %3" : "=v"(p1[8 + r]) : "v"(NEG), "v"(p1[8 + r]), "s"(mk)); }
    }
};
template <int RS_, bool PIN_, bool POUT_>
struct DilHookT {
    static constexpr bool EARLY = false, PART_IN = PIN_, PART_OUT = POUT_; static constexpr int RS = RS_; float* part;
    __device__ __forceinline__ void prefetch(int, int) {}
    __device__ __forceinline__ void prefetch_issue(int, int) {}
    __device__ __forceinline__ void prefetch_wait() {}
    __device__ __forceinline__ bool stop(int, float) const { return false; }
    long rowbase; int q0, kt0; const LAS float* tb;
    __device__ __forceinline__ long tile_row(int t) const { return rowbase + (long)RS_ * 64 * (kt0 + t); }
    __device__ __forceinline__ void apply(f32x16& p0, f32x16& p1, int t, int r32, int hi, int wid) const {
        const int kb = 64 * (kt0 + t); const int tq = q0 + wid * 32 + r32;
        const LAS float* tl = tb + (tq + 256 - kb - 4 * hi);
        asm volatile("s_nop 3" : "+v"(p0), "+v"(p1));
#pragma unroll
        for (int g = 0; g < 4; ++g) { float t0[4], t1[4];
#pragma unroll
            for (int i = 0; i < 4; ++i) { t0[i] = tl[-(8 * g + i)]; t1[i] = tl[-(8 * g + i) - 32]; }
#pragma unroll
            for (int i = 0; i < 4; ++i) { asm volatile("v_add_f32 %0, %1, %2" : "=v"(p0[4 * g + i]) : "v"(p0[4 * g + i]), "v"(t0[i])); asm volatile("v_add_f32 %0, %1, %2" : "=v"(p1[4 * g + i]) : "v"(p1[4 * g + i]), "v"(t1[i])); }
            __builtin_amdgcn_sched_barrier(0); }
    }
};
}
namespace gla {
constexpr int LS = 72;
constexpr int O_QT = 0, O_KT = 9216, O_KHT = 18432, O_VT = 27648, O_AT = 46080, O_GA = 55296, O_WG = 59392, O_TOT = 63488, O_END = 65536;
__device__ __forceinline__ bf16x8 frag(const LAS bf16* base, int row, int k0) { return *(const LAS bf16x8*)(base + row * LS + k0); }
__device__ __forceinline__ int swz(int row, int k) { return row * LS + ((((k >> 3) ^ (row >> 3)) & 7) << 3) + (k & 7); }
__device__ __forceinline__ bf16x8 frag_sw(const LAS bf16* base, int row, int k0) { return *(const LAS bf16x8*)(base + swz(row, k0)); }
#define GLA_MFMA(x, y, c) __builtin_amdgcn_mfma_f32_16x16x32_bf16(x, y, c, 0, 0, 0)
__device__ __forceinline__ void chunk_unit(Frame& F, int b, int h, int c, const float* w_gate, const float* b_gate) {
    unsigned char* act = F.ws + WS_ACT; unsigned char* big = F.ws + WS_BIG;
    const bf16* QA = (const bf16*)(act + pg8::A_QA); const bf16* KA = (const bf16*)(act + pg8::A_KA); const bf16* VA = (const bf16*)(act + pg8::A_VA);
    const float* SM = (const float*)(act + pg8::A_SMALL);
    float* DS = (float*)(big + BG_DS); float* OI = (float*)(F.ws + WS_Y); bf16* QS = (bf16*)(big + BG_QS); float* DEC = (float*)(big + BG_DEC);
    LAS bf16* QT = (LAS bf16*)(F.lds + O_QT); LAS bf16* KT = (LAS bf16*)(F.lds + O_KT); LAS bf16* KHT = (LAS bf16*)(F.lds + O_KHT); LAS bf16* VT = (LAS bf16*)(F.lds + O_VT); LAS bf16* AT = (LAS bf16*)(F.lds + O_AT);
    LAS float* GA = (LAS float*)(F.lds + O_GA); LAS float* WG = (LAS float*)(F.lds + O_WG); LAS float* TOT = (LAS float*)(F.lds + O_TOT);
    int tidl_ = threadIdx.x; asm volatile("" : "+v"(tidl_));
    const int tid = tidl_, lane = tid & 63, wave = __builtin_amdgcn_readfirstlane(tid >> 6); const size_t m0 = (size_t)b * SEQ + 64 * c; const int bh = b * 4 + h;
    unsigned short qraw[8], kraw[8];
#pragma unroll
    for (int a = 0; a < 8; ++a) { const size_t o_ = (m0 + 8 * wave + a) * 256 + 64 * h + (tid & 63); qraw[a] = QA[o_]; kraw[a] = KA[o_]; }
    for (int i = tid; i < 1024; i += NTHR) { GA[i] = SM[(m0 + (i >> 4)) * 32 + (i & 15)]; WG[i] = w_gate[(i >> 6) * 256 + 64 * h + (i & 63)]; }
    for (int ch = tid; ch < 1024; ch += NTHR) { const int j = ch >> 4, v0 = (ch & 15) * 8; const v4u w = *(const GAS v4u*)(VA + (m0 + j) * 512 + 128 * h + v0);
        LAS bf16* pv_ = VT + swz(v0, j);
        pv_[0 * LS] = (bf16)(w.x & 0xffff); pv_[1 * LS] = (bf16)(w.x >> 16); pv_[2 * LS] = (bf16)(w.y & 0xffff); pv_[3 * LS] = (bf16)(w.y >> 16);
        pv_[4 * LS] = (bf16)(w.z & 0xffff); pv_[5 * LS] = (bf16)(w.z >> 16); pv_[6 * LS] = (bf16)(w.w & 0xffff); pv_[7 * LS] = (bf16)(w.w >> 16); }
    LDS_BAR();
    const int kap = tid & 63, part = wave;
    float cg[8];
    { const float bg = b_gate[64 * h + kap]; float run = 0.f;
#pragma unroll
      for (int a = 0; a < 8; ++a) { float z = bg;
#pragma unroll
          for (int r = 0; r < 16; ++r) z += GA[(8 * part + a) * 16 + r] * WG[r * 64 + kap];
          run += log_sigmoid(z) * (1.0f / 16.0f); cg[a] = run; }
      TOT[part * 64 + kap] = run; }
    LDS_BAR();
    float offs = 0.f, gmid = 0.f, glast = 0.f;
#pragma unroll
    for (int p = 0; p < 8; ++p) { const float tv = TOT[p * 64 + kap]; if (p < part) offs += tv; if (p < 4) gmid += tv; glast += tv; }
#pragma unroll
    for (int a = 0; a < 8; ++a) { const int i = 8 * part + a; const float G = offs + cg[a];
        const float q = bf2f(qraw[a]), k = bf2f(kraw[a]);
        QT[i * LS + kap] = (bf16)f2bf(q * __expf(G - gmid)); KT[i * LS + kap] = (bf16)f2bf(k * __expf(gmid - G)); KHT[kap * LS + i] = (bf16)f2bf(k * __expf(glast - G));
        QS[(m0 + i) * 256 + 64 * h + kap] = (bf16)f2bf(q * __expf(G)); }
    if (part == 7) DEC[((size_t)bh * 128 + c) * 64 + kap] = __expf(glast);
    LDS_BAR();
    const int fr = lane & 15, fq = lane >> 4;
#pragma unroll
    for (int tt = 0; tt < 2; ++tt) { const int tile = 2 * wave + tt, it = tile >> 2, jt = tile & 3; f32x4 acc = {0.f, 0.f, 0.f, 0.f};
        if (jt <= it) {
#pragma unroll
            for (int ks = 0; ks < 2; ++ks) acc = GLA_MFMA(frag(QT, 16 * it + fr, 32 * ks + 8 * fq), frag(KT, 16 * jt + fr, 32 * ks + 8 * fq), acc); }
#pragma unroll
        for (int r = 0; r < 4; ++r) { const int i = 16 * it + 4 * fq + r, j = 16 * jt + fr; AT[i * LS + j] = (bf16)f2bf(j <= i ? acc[r] : 0.f); } }
    LDS_BAR();
    { const int it = wave & 3;
#pragma unroll
      for (int vv = 0; vv < 4; ++vv) { const int vt = 4 * (wave >> 2) + vv; f32x4 ao = {0.f, 0.f, 0.f, 0.f}, ad = {0.f, 0.f, 0.f, 0.f};
#pragma unroll
          for (int ks = 0; ks < 2; ++ks) { const bf16x8 y = frag_sw(VT, 16 * vt + fr, 32 * ks + 8 * fq);
              ao = GLA_MFMA(frag(AT, 16 * it + fr, 32 * ks + 8 * fq), y, ao); ad = GLA_MFMA(frag(KHT, 16 * it + fr, 32 * ks + 8 * fq), y, ad); }
#pragma unroll
          for (int r = 0; r < 4; ++r) { const int i = 16 * it + 4 * fq + r, v = 16 * vt + fr;
              OI[(m0 + i) * 512 + 128 * h + v] = ao[r]; DS[(((size_t)bh * 128 + c) * 64 + i) * 128 + v] = ad[r]; } } }
}
__device__ __forceinline__ void scan_unit(Frame& F, int u) {
    unsigned char* big = F.ws + WS_BIG;
    const float* DS = (const float*)(big + BG_DS); const float* DEC = (const float*)(big + BG_DEC); bf16* SP = (bf16*)(big + BG_SP);
    int tidl_ = threadIdx.x; asm volatile("" : "+v"(tidl_));
    const int bh = u >> 4, e = (u & 15) * 512 + tidl_, kap = e >> 7;
    const float* ds = DS + (size_t)bh * 128 * 8192 + e; const float* dc = DEC + (size_t)bh * 128 * 64 + kap; bf16* sp = SP + (size_t)bh * 128 * 8192 + e;
    float S = 0.f;
    for (int c0 = 0; c0 < 128; c0 += 8) { float d[8], g[8];
#pragma unroll
        for (int k = 0; k < 8; ++k) { d[k] = ds[(size_t)(c0 + k) * 8192]; g[k] = dc[(c0 + k) * 64]; }
#pragma unroll
        for (int k = 0; k < 8; ++k) { sp[(size_t)(c0 + k) * 8192] = (bf16)f2bf(S); S = g[k] * S + d[k]; } }
}
__device__ __forceinline__ void out_unit(Frame& F, int b, int h, int c, const float* g_norm) {
    unsigned char* act = F.ws + WS_ACT; unsigned char* big = F.ws + WS_BIG;
    const bf16* RA = (const bf16*)(act + pg8::A_RA); const float* OI = (const float*)(F.ws + WS_Y); const bf16* QS = (const bf16*)(big + BG_QS); const bf16* SP = (const bf16*)(big + BG_SP);
    bf16* MIX = (bf16*)(F.ws + WS_MIX);
    LAS bf16* QL = (LAS bf16*)(F.lds + 0); LAS bf16* ST = (LAS bf16*)(F.lds + 9216); LAS float* SS = (LAS float*)(F.lds + 27648);
    int tidl_ = threadIdx.x; asm volatile("" : "+v"(tidl_));
    const int tid = tidl_, lane = tid & 63, wave = __builtin_amdgcn_readfirstlane(tid >> 6); const size_t m0 = (size_t)b * SEQ + 64 * c; const int bh = b * 4 + h;
    float oi[4][4]; unsigned short rr_[4][4];
    { const int fr_ = lane & 15, fq_ = lane >> 4, it_ = wave & 3, vh_ = wave >> 2;
#pragma unroll
      for (int vv = 0; vv < 4; ++vv)
#pragma unroll
          for (int r = 0; r < 4; ++r) { const size_t o_ = (m0 + 16 * it_ + 4 * fq_ + r) * 512 + 128 * h + 16 * (4 * vh_ + vv) + fr_; oi[vv][r] = OI[o_]; rr_[vv][r] = RA[o_]; } }
    { const int i = tid >> 3, k0 = (tid & 7) * 8; *(LAS v4u*)(QL + i * LS + k0) = *(const GAS v4u*)(QS + (m0 + i) * 256 + 64 * h + k0); }
    const bf16* sp = SP + ((size_t)bh * 128 + c) * 8192;
    for (int ch = tid; ch < 1024; ch += NTHR) { const int kap = ch >> 4, v0 = (ch & 15) * 8; const v4u w = *(const GAS v4u*)(sp + kap * 128 + v0);
        LAS bf16* ps_ = ST + swz(v0, kap);
        ps_[0 * LS] = (bf16)(w.x & 0xffff); ps_[1 * LS] = (bf16)(w.x >> 16); ps_[2 * LS] = (bf16)(w.y & 0xffff); ps_[3 * LS] = (bf16)(w.y >> 16);
        ps_[4 * LS] = (bf16)(w.z & 0xffff); ps_[5 * LS] = (bf16)(w.z >> 16); ps_[6 * LS] = (bf16)(w.w & 0xffff); ps_[7 * LS] = (bf16)(w.w >> 16); }
    LDS_BAR();
    const int fr = lane & 15, fq = lane >> 4, it = wave & 3, vh = wave >> 2;
    f32x4 o[4]; float ss[4] = {0.f, 0.f, 0.f, 0.f};
#pragma unroll
    for (int vv = 0; vv < 4; ++vv) { const int vt = 4 * vh + vv; f32x4 a = {0.f, 0.f, 0.f, 0.f};
#pragma unroll
        for (int ks = 0; ks < 2; ++ks) a = GLA_MFMA(frag(QL, 16 * it + fr, 32 * ks + 8 * fq), frag_sw(ST, 16 * vt + fr, 32 * ks + 8 * fq), a);
#pragma unroll
        for (int r = 0; r < 4; ++r) { const int i = 16 * it + 4 * fq + r, v = 16 * vt + fr; const float x = a[r] + oi[vv][r]; a[r] = x; ss[r] += x * x; }
        o[vv] = a; }
#pragma unroll
    for (int r = 0; r < 4; ++r) { float s = ss[r]; s += __shfl_xor(s, 1); s += __shfl_xor(s, 2); s += __shfl_xor(s, 4); s += __shfl_xor(s, 8); ss[r] = s; }
    if (fr == 0) {
#pragma unroll
        for (int r = 0; r < 4; ++r) SS[vh * 64 + 16 * it + 4 * fq + r] = ss[r]; }
    LDS_BAR();
#pragma unroll
    for (int r = 0; r < 4; ++r) { const int i = 16 * it + 4 * fq + r; const float tot = SS[i] + SS[64 + i]; const float rinv = 1.0f / sqrtf(tot * (1.0f / 128.0f) + LN_EPS);
#pragma unroll
        for (int vv = 0; vv < 4; ++vv) { const int v = 16 * (4 * vh + vv) + fr; const float rr = bf2f(rr_[vv][r]);
            const float of = o[vv][r] * rinv * g_norm[v]; const float sg = rr / (1.0f + __expf(-rr));
            MIX[(m0 + i) * 1024 + 128 * h + v] = (bf16)f2bf(of * sg); } }
}
}

namespace dsa {
__device__ __forceinline__ size_t sc_base(int b, int tq) { const size_t J = (size_t)(tq >> 6); return (size_t)b * SCB + 4096 * (J * (J + 1) / 2) + (size_t)(tq & 63) * 64 * (J + 1); }
__device__ __forceinline__ void score_unit(Frame& F, int b, int qb32) {
    unsigned char* act = F.ws + WS_ACT;
    const bf16* QI = (const bf16*)(act + pg8::A_QI); const bf16* KI = (const bf16*)(act + pg8::A_KI); const float* SM = (const float*)(act + pg8::A_SMALL);
    float* SC = (float*)(F.ws + WS_BIG + BG_SC);
    int tidl_ = threadIdx.x; asm volatile("" : "+v"(tidl_));
    const int lane = tidl_ & 63, wv_ = __builtin_amdgcn_readfirstlane(tidl_ >> 6), fr = lane & 15, fq = lane >> 4, qs = wv_ & 1, kp = wv_ >> 1;
    const int tq = 32 * qb32 + 16 * qs + fr; const size_t m = (size_t)b * SEQ + tq;
    bf16x8 qf[8][2]; float wv[8];
#pragma unroll
    for (int h = 0; h < 8; ++h) { wv[h] = SM[m * 32 + 16 + h];
#pragma unroll
        for (int ks = 0; ks < 2; ++ks) qf[h][ks] = *(const bf16x8*)(QI + m * 512 + 64 * h + 32 * ks + 8 * fq); }
    float* srow = SC + sc_base(b, tq);
    const int ntile = (qb32 >> 1) + 1;
    const bf16* kbase = KI + ((size_t)b * SEQ + fr) * 64 + 8 * fq;
    bf16x8 kn[4][2];
    if (kp < ntile) {
#pragma unroll
        for (int s4 = 0; s4 < 4; ++s4) { kn[s4][0] = *(const bf16x8*)(kbase + (size_t)(64 * kp + 16 * s4) * 64); kn[s4][1] = *(const bf16x8*)(kbase + (size_t)(64 * kp + 16 * s4) * 64 + 32); } }
    for (int kt = kp; kt < ntile; kt += 4) {
        bf16x8 kc[4][2];
#pragma unroll
        for (int s4 = 0; s4 < 4; ++s4) { kc[s4][0] = kn[s4][0]; kc[s4][1] = kn[s4][1]; }
        if (kt + 4 < ntile) {
#pragma unroll
            for (int s4 = 0; s4 < 4; ++s4) { kn[s4][0] = *(const bf16x8*)(kbase + (size_t)(64 * (kt + 4) + 16 * s4) * 64); kn[s4][1] = *(const bf16x8*)(kbase + (size_t)(64 * (kt + 4) + 16 * s4) * 64 + 32); } }
#pragma unroll
        for (int s4 = 0; s4 < 4; ++s4) {
            f32x4 acc = {0.f, 0.f, 0.f, 0.f};
#pragma unroll
            for (int h = 0; h < 8; ++h) { f32x4 d = {0.f, 0.f, 0.f, 0.f}; d = GLA_MFMA(kc[s4][0], qf[h][0], d); d = GLA_MFMA(kc[s4][1], qf[h][1], d);
#pragma unroll
                for (int r = 0; r < 4; ++r) acc[r] += wv[h] * __builtin_fmaxf(d[r], 0.f); }
            *(f32x4*)(srow + 64 * kt + 16 * s4 + 4 * fq) = acc; }
    }
}
__device__ __forceinline__ unsigned okey(float v) { const unsigned u = __float_as_uint(v + 0.0f); return u ^ ((u >> 31) ? 0xffffffffu : 0x80000000u); }
__device__ __forceinline__ void hadd(LAS unsigned* hist, unsigned bin) { __hip_atomic_fetch_add(&hist[bin >> 1], 1u << ((bin & 1u) * 16u), __ATOMIC_RELAXED, __HIP_MEMORY_SCOPE_WORKGROUP); }
__device__ __forceinline__ int hget(const LAS unsigned* hist, int bin) { return (int)((hist[bin >> 1] >> ((bin & 1) * 16)) & 0xffffu); }
__device__ __forceinline__ void find_bin(const LAS unsigned* hist, int wpl, int need, int lane, int& bin, int& above) {
    int cnt = 0;
#pragma unroll 1
    for (int i = 0; i < wpl; i += 4) { const v4u w = *(const LAS v4u*)(hist + lane * wpl + i);
        cnt += (int)(w.x & 0xffffu) + (int)(w.x >> 16) + (int)(w.y & 0xffffu) + (int)(w.y >> 16) + (int)(w.z & 0xffffu) + (int)(w.z >> 16) + (int)(w.w & 0xffffu) + (int)(w.w >> 16); }
    int incl = cnt;
#pragma unroll
    for (int o = 1; o < 64; o <<= 1) { const int t = __shfl_down(incl, o); if (lane + o < 64) incl += t; }
    const int sfx = incl - cnt; const bool mine = (sfx < need) && (sfx + cnt >= need);
    const unsigned long long bal = __ballot(mine); const int tl = __ffsll((long long)bal) - 1;
    const int sfx_t = __shfl(sfx, tl), nb = 2 * wpl, base_bin = tl * nb;
    const int hv = (lane < nb) ? hget(hist, base_bin + lane) : 0;
    int inc = hv;
#pragma unroll
    for (int o = 1; o < 32; o <<= 1) { const int t = __shfl_down(inc, o); if (lane + o < 64) inc += t; }
    const bool hit = (lane < nb) && (sfx_t + inc - hv < need) && (sfx_t + inc >= need);
    const unsigned long long bal2 = __ballot(hit); const int bl = __ffsll((long long)bal2) - 1;
    bin = base_bin + bl; above = sfx_t + __shfl(inc - hv, bl);
}
constexpr int SEL_CAP = 1024;
__device__ __forceinline__ void select_unit(Frame& F, int b, int qb32, unsigned long long* maskp) {
    const float* SC = (const float*)(F.ws + WS_BIG + BG_SC);
    LAS unsigned* W = (LAS unsigned*)(F.lds);
    LAS unsigned* hist = (LAS unsigned*)(F.lds + 32768 + __builtin_amdgcn_readfirstlane((int)threadIdx.x >> 6) * 10240); LAS unsigned* ckey = hist + 1024; LAS unsigned short* cidx = (LAS unsigned short*)(ckey + 1024);
    int tidl_ = threadIdx.x; asm volatile("" : "+v"(tidl_));
    const int tid = tidl_, lane = tid & 63; const unsigned long long lt = (1ull << lane) - 1ull;
    for (int i = tid; i < 8192; i += NTHR) W[i] = 0u;
    LDS_BAR();
#define SEL_OR(s_) __hip_atomic_fetch_or(&W[s_], qbit, __ATOMIC_RELAXED, __HIP_MEMORY_SCOPE_WORKGROUP)
#define SEL_ZERO(nw_) do { LDS_WAIT(); for (int i_ = lane; i_ < (nw_); i_ += 64) hist[i_] = 0u; LDS_WAIT(); } while (0)
    for (int qi = 0; qi < 4; ++qi) {
        const int q = 4 * __builtin_amdgcn_readfirstlane((int)threadIdx.x >> 6) + qi, tq = 32 * qb32 + q, n = tq + 1; const unsigned qbit = 1u << q;
        const float* row = SC + sc_base(b, tq);
        if (n <= 256) { for (int s = lane; s < n; s += 64) SEL_OR(s); continue; }
        const int nch = (n + 255) >> 8;
        int B1, B2, B3, ab1, ab2, ab3;
        SEL_ZERO(1024);
        { f32x4 vn[4];
#define SEL_LOADG(c0_) do { _Pragma("unroll") for (int u = 0; u < 4; ++u) { const int s0 = ((c0_) + u) * 256 + lane * 4; vn[u] = (s0 < n) ? *(const GAS f32x4*)(row + s0) : (f32x4){0.f, 0.f, 0.f, 0.f}; } } while (0)
          SEL_LOADG(0);
          for (int c0 = 0; c0 < nch; c0 += 4) { f32x4 v[4];
#pragma unroll
            for (int u = 0; u < 4; ++u) v[u] = vn[u];
            if (c0 + 4 < nch) SEL_LOADG(c0 + 4);
#pragma unroll
            for (int u = 0; u < 4; ++u) { const int s0 = (c0 + u) * 256 + lane * 4;
#pragma unroll
                for (int c = 0; c < 4; ++c) if (s0 + c < n) hadd(hist, okey(v[u][c]) >> 21); } } }
        LDS_WAIT(); find_bin(hist, 16, 256, lane, B1, ab1);
        const int need1 = 256 - ab1, cnt1 = hget(hist, B1);
        if (cnt1 <= SEL_CAP) {
            int cbase = 0;
            { f32x4 vn[4];
              SEL_LOADG(0);
              for (int c0 = 0; c0 < nch; c0 += 4) { f32x4 v[4];
#pragma unroll
                for (int u = 0; u < 4; ++u) v[u] = vn[u];
                if (c0 + 4 < nch) SEL_LOADG(c0 + 4);
#pragma unroll
                for (int u = 0; u < 4; ++u) { const int s0 = (c0 + u) * 256 + lane * 4;
#pragma unroll
                    for (int c = 0; c < 4; ++c) { const unsigned k = okey(v[u][c]); const int bin = (int)(k >> 21); const bool valid = s0 + c < n;
                        if (valid && bin > B1) SEL_OR(s0 + c);
                        const bool isc = valid && bin == B1; const unsigned long long bal = __ballot(isc);
                        if (isc) { const int pos = cbase + __popcll(bal & lt); ckey[pos] = k; cidx[pos] = (unsigned short)(s0 + c); }
                        cbase += __popcll(bal); } } } }
#undef SEL_LOADG
            const int C = cbase;
            SEL_ZERO(1024);
            for (int i = lane; i < C; i += 64) hadd(hist, (ckey[i] >> 10) & 2047u);
            LDS_WAIT(); find_bin(hist, 16, need1, lane, B2, ab2);
            const int need2 = need1 - ab2;
            SEL_ZERO(512);
            for (int i = lane; i < C; i += 64) { const unsigned k = ckey[i]; if ((int)((k >> 10) & 2047u) == B2) hadd(hist, k & 1023u); }
            LDS_WAIT(); find_bin(hist, 8, need2, lane, B3, ab3);
            const int need3 = need2 - ab3, cnt3 = hget(hist, B3);
            const unsigned T = ((unsigned)B1 << 21) | ((unsigned)B2 << 10) | (unsigned)B3;
            if (need3 >= cnt3) { for (int i = lane; i < C; i += 64) if (ckey[i] >= T) SEL_OR((int)cidx[i]); }
            else { for (int i0 = 0; i0 < C; i0 += 64) { const int i = i0 + lane; const bool valid = i < C; const unsigned k = valid ? ckey[i] : 0u; const int id = valid ? (int)cidx[i] : 0;
                       bool sel = valid && k > T;
                       if (__any(valid && k == T)) { int rank = 0; for (int jj = 0; jj < C; ++jj) rank += (ckey[jj] == T && (int)cidx[jj] < id) ? 1 : 0; if (valid && k == T && rank < need3) sel = true; }
                       if (sel) SEL_OR(id); } }
        } else {
            SEL_ZERO(1024);
            for (int ci = 0; ci < nch; ++ci) { const int s0 = ci * 256 + lane * 4; if (s0 < n) { const f32x4 v = *(const GAS f32x4*)(row + s0);
#pragma unroll
                for (int c = 0; c < 4; ++c) { const unsigned k = okey(v[c]); if (s0 + c < n && (int)(k >> 21) == B1) hadd(hist, (k >> 10) & 2047u); } } }
            LDS_WAIT(); find_bin(hist, 16, need1, lane, B2, ab2);
            const unsigned pre2 = ((unsigned)B1 << 11) | (unsigned)B2; const int need2 = need1 - ab2;
            SEL_ZERO(512);
            for (int ci = 0; ci < nch; ++ci) { const int s0 = ci * 256 + lane * 4; if (s0 < n) { const f32x4 v = *(const GAS f32x4*)(row + s0);
#pragma unroll
                for (int c = 0; c < 4; ++c) { const unsigned k = okey(v[c]); if (s0 + c < n && (k >> 10) == pre2) hadd(hist, k & 1023u); } } }
            LDS_WAIT(); find_bin(hist, 8, need2, lane, B3, ab3);
            const unsigned T = (pre2 << 10) | (unsigned)B3; const int need_eq = need2 - ab3, cnt_eq = hget(hist, B3);
            if (need_eq >= cnt_eq) {
                for (int ci = 0; ci < nch; ++ci) { const int s0 = ci * 256 + lane * 4; if (s0 < n) { const f32x4 v = *(const GAS f32x4*)(row + s0);
#pragma unroll
                    for (int c = 0; c < 4; ++c) if (s0 + c < n && okey(v[c]) >= T) SEL_OR(s0 + c); } }
            } else {
                int running = 0;
                for (int s0 = 0; s0 < n; s0 += 64) { const int s = s0 + lane; const bool valid = s < n; const unsigned k = valid ? okey(row[s]) : 0u;
                    const bool eq = valid && k == T, gt = valid && k > T; const unsigned long long bal = __ballot(eq);
                    const int rank = running + __popcll(bal & lt); if (gt || (eq && rank < need_eq)) SEL_OR(s); running += __popcll(bal); }
            }
        }
        LDS_WAIT();
    }
#undef SEL_OR
#undef SEL_ZERO
    LDS_BAR();
    const int ntile = 4 * (qb32 >> 3) + 4;
    for (int idx = tid; idx < ntile * 32; idx += NTHR) { const int kt = idx >> 5, j = idx & 31, p = j >> 4, r = j & 15; const int klo = 64 * kt + 32 * p + (r & 3) + 8 * (r >> 2);
        maskp[(size_t)kt * 32 + j] = (unsigned long long)W[klo] | ((unsigned long long)W[klo + 4] << 32); }
}
}
__device__ __forceinline__ void dsa_attn_unit(Frame& F, int b, int h, int qb, const float* rel, const unsigned long long* mask_layer) {
    unsigned char* act = F.ws + WS_ACT;
    LAS float* tb = (LAS float*)(F.lds + att::L_TAB);
    const float b31 = rel[31 * 8 + h];
    for (int i = F.tid; i < 1920; i += NTHR) { const int d = i - 256; tb[i] = (rel[att::t5_bucket(d) * 8 + h] - b31) * LOG2E; }
    att::DsaHook hk; hk.rowbase = (long)b * SEQ; hk.q0 = 256 * qb; hk.tb = tb; hk.c31 = rel[31 * 8 + h] * LOG2E;
    hk.maskq = mask_layer + ((size_t)(b * 256 + 8 * qb) * 128) * 32;
    att::attn_unit(hk, (const bf16*)(act + pg8::A_QB) + 64 * h, (const bf16*)(act + pg8::A_KB) + 64 * h, (const bf16*)(act + pg8::A_VB) + 64 * h,
                   (bf16*)(F.ws + WS_MIX) + 512 + 64 * h, (long)b * SEQ + 256 * qb, 4 * (qb + 1), F.lds, 1024);
}
constexpr size_t BG_PART = BG_H;
__device__ __forceinline__ void dil_attn_unit(Frame& F, int b, int h, int qb, const float* rel) {
    unsigned char* act = F.ws + WS_ACT;
    LAS float* tb = (LAS float*)(F.lds + att::L_TAB);
    for (int i = F.tid; i < 1024; i += NTHR) { const int d = i - 256; float v = -INFINITY;
        if (d >= 0 && d <= 512) { const int mult = (d <= 128 ? 1 : 0) + (((d & 3) == 0) ? 1 : 0) + (((d & 15) == 0) ? 1 : 0);
            if (mult > 0) v = (rel[att::t5_bucket(d) * 8 + h] + (mult == 1 ? 0.f : (mult == 2 ? 0.6931471805599453f : 1.0986122886681098f))) * LOG2E; }
        tb[i] = v; }
    att::DilHookT<1, true, false> hk; hk.rowbase = (long)b * SEQ; hk.q0 = 256 * qb; hk.kt0 = (4 * qb - 8) > 0 ? (4 * qb - 8) : 0; hk.tb = tb;
    hk.part = (float*)(F.ws + WS_BIG + BG_PART) + ((size_t)((long)b * SEQ + 256 * qb) * 8 + h) * 72;
    att::attn_unit(hk, (const bf16*)(act + pg8::A_QD) + 64 * h, (const bf16*)(act + pg8::A_KD) + 64 * h, (const bf16*)(act + pg8::A_VD) + 64 * h,
                   (bf16*)(F.ws + WS_MIX) + 512 + 64 * h, (long)b * SEQ + 256 * qb, 4 * (qb + 1) - hk.kt0, F.lds, 1024);
}
__device__ __forceinline__ void dil_far_unit(Frame& F, int b, int h, int r, int blk, const float* rel) {
    unsigned char* act = F.ws + WS_ACT;
    LAS float* tb = (LAS float*)(F.lds + att::L_TAB);
    for (int i = F.tid; i < 640; i += NTHR) { const int dc = i - 256; tb[i] = (dc >= 33 && dc <= 128) ? rel[att::t5_bucket(16 * dc) * 8 + h] * LOG2E : -INFINITY; }
    att::DilHookT<16, false, true> hk; hk.rowbase = (long)b * SEQ + r; hk.q0 = 256 * blk; hk.kt0 = blk ? 2 : 0; hk.tb = tb;
    const long qrow0 = (long)b * SEQ + r + 16 * 256 * blk;
    hk.part = (float*)(F.ws + WS_BIG + BG_PART) + ((size_t)qrow0 * 8 + h) * 72;
    att::attn_unit(hk, (const bf16*)(act + pg8::A_QD) + 64 * h, (const bf16*)(act + pg8::A_KD) + 64 * h, (const bf16*)(act + pg8::A_VD) + 64 * h,
                   (bf16*)nullptr, qrow0, blk ? 6 : 4, F.lds, 1024);
}
constexpr size_t MI_FG = 2 * MiB, MI_KNT = MI_FG + 2 * 8 * SEQ * 4;
__device__ __forceinline__ void fox_fscan_unit(Frame& F, int bh) {
    const int b = bh >> 3, h = bh & 7;
    const float* fl = (const float*)(F.ws + WS_MISC + MI_FL) + (size_t)b * SEQ * 8 + h; float* FG = (float*)(F.ws + WS_MISC + MI_FG) + (size_t)bh * SEQ;
    LAS float* wt = (LAS float*)(F.lds);
    const int s0 = 16 * F.tid; float v[16]; float run = 0.f;
#pragma unroll
    for (int k = 0; k < 16; ++k) { run += fl[(size_t)(s0 + k) * 8]; v[k] = run; }
    float incl = run;
#pragma unroll
    for (int o = 1; o < 64; o <<= 1) { const float t = __shfl_up(incl, o); if (F.lane >= o) incl += t; }
    if (F.lane == 63) wt[F.wave] = incl;
    LDS_BAR();
    float base = incl - run;
#pragma unroll
    for (int w = 0; w < 8; ++w) if (w < F.wave) base += wt[w];
#pragma unroll
    for (int k = 0; k < 16; k += 4) *(GAS f32x4*)(FG + s0 + k) = (f32x4){(base + v[k]) * LOG2E, (base + v[k + 1]) * LOG2E, (base + v[k + 2]) * LOG2E, (base + v[k + 3]) * LOG2E};
}
__device__ __forceinline__ void knorm_unit(Frame& F, int u) {
    const int item = 8 * u + F.wave, bh = item >> 7, tile = item & 127, b = bh >> 3, h = bh & 7;
    const bf16* KC = (const bf16*)(F.ws + WS_ACT + pg8::A_KC) + ((size_t)b * SEQ + 64 * tile + F.lane) * 512 + 64 * h;
    float ss = 0.f;
#pragma unroll
    for (int c = 0; c < 8; ++c) { const v4u w = *(const GAS v4u*)(KC + 8 * c);
        ss += bflo(w.x) * bflo(w.x) + bfhi(w.x) * bfhi(w.x) + bflo(w.y) * bflo(w.y) + bfhi(w.y) * bfhi(w.y) + bflo(w.z) * bflo(w.z) + bfhi(w.z) * bfhi(w.z) + bflo(w.w) * bflo(w.w) + bfhi(w.w) * bfhi(w.w); }
#pragma unroll
    for (int o = 1; o < 64; o <<= 1) ss = __builtin_fmaxf(ss, __shfl_xor(ss, o));
    if (F.lane == 0) ((float*)(F.ws + WS_MISC + MI_KNT))[item] = sqrtf(ss);
}
__device__ __forceinline__ void fox_attn_unit(Frame& F, int b, int h, int qb) {
    unsigned char* act = F.ws + WS_ACT;
    LAS float* Ft = (LAS float*)(F.lds + att::L_TAB); LAS float* knp = (LAS float*)(F.lds + att::L_TAB + 32768); LAS float* red = knp + 128;
    int tidl = threadIdx.x; asm volatile("" : "+v"(tidl));
    const int bh = b * 8 + h; const int n = 256 * (qb + 1), NT = 4 * (qb + 1);
    const float* FG = (const float*)(F.ws + WS_MISC + MI_FG) + (size_t)bh * SEQ; const float* KNT = (const float*)(F.ws + WS_MISC + MI_KNT) + bh * 128;
    { const int s0 = 16 * tidl; if (s0 < n) {
#pragma unroll
          for (int k = 0; k < 16; k += 4) *(LAS f32x4*)(Ft + s0 + k) = *(const GAS f32x4*)(FG + s0 + k); } }
    if (tidl < 128) { float m = tidl < NT ? KNT[tidl] : 0.f;
#pragma unroll
        for (int o = 1; o < 64; o <<= 1) { const float t = __shfl_up(m, o); if (F.lane >= o) m = __builtin_fmaxf(m, t); }
        if (tidl == 63) red[8] = m; knp[tidl] = m; }
    { const bf16* qp = (const bf16*)(act + pg8::A_QC) + ((size_t)b * SEQ + 256 * qb + (tidl >> 1)) * 512 + 64 * h + 32 * (tidl & 1); float ss = 0.f;
#pragma unroll
      for (int c = 0; c < 4; ++c) { const v4u w = *(const GAS v4u*)(qp + 8 * c);
          ss += bflo(w.x) * bflo(w.x) + bfhi(w.x) * bfhi(w.x) + bflo(w.y) * bflo(w.y) + bfhi(w.y) * bfhi(w.y) + bflo(w.z) * bflo(w.z) + bfhi(w.z) * bfhi(w.z) + bflo(w.w) * bflo(w.w) + bfhi(w.w) * bfhi(w.w); }
      ss += __shfl_xor(ss, 1);
#pragma unroll
      for (int o = 2; o < 64; o <<= 1) ss = __builtin_fmaxf(ss, __shfl_xor(ss, o));
      if (F.lane == 0) red[F.wave] = ss; }
    LDS_BAR();
    if (tidl >= 64 && tidl < 128) knp[tidl] = __builtin_fmaxf(knp[tidl], red[8]);
    LDS_BAR();
    float qm = red[0];
#pragma unroll
    for (int w = 1; w < 8; ++w) qm = __builtin_fmaxf(qm, red[w]);
    att::FoxHook hk; hk.rowbase = (long)b * SEQ; hk.NT = NT; hk.q0 = 256 * qb; hk.Ft = Ft; hk.knp = knp; hk.qmax = sqrtf(qm);
    att::attn_unit_pipe(hk, (const bf16*)(act + pg8::A_QC) + 64 * h, (const bf16*)(act + pg8::A_KC) + 64 * h, (const bf16*)(act + pg8::A_VC) + 64 * h,
                   (bf16*)(F.ws + WS_MIX) + 64 * h, (long)b * SEQ + 256 * qb, NT, F.lds, 1024);
}

struct Args {
    const float *x, *ln_g, *ln_b, *rel, *w_in_ab, *w_gate, *b_gate, *g_norm, *w_out_ab, *w_in_cd, *b_forget, *w_out_cd, *w1d, *w3d, *w2d, *w_router, *w1m, *w3m, *w2m;
    float* out; unsigned char* ws; int ph_lo, ph_hi;
};
#ifndef PH_MASK
#define PH_MASK 0x7ff
#endif
#define PH_EN(k) (((PH_MASK) >> (k)) & 1)
#ifndef REP_K
#define REP_K (-1)
#endif
#ifndef REP_PAR
#define REP_PAR 2
#endif
#ifndef REP_SUB
#define REP_SUB 0
#endif
#define SUBSKIP(first) (rep == 1 && ((REP_SUB == 1 && !(first)) || (REP_SUB == 2 && (first))))
#define NREP(k) ((REP_K == (k) && (REP_PAR == 2 || REP_PAR == (ly & 1))) ? 2 : 1)
constexpr int PH_PER_LAYER = 11, PH_TOTAL = DEPTH * PH_PER_LAYER;
__global__ void __launch_bounds__(NTHR, 2) hyb_fwd(Args args) {
    extern __shared__ __attribute__((aligned(16))) unsigned char lds_raw[];
    Frame F;
    F.lds = (LAS unsigned char*)lds_raw;
    F.MISC = (volatile LAS unsigned*)(F.lds + MISC_OFF);
    F.tid = threadIdx.x; F.lane = F.tid & 63; F.wave = __builtin_amdgcn_readfirstlane(F.tid >> 6);
    F.G = gridDim.x; { const int bx = blockIdx.x; F.vcu = (F.G % 8 == 0) ? (bx % 8) * (F.G / 8) + bx / 8 : bx; }
    F.ws = args.ws; F.ctl = (gu32*)(args.ws + WS_CTL);
    for (int u = F.tid; u < (LDS_BYTES - LDSCTL_OFF) / 4; u += NTHR) ((LAS unsigned*)(F.lds + LDSCTL_OFF))[u] = 0u;
    __syncthreads();
    const int lo = args.ph_lo, hi = args.ph_hi;
    const bool use_bar = (hi - lo) > 1;
    XcdBarrier bar; bar.bar = (unsigned*)(F.ctl + CW_BAR); bar.x = 0; bar.st = nullptr;
    if (use_bar) bar = xcd_barrier_post((unsigned*)(F.ctl + CW_BAR), F.MISC + 8);
#define RUN(g) (lo <= (g) && (g) < hi)
#if defined(PROF_A)
    volatile LAS unsigned long long* pstamp = (volatile LAS unsigned long long*)(F.lds + LDSCTL_OFF + 512);
    if (blockIdx.x == 0 && F.tid == 0) { for (int i_ = 0; i_ <= PH_TOTAL; ++i_) pstamp[i_] = 0ull; pstamp[0] = __builtin_amdgcn_s_memrealtime(); }
#define STAMP(g) do { if (blockIdx.x == 0 && threadIdx.x == 0) pstamp[(g) + 1] = __builtin_amdgcn_s_memrealtime(); } while (0)
#else
#define STAMP(g) do { } while (0)
#endif
#define PHASE_BEGIN() do { int t_ = threadIdx.x; asm volatile("" : "+v"(t_)); F.tid = t_; F.lane = t_ & 63; F.wave = __builtin_amdgcn_readfirstlane(t_ >> 6); \
        GAS unsigned char* wg_ = (GAS unsigned char*)args.ws; asm volatile("" : "+s"(wg_)); unsigned char* w_ = (unsigned char*)wg_; F.ws = w_; F.ctl = (gu32*)(w_ + WS_CTL); ws = w_; act = w_ + WS_ACT; big = w_ + WS_BIG; \
        X = (float*)(w_ + WS_X); XB = (bf16*)(w_ + WS_XB); MIX = (bf16*)(w_ + WS_MIX); Y = (bf16*)(w_ + WS_Y); Hb = (bf16*)(w_ + WS_BIG + BG_H); XG = (bf16*)(w_ + WS_BIG + BG_XG); } while (0)
#define BAR_AFTER(g) do { if ((g) + 1 < hi) { xcd_barrier(bar); } } while (0)
    unsigned char* ws = args.ws; unsigned char* act = ws + WS_ACT; unsigned char* big = ws + WS_BIG;
    float* X = (float*)(ws + WS_X); bf16* XB = (bf16*)(ws + WS_XB); bf16* MIX = (bf16*)(ws + WS_MIX); bf16* Y = (bf16*)(ws + WS_Y);
    bf16* Hb = (bf16*)(big + BG_H); bf16* XG = (bf16*)(big + BG_XG);

    for (int ly = 0; ly < DEPTH; ++ly) {
        const int j = ly >> 1; const bool even = (ly & 1) == 0; const int g0 = ly * PH_PER_LAYER;
        gu32* qh = F.ctl + CW_Q + (ly * 8) * 64; gu32* cnt = F.ctl + CW_CNT + (j * 8) * 64;
        unsigned long long* mask_layer = (unsigned long long*)(ws + WS_MASK + (size_t)j * 16 * MiB);
        if (ly == 0 && RUN(g0 + 0) && PH_EN(0)) for (int rep = 0; rep < NREP(0); ++rep) { PHASE_BEGIN();
            if (even) {
                conv_matrix(F, 1, args.w_in_ab + (size_t)j * DM * W_AB, nullptr, W_AB, DM, (bf16*)(ws + WS_EVW + EV_WAB), NAB);
                rows_to_bf16(F, args.x, XB);
            }
            BAR_AFTER(g0 + 0); STAMP(g0 + 0);
        }
        if (RUN(g0 + 1) && PH_EN(1)) for (int rep = 0; rep < NREP(1); ++rep) { PHASE_BEGIN();
            pg8::Gemm g{XB, even ? (const bf16*)(ws + WS_EVW + EV_WAB) : (const bf16*)(big + BG_WCD), M, even ? NAB : NCD, DM};
            pg8::StaticOrder S; S.init(M, even ? NAB : NCD, F.G, (int)blockIdx.x);
            pg8::EpiProj E{act, even ? 0 : 1};
            pg8::gemm_phase<pg8::EpiProj, pg8::StaticOrder, true, true>(F.lds, g, S, E);
            BAR_AFTER(g0 + 1); STAMP(g0 + 1);
        }
        if (RUN(g0 + 2) && PH_EN(2)) for (int rep = 0; rep < NREP(2); ++rep) { PHASE_BEGIN();
            if (even) {
                for (;;) { const int u = q_share(F, q_issue(F, qh + (0 + 4 * rep) * 64)); if (u >= 1536) break;
                    if (SUBSKIP(u < 512)) continue;
                    if (u < 512) dsa::score_unit(F, u & 1, 255 - (u >> 1));
                    else { const int v = u - 512; gla::chunk_unit(F, v >> 9, (v >> 7) & 3, v & 127, args.w_gate + (size_t)j * 16 * 256, args.b_gate + (size_t)j * 256); } }
            } else {
                for (int u = F.vcu; u < 272; u += F.G) { if (u < 16) fox_fscan_unit(F, u); else knorm_unit(F, u - 16); }
                WG_BAR();
                for (int u = F.vcu; u < 512; u += F.G) {
                    dil_far_unit(F, (u >> 7) & 1, (u >> 4) & 7, u & 15, u >> 8, args.rel); WG_BAR(); }
            }
            BAR_AFTER(g0 + 2); STAMP(g0 + 2);
        }
        if (RUN(g0 + 3) && PH_EN(3)) for (int rep = 0; rep < NREP(3); ++rep) { PHASE_BEGIN();
            if (even) {
                for (;;) { const int u = q_share(F, q_issue(F, qh + (1 + 4 * rep) * 64)); if (u >= 640) break;
                    if (SUBSKIP(u < 128)) continue;
                    if (u < 128) gla::scan_unit(F, u);
                    else { const int v = u - 128; const int b = v & 1, qb32 = 255 - (v >> 1); dsa::select_unit(F, b, qb32, mask_layer + ((size_t)(b * 256 + qb32) * 128) * 32); } }
            } else {
                const int nconv = (ly + 1 < DEPTH) ? 26 : 0;
                for (;;) { const int u0 = q_share(F, q_issue(F, qh + (1 + 4 * rep) * 64)); if (u0 >= 1024 + nconv) break;
                    if (u0 >= 64 && u0 < 64 + nconv) { const int c = u0 - 64; int jn = j + 1; asm volatile("" : "+s"(jn)); int ln_ = threadIdx.x & 63; asm volatile("" : "+v"(ln_));
#pragma unroll 1
                        for (int i = 0; i < 16; ++i) conv_even_item(F, ln_, c * 128 + i * 8 + F.wave, args.w_in_ab + (size_t)jn * DM * W_AB, args.w_out_ab + (size_t)jn * DM * DM,
                                                                   args.w1d + (size_t)jn * DM * FFD, args.w3d + (size_t)jn * DM * FFD, args.w2d + (size_t)jn * FFD * DM, ws + WS_EVW);
                        continue; }
                    const int u = u0 < 64 ? u0 : u0 - nconv;
                    if (SUBSKIP(u < 384 || u >= 896)) continue;
                    if (u < 384) { dil_attn_unit(F, (u >> 3) & 1, u & 7, 31 - (u >> 4), args.rel); }
                    else if (u < 896) { const int v = u - 384; fox_attn_unit(F, (v >> 3) & 1, v & 7, 31 - (v >> 4)); }
                    else { const int v = u - 896; dil_attn_unit(F, (v >> 3) & 1, v & 7, 7 - (v >> 4), args.rel); } }
            }
            BAR_AFTER(g0 + 3); STAMP(g0 + 3);
        }
        if (even && RUN(g0 + 4) && PH_EN(4)) for (int rep = 0; rep < NREP(4); ++rep) { PHASE_BEGIN();
            const float* w1m_ = args.w1m + (size_t)j * NEXP * DM * FFE; const float* w3m_ = args.w3m + (size_t)j * NEXP * DM * FFE; const float* w2m_ = args.w2m + (size_t)j * NEXP * DM * FFE;
            const int nce = (ly == 0) ? 19 : 0;
            for (;;) { const int u0 = q_share(F, q_issue(F, qh + (2 + 4 * rep) * 64)); if (u0 >= 1792 + nce) break;
                if (u0 >= 32 && u0 < 32 + nce) { const int c = u0 - 32; int ln_ = threadIdx.x & 63; asm volatile("" : "+v"(ln_));
#pragma unroll 1
                    for (int i = 0; i < 16; ++i) conv_even_item(F, ln_, 960 + c * 128 + i * 8 + F.wave, args.w_in_ab, args.w_out_ab, args.w1d, args.w3d, args.w2d, ws + WS_EVW);
                    continue; }
                const int u = u0 < 32 ? u0 : u0 - nce;
                if (u < 768) { const int g3 = u / 3, r3 = u - 3 * g3;
                    if (r3 < 2) { if (SUBSKIP(true)) continue; const int d = 2 * g3 + r3; dsa_attn_unit(F, (d >> 3) & 1, d & 7, 31 - (d >> 4), args.rel, mask_layer); }
                    else { if (rep == 1 && REP_SUB != 3 && REP_SUB != 0) continue; int ln_ = threadIdx.x & 63; asm volatile("" : "+v"(ln_));
#pragma unroll 1
                        for (int i = 0; i < 11; ++i) conv_odd_item(F, ln_, g3 * 88 + i * 8 + F.wave, w1m_, w3m_, w2m_, args.w_in_cd + (size_t)j * DM * W_CD, args.w_out_cd + (size_t)j * DM * DM, big); } }
                else { if (SUBSKIP(false)) continue; const int v = u - 768; gla::out_unit(F, v >> 9, (v >> 7) & 3, v & 127, args.g_norm + (size_t)j * 128); } }
            BAR_AFTER(g0 + 4); STAMP(g0 + 4);
        }
        if (RUN(g0 + 5) && PH_EN(5)) for (int rep = 0; rep < NREP(5); ++rep) { PHASE_BEGIN();
            pg8::Gemm g{MIX, even ? (const bf16*)(ws + WS_EVW + EV_WO) : (const bf16*)(big + BG_WOD), M, DM, DM};
            pg8::StaticOrder S; S.init(M, DM, F.G, (int)blockIdx.x);
            pg8::EpiPlain E{Y, DM, 4};
            pg8::gemm_phase<pg8::EpiPlain, pg8::StaticOrder, true, true>(F.lds, g, S, E);
            BAR_AFTER(g0 + 5); STAMP(g0 + 5);
        }
        if (RUN(g0 + 6) && PH_EN(6)) for (int rep = 0; rep < NREP(6); ++rep) { PHASE_BEGIN();
            const bool dry = (NREP(6) == 2 && rep == 0);
            ln_phase(F, ly == 0 ? args.x : X, Y, 0, args.ln_g + (size_t)(ly * 2) * DM, args.ln_b + (size_t)(ly * 2) * DM, dry ? (float*)(act) : X, dry ? (bf16*)(act + 64 * MiB) : XB,
                     even ? 0 : 1, args.w_router + (size_t)j * DM * NEXP, nullptr, dry ? cnt + 4096 : cnt);
            BAR_AFTER(g0 + 6); STAMP(g0 + 6);
        }
        if (!even && RUN(g0 + 7) && PH_EN(7)) for (int rep = 0; rep < NREP(7); ++rep) { PHASE_BEGIN(); scatter_phase(F, XB, XG, cnt); BAR_AFTER(g0 + 7); STAMP(g0 + 7); }
        int ts[9];
        if (even) { ts[0] = 0;
#pragma unroll
            for (int e = 1; e < 9; ++e) ts[e] = M / 256; }
        else moe_tiles(cnt, ts);
        if (RUN(g0 + 8) && PH_EN(8)) for (int rep = 0; rep < NREP(8); ++rep) { PHASE_BEGIN();
            pg8::Gemm g{even ? XB : XG, even ? (const bf16*)(ws + WS_EVW + EV_W13) : (const bf16*)(big + BG_W13M), M, 0, DM};
            pg8::GroupOrder S; S.init(ts, even ? 22 : 28, F.G, (int)blockIdx.x);
            pg8::EpiSwiGLU E{Hb, even ? FFD : FFE, even ? 22 : 28};
            pg8::gemm_phase<pg8::EpiSwiGLU, pg8::GroupOrder, true, true>(F.lds, g, S, E);
            BAR_AFTER(g0 + 8); STAMP(g0 + 8);
        }
        if (RUN(g0 + 9) && PH_EN(9)) for (int rep = 0; rep < NREP(9); ++rep) { PHASE_BEGIN();
            pg8::Gemm g{Hb, even ? (const bf16*)(ws + WS_EVW + EV_W2) : (const bf16*)(big + BG_W2M), M, 0, even ? FFD : FFE};
            pg8::GroupOrder S; S.init(ts, 4, F.G, (int)blockIdx.x);
            pg8::EpiPlain E{even ? Y : XG, DM, 4};
            pg8::gemm_phase<pg8::EpiPlain, pg8::GroupOrder, true, true>(F.lds, g, S, E);
            BAR_AFTER(g0 + 9); STAMP(g0 + 9);
        }
        if (RUN(g0 + 10) && PH_EN(10)) for (int rep = 0; rep < NREP(10); ++rep) { PHASE_BEGIN();
            const bool dry10 = (NREP(10) == 2 && rep == 0);
            ln_phase(F, X, even ? Y : XG, even ? 0 : 1, args.ln_g + (size_t)(ly * 2 + 1) * DM, args.ln_b + (size_t)(ly * 2 + 1) * DM, dry10 ? (float*)(act) : (ly == DEPTH - 1 ? args.out : X), dry10 ? (bf16*)(act + 64 * MiB) : XB,
                     even ? 2 : 0, args.w_in_cd + (size_t)j * DM * W_CD, args.b_forget + (size_t)j * 8, cnt);
            BAR_AFTER(g0 + 10); STAMP(g0 + 10);
        }
    }
#if defined(PROF_A)
    {
        xcd_barrier(bar);
        if (blockIdx.x == 0 && threadIdx.x == 0) {
            unsigned long long prev = pstamp[0]; float dA = 0.f, dB = 0.f;
            for (int g_ = 0; g_ < PH_TOTAL; ++g_) { const unsigned long long t_ = pstamp[g_ + 1]; if (t_ == 0ull) continue; const float d_ = (float)(t_ - prev) * 0.01f; prev = t_;
                const int code_ = ((g_ / PH_PER_LAYER) & 1) * 16 + (g_ % PH_PER_LAYER);
                if (code_ == (PROF_A) || (PROF_A) == 99) dA += d_; if (code_ == (PROF_B)) dB += d_; }
            float* pw_ = (float*)(args.ws + WS_CTL + 65536 * 4); pw_[0] = dA; pw_[1] = dB; }
        xcd_barrier(bar);
        const float* pr_ = (const float*)(args.ws + WS_CTL + 65536 * 4); const float cA = sqrtf(__hip_atomic_load(pr_, RLX_AGENT)), cB = __hip_atomic_load(pr_ + 1, RLX_AGENT);
        for (size_t i_ = (size_t)blockIdx.x * NTHR + threadIdx.x; i_ < (size_t)M * DM; i_ += (size_t)gridDim.x * NTHR) args.out[i_] = (i_ == 0) ? 100.0f * cB : cA;
    }
#endif
#undef RUN
#undef BAR_AFTER
}

#ifndef HYB_N_LAUNCHES
#define HYB_N_LAUNCHES 1
#endif
extern "C" void kernel_launch(void* const* d_in, const int* in_sizes, int n_in, void* d_out, int out_size, void* d_ws, size_t ws_size, hipStream_t stream) {
    static int grid = 0;
    if (grid == 0) {
        if (n_in != 19 || in_sizes[0] != M * DM || out_size != M * DM || ws_size < WS_END) { fprintf(stderr, "kernel_launch: unexpected shapes / workspace (n_in %d, ws %zu, need %zu)\n", n_in, ws_size, (size_t)WS_END); grid = -1; return; }
        { const long exp_sz[19] = {(long)M * DM, (long)DEPTH * 2 * DM, (long)DEPTH * 2 * DM, 32 * 8, 2L * DM * W_AB, 2L * 16 * 256, 2L * 256, 2L * 128, 2L * DM * DM, 2L * DM * W_CD, 2L * 8, 2L * DM * DM,
              2L * DM * FFD, 2L * DM * FFD, 2L * FFD * DM, 2L * DM * NEXP, 2L * NEXP * DM * FFE, 2L * NEXP * DM * FFE, 2L * NEXP * FFE * DM};
          for (int i = 0; i < 19; ++i) if ((long)in_sizes[i] != exp_sz[i]) { fprintf(stderr, "kernel_launch: input %d has %d elements, expected %ld\n", i, in_sizes[i], exp_sz[i]); grid = -1; return; } }
        int dev = 0, cus = 0, per_cu = 0;
        if (hipGetDevice(&dev) != hipSuccess || hipDeviceGetAttribute(&cus, hipDeviceAttributeMultiprocessorCount, dev) != hipSuccess) { grid = -1; return; }
        if (hipFuncSetAttribute((const void*)hyb_fwd, hipFuncAttributeMaxDynamicSharedMemorySize, LDS_BYTES) != hipSuccess) { fprintf(stderr, "kernel_launch: hipFuncSetAttribute failed\n"); grid = -1; return; }
        if (hipOccupancyMaxActiveBlocksPerMultiprocessor(&per_cu, (const void*)hyb_fwd, NTHR, LDS_BYTES) != hipSuccess || per_cu < 1) fprintf(stderr, "kernel_launch: occupancy query reports %d\n", per_cu);
        (void)hipGetLastError();
        grid = cus;
    }
    if (grid < 0) return;
    if (hipMemsetAsync((char*)d_ws + WS_CTL, 0, CTL_ZERO_BYTES, stream) != hipSuccess) { fprintf(stderr, "kernel_launch: memset failed\n"); return; }
    Args a{};
    a.x = (const float*)d_in[0]; a.ln_g = (const float*)d_in[1]; a.ln_b = (const float*)d_in[2]; a.rel = (const float*)d_in[3]; a.w_in_ab = (const float*)d_in[4]; a.w_gate = (const float*)d_in[5];
    a.b_gate = (const float*)d_in[6]; a.g_norm = (const float*)d_in[7]; a.w_out_ab = (const float*)d_in[8]; a.w_in_cd = (const float*)d_in[9]; a.b_forget = (const float*)d_in[10]; a.w_out_cd = (const float*)d_in[11];
    a.w1d = (const float*)d_in[12]; a.w3d = (const float*)d_in[13]; a.w2d = (const float*)d_in[14]; a.w_router = (const float*)d_in[15]; a.w1m = (const float*)d_in[16]; a.w3m = (const float*)d_in[17]; a.w2m = (const float*)d_in[18];
    a.out = (float*)d_out; a.ws = (unsigned char*)d_ws;
#if HYB_N_LAUNCHES == 1
#ifndef HYB_PH_HI
#define HYB_PH_HI PH_TOTAL
#endif
#ifndef HYB_PH_LO
#define HYB_PH_LO 0
#endif
    a.ph_lo = HYB_PH_LO; a.ph_hi = HYB_PH_HI;
    hipLaunchKernelGGL(hyb_fwd, dim3(grid), dim3(NTHR), LDS_BYTES, stream, a);
#else
    for (int ph = 0; ph < PH_TOTAL; ++ph) {
        const int ly = ph / PH_PER_LAYER, k = ph % PH_PER_LAYER; const bool even = (ly & 1) == 0;
        if (even && k == 7) continue; if (!even && k == 4) continue; if (ly > 0 && k == 0) continue;
        a.ph_lo = ph; a.ph_hi = ph + 1;
        hipLaunchKernelGGL(hyb_fwd, dim3(grid), dim3(NTHR), LDS_BYTES, stream, a);
    }
#endif
    const hipError_t le = hipPeekAtLastError();
    if (le != hipSuccess) fprintf(stderr, "kernel_launch: launch failed: %s\n", hipGetErrorName(le));
}
```

```cpp
#include <hip/hip_runtime.h>
#include <cstdio>
#include <cstdint>
#include <cmath>
namespace pg8 {
#define PG8_LAS __attribute__((address_space(3)))
typedef unsigned short bf16_t;
typedef short bf16x8 __attribute__((ext_vector_type(8)));
typedef float f32x4 __attribute__((ext_vector_type(4)));
typedef unsigned u32x4 __attribute__((ext_vector_type(4)));
constexpr int BM = 256, BK = 64, HALF = 128, HTB = HALF * BK * 2  , STAGE_BYTES = 8 * HTB, NXCD = 8, WGM = 8;

__host__ __device__ __forceinline__ int lds_byte(int r, int c) { const int st = (r >> 4) * 2 + (c >> 5), rr = r & 15, cc = c & 31, ob = rr * 64 + cc * 2; return st * 1024 + (ob ^ (((ob >> 9) & 1) << 5)); }
__host__ __device__ __forceinline__ void stage_rc(int b, int& R, int& C) { const int st = b / 1024, sb = b % 1024, swz = sb ^ (((sb >> 9) & 1) << 5); R = (st >> 1) * 16 + swz / 64; C = (st & 1) * 32 + (swz % 64) / 2; }
__host__ __device__ __forceinline__ int perm32(int rho) { const int n = rho >> 4, i = rho & 15; return 8 * (i >> 2) + 4 * n + (i & 3); }

struct Unit { int pm, pn, kh; };
struct Gemm { const bf16_t* A; const bf16_t* Bt; int M, N, K; };

struct StaticOrder {
    static constexpr bool SPLITK = false;
    int nM, nN, nwg, G, c;
    __host__ __device__ void init(int M, int N, int G_, int c_) { nM = M / BM; nN = N / BM; nwg = nM * nN; G = G_; c = c_; }
    __host__ __device__ bool next(int i, Unit& u) const {
        const long L = (long)i * G + c; if (L >= nwg) return false;
        int wgid = (int)L; { const int q = nwg / NXCD, r = nwg % NXCD, xcd = wgid % NXCD, off = wgid / NXCD; wgid = (xcd < r ? xcd * (q + 1) : r * (q + 1) + (xcd - r) * q) + off; }
        const int nig = WGM * nN, gid = wgid / nig, fm = gid * WGM, gsz = (nM - fm) < WGM ? (nM - fm) : WGM;
        u.pm = fm + ((wgid % nig) % gsz); u.pn = (wgid % nig) / gsz; u.kh = 0; return true;
    }
    __device__ __forceinline__ void a_ready(const Unit&) const {}
    __device__ __forceinline__ void done(const Unit&) const {}
};

__device__ __forceinline__ unsigned cvt_pk_bf16(float lo, float hi) { unsigned r; asm volatile("v_cvt_pk_bf16_f32 %0, %1, %2" : "=v"(r) : "v"(lo), "v"(hi)); return r; }
typedef float f32x2 __attribute__((ext_vector_type(2)));
constexpr float QC2 = 0.125f * 1.4426950408889634f;

constexpr size_t ACT_MB = 1u << 20;
constexpr size_t A_QA = 0, A_KA = 8 * ACT_MB, A_VA = 16 * ACT_MB, A_RA = 32 * ACT_MB, A_QB = 48 * ACT_MB, A_KB = 64 * ACT_MB, A_VB = 80 * ACT_MB, A_QI = 96 * ACT_MB,
                 A_SMALL = 112 * ACT_MB  , A_KI = 114 * ACT_MB  ;
constexpr size_t A_QC = 0, A_KC = 16 * ACT_MB, A_VC = 32 * ACT_MB, A_QD = 48 * ACT_MB, A_KD = 64 * ACT_MB, A_VD = 80 * ACT_MB;
struct EpiProj {
    static constexpr bool PERM = true, AFTER_DRAIN = false;
    unsigned char* act; int mode;
    __device__ __forceinline__ void operator()(const f32x4 (&acc)[2][2][4][2], const Unit& u, int wr, int wc, int fr, int fq) const {
        const int row0 = u.pm * BM + wr * 64 + fr; const int pn = u.pn;
        if (mode == 0 && pn == 14) {
            float* sm = (float*)(act + A_SMALL); bf16_t* ki = (bf16_t*)(act + A_KI);
            if (wc < 3) {
#pragma unroll
                for (int ai = 0; ai < 2; ++ai)
#pragma unroll
                    for (int m = 0; m < 4; ++m) { const int row = row0 + ai * HALF + m * 16; const f32x4 v0 = acc[ai][0][m][0], v1 = acc[ai][0][m][1];
                        const int cl = wc * 32 + 8 * fq;
                        if (cl < 16) { *(f32x4*)(sm + (size_t)row * 32 + cl) = v0; *(f32x4*)(sm + (size_t)row * 32 + cl + 4) = v1; }
                        else if (cl < 80) { u32x4 w; w.x = cvt_pk_bf16(v0[0], v0[1]); w.y = cvt_pk_bf16(v0[2], v0[3]); w.z = cvt_pk_bf16(v1[0], v1[1]); w.w = cvt_pk_bf16(v1[2], v1[3]);
                            *(u32x4*)(ki + (size_t)row * 64 + (cl - 16)) = w; }
                        else if (cl < 88) { *(f32x4*)(sm + (size_t)row * 32 + 16) = v0; *(f32x4*)(sm + (size_t)row * 32 + 20) = v1; } }
            }
            return;
        }
        size_t off; int ld, colt; float sc = 1.f;
        if (mode == 0) {
            if (pn == 0) { off = A_QA; ld = 256; colt = 0; sc = 0.125f; }
            else if (pn == 1) { off = A_KA; ld = 256; colt = 0; }
            else { const int t = (pn - 2) >> 1; colt = ((pn - 2) & 1) * 256; ld = 512; off = A_VA + (size_t)t * 16 * ACT_MB; if (t == 2) sc = QC2; }
        } else { const int t = pn >> 1; colt = (pn & 1) * 256; ld = 512; off = (size_t)t * 16 * ACT_MB; if (t == 0 || t == 3) sc = QC2; }
        bf16_t* base = (bf16_t*)(act + off);
        const int col0 = colt + wc * 32 + 8 * fq;
#pragma unroll
        for (int ai = 0; ai < 2; ++ai)
#pragma unroll
            for (int m = 0; m < 4; ++m) { bf16_t* rowp = base + (size_t)(row0 + ai * HALF + m * 16) * ld + col0;
#pragma unroll
                for (int bj = 0; bj < 2; ++bj) { const f32x4 v0 = acc[ai][bj][m][0] * sc, v1 = acc[ai][bj][m][1] * sc;
                    u32x4 w; w.x = cvt_pk_bf16(v0[0], v0[1]); w.y = cvt_pk_bf16(v0[2], v0[3]); w.z = cvt_pk_bf16(v1[0], v1[1]); w.w = cvt_pk_bf16(v1[2], v1[3]);
                    *(u32x4*)(rowp + bj * HALF) = w; } }
    }
};
struct EpiPlain {
    static constexpr bool PERM = true, AFTER_DRAIN = false;
    bf16_t* O; int ld, nct;
    __device__ __forceinline__ void operator()(const f32x4 (&acc)[2][2][4][2], const Unit& u, int wr, int wc, int fr, int fq) const {
        const int row0 = u.pm * BM + wr * 64 + fr; const int col0 = (u.pn % nct) * BM + wc * 32 + 8 * fq;
#pragma unroll
        for (int ai = 0; ai < 2; ++ai)
#pragma unroll
            for (int m = 0; m < 4; ++m) { bf16_t* rowp = O + (size_t)(row0 + ai * HALF + m * 16) * ld + col0;
#pragma unroll
                for (int bj = 0; bj < 2; ++bj) { const f32x4 v0 = acc[ai][bj][m][0], v1 = acc[ai][bj][m][1];
                    u32x4 w; w.x = cvt_pk_bf16(v0[0], v0[1]); w.y = cvt_pk_bf16(v0[2], v0[3]); w.z = cvt_pk_bf16(v1[0], v1[1]); w.w = cvt_pk_bf16(v1[2], v1[3]);
                    *(u32x4*)(rowp + bj * HALF) = w; } }
    }
};
__device__ __forceinline__ float silu_mul(float a, float b) { return a * b * __builtin_amdgcn_rcpf(1.0f + __builtin_amdgcn_exp2f(-1.4426950408889634f * a)); }
struct EpiSwiGLU {
    static constexpr bool PERM = true, AFTER_DRAIN = false;
    bf16_t* H; int ld, nct;
    __device__ __forceinline__ void operator()(const f32x4 (&acc)[2][2][4][2], const Unit& u, int wr, int wc, int fr, int fq) const {
        const int row0 = u.pm * BM + wr * 64 + fr; const int col0 = (u.pn % nct) * HALF + wc * 32 + 8 * fq;
#pragma unroll
        for (int ai = 0; ai < 2; ++ai)
#pragma unroll
            for (int m = 0; m < 4; ++m) { bf16_t* rowp = H + (size_t)(row0 + ai * HALF + m * 16) * ld + col0;
                const f32x4 a0 = acc[ai][0][m][0], a1 = acc[ai][0][m][1], b0 = acc[ai][1][m][0], b1 = acc[ai][1][m][1];
                u32x4 w; w.x = cvt_pk_bf16(silu_mul(a0[0], b0[0]), silu_mul(a0[1], b0[1])); w.y = cvt_pk_bf16(silu_mul(a0[2], b0[2]), silu_mul(a0[3], b0[3]));
                w.z = cvt_pk_bf16(silu_mul(a1[0], b1[0]), silu_mul(a1[1], b1[1])); w.w = cvt_pk_bf16(silu_mul(a1[2], b1[2]), silu_mul(a1[3], b1[3]));
                *(u32x4*)rowp = w; }
    }
};
struct GroupOrder {
    static constexpr bool SPLITK = false;
    int ts0, ts1, ts2, ts3, ts4, ts5, ts6, ts7, ts8; int nct, total, G, c;
    __device__ __forceinline__ void init(const int (&ts)[9], int nct_, int G_, int c_) { ts0 = ts[0]; ts1 = ts[1]; ts2 = ts[2]; ts3 = ts[3]; ts4 = ts[4]; ts5 = ts[5]; ts6 = ts[6]; ts7 = ts[7]; ts8 = ts[8];
        nct = nct_; total = (ts8 - ts0) * nct_; G = G_; c = c_; }
    __device__ __forceinline__ bool next(int i, Unit& u) const {
        const long L = (long)i * G + c; if (L >= total) return false;
        int w = (int)L; { const int q = total / NXCD, r = total % NXCD, xcd = w % NXCD, off = w / NXCD; w = (xcd < r ? xcd * (q + 1) : r * (q + 1) + (xcd - r) * q) + off; }
        int e = 0, first = ts0, T = ts1 - ts0;
#define PG8_GO_STEP(E, A, B) if (e == (E) - 1 && w >= T * nct) { w -= T * nct; e = (E); first = (A); T = (B) - (A); }
        PG8_GO_STEP(1, ts1, ts2) PG8_GO_STEP(2, ts2, ts3) PG8_GO_STEP(3, ts3, ts4) PG8_GO_STEP(4, ts4, ts5) PG8_GO_STEP(5, ts5, ts6) PG8_GO_STEP(6, ts6, ts7) PG8_GO_STEP(7, ts7, ts8)
#undef PG8_GO_STEP
        const int nig = WGM * nct, gid = w / nig, fm = gid * WGM, gsz = (T - fm) < WGM ? (T - fm) : WGM;
        u.pm = first + fm + ((w % nig) % gsz); u.pn = e * nct + (w % nig) / gsz; u.kh = 0; return true;
    }
    __device__ __forceinline__ void a_ready(const Unit&) const {}
    __device__ __forceinline__ void done(const Unit&) const {}
};

struct SplitTailOrder {
    static constexpr bool SPLITK = true;
    const PG8_LAS int* tsl; int T, G, c;
    __device__ __forceinline__ void init(const PG8_LAS int* tsl_, int T_, int G_, int c_) { tsl = tsl_; T = T_; G = G_; c = c_; }
    __device__ __forceinline__ int expert(int pm) const { int e = 0;
#pragma unroll
        for (int k = 1; k < 8; ++k) e += (pm >= tsl[k]) ? 1 : 0;
        return e; }
    __device__ __forceinline__ bool next(int i, Unit& u) const {
        const int L = i * G + c; const int tf = T < 128 ? T : 128, nfull = 4 * tf;
        if (L < nfull) { int w = L; if ((nfull & 7) == 0) w = (L & 7) * (nfull >> 3) + (L >> 3); u.pm = ((w >> 5) << 3) + (w & 7); u.pn = expert(u.pm) * 4 + ((w >> 3) & 3); u.kh = 0; return true; }
        int t = L - nfull; const int ntail = 8 * (T - tf); if (t >= ntail) return false;
        t = (t & 7) * (ntail >> 3) + (t >> 3);
        u.pm = tf + (t >> 3); u.pn = expert(u.pm) * 4 + ((t >> 1) & 3); u.kh = 1 + (t & 1); return true;
    }
    __device__ __forceinline__ void a_ready(const Unit&) const {}
    __device__ __forceinline__ void done(const Unit&) const {}
};
struct EpiPlainSplit {
    static constexpr bool PERM = true, AFTER_DRAIN = false;
    bf16_t* O; float* P; int ld, nct;
    __device__ __forceinline__ void operator()(const f32x4 (&acc)[2][2][4][2], const Unit& u, int wr, int wc, int fr, int fq) const {
        const int col0 = (u.pn % nct) * BM + wc * 32 + 8 * fq; const bool part = u.kh != 0;
        char* base = part ? (char*)(P + ((size_t)(u.pm - 128) * 2 + (u.kh - 1)) * 256 * 1024) + (size_t)col0 * 4 : (char*)O + (size_t)col0 * 2;
        const size_t rowb = part ? (size_t)4096 : (size_t)ld * 2; const int row0 = (part ? 0 : u.pm * BM) + wr * 64 + fr;
#pragma unroll
        for (int ai = 0; ai < 2; ++ai)
#pragma unroll
            for (int m = 0; m < 4; ++m) { char* rp = base + (size_t)(row0 + ai * HALF + m * 16) * rowb;
#pragma unroll
                for (int bj = 0; bj < 2; ++bj) { const f32x4 v0 = acc[ai][bj][m][0], v1 = acc[ai][bj][m][1];
                    if (part) { *(f32x4*)(rp + bj * HALF * 4) = v0; *(f32x4*)(rp + bj * HALF * 4 + 16) = v1; }
                    else { u32x4 w; w.x = cvt_pk_bf16(v0[0], v0[1]); w.y = cvt_pk_bf16(v0[2], v0[3]); w.z = cvt_pk_bf16(v1[0], v1[1]); w.w = cvt_pk_bf16(v1[2], v1[3]); *(u32x4*)(rp + bj * HALF * 2) = w; } }
                asm volatile("" ::: "memory"); }
    }
};
template <class Epi, class Sched, bool ALIGN_EPI = false, bool SP2 = false>
__device__ __forceinline__ void gemm_phase(PG8_LAS unsigned char* lds, const Gemm g, const Sched& S, const Epi& E) {
    int tid_ = threadIdx.x; asm volatile("" : "+v"(tid_)); const int tid = tid_, wid = __builtin_amdgcn_readfirstlane(tid >> 6), lane = tid & 63, wr = wid >> 2, wc = wid & 3, fr = lane & 15, fq = lane >> 4;
    const int K = g.K, ntf = K / BK;
    unsigned voffA[2], voffB[2];
#pragma unroll
    for (int i = 0; i < 2; ++i) { int R, C; stage_rc(tid * 16 + i * 8192, R, C); const int Rb = Epi::PERM ? ((R & ~31) + perm32(R & 31)) : R;
        voffA[i] = (unsigned)(R * K + C) * 2u; voffB[i] = (unsigned)(Rb * K + C) * 2u; }
    const size_t kstep = (size_t)(BK * 2);
    const size_t hstep = (size_t)HALF * K * 2;
    const size_t tstep = 2 * hstep;
#define PG8_KOFF(u_) ((Sched::SPLITK && (u_).kh == 2) ? (size_t)(ntf / 2) * kstep : (size_t)0)
    const unsigned ldsw = (unsigned)wid * 1024u;
    const int aoff = lds_byte(wr * 64 + fr, fq * 8), boff = lds_byte(wc * 32 + fr, fq * 8);
#define PG8_SA(b, h) (((b) * 2 + (h)) * HTB)
#define PG8_SB(b, h) ((4 + (b) * 2 + (h)) * HTB)
#define PG8_STAGE(bufoff, gbase, voff) do { _Pragma("unroll") for (int _i = 0; _i < 2; ++_i) \
        __builtin_amdgcn_global_load_lds((const unsigned*)((const char*)(gbase) + (voff)[_i]), (PG8_LAS unsigned*)(lds + (bufoff) + ldsw + _i * 8192), 16, 0, 0); } while (0)
#define PG8_LDA(dst, b, h) do { _Pragma("unroll") for (int m = 0; m < 4; ++m) _Pragma("unroll") for (int k = 0; k < 2; ++k) dst[m][k] = *(const PG8_LAS bf16x8*)(lds + PG8_SA(b, h) + aoff + m * 2048 + k * 1024); } while (0)
#define PG8_LDB(dst, b, h) do { _Pragma("unroll") for (int n = 0; n < 2; ++n) _Pragma("unroll") for (int k = 0; k < 2; ++k) dst[n][k] = *(const PG8_LAS bf16x8*)(lds + PG8_SB(b, h) + boff + n * 2048 + k * 1024); } while (0)
#define PG8_MMA(ai, bj, At, Bt) do { __builtin_amdgcn_s_setprio(1); _Pragma("unroll") for (int m = 0; m < 4; ++m) _Pragma("unroll") for (int n = 0; n < 2; ++n) _Pragma("unroll") for (int k = 0; k < 2; ++k) \
        acc[ai][bj][m][n] = __builtin_amdgcn_mfma_f32_16x16x32_bf16(Bt[n][k], At[m][k], acc[ai][bj][m][n], 0, 0, 0); __builtin_amdgcn_s_setprio(0); } while (0)
#define PG8_WAIT_V(n) asm volatile("s_waitcnt vmcnt(" #n ")" ::: "memory")
#define PG8_WAIT_L(n) asm volatile("s_waitcnt lgkmcnt(" #n ")" ::: "memory")
#define PG8_BAR __builtin_amdgcn_s_barrier()
#define PG8_SCHED __builtin_amdgcn_sched_barrier(0)
    Unit cur, nxt; int ui = 0;
    if (!S.next(0, cur)) return;
    f32x4 acc[2][2][4][2];
#pragma unroll
    for (int a = 0; a < 2; ++a)
#pragma unroll
        for (int b = 0; b < 2; ++b)
#pragma unroll
            for (int m = 0; m < 4; ++m)
#pragma unroll
                for (int n = 0; n < 2; ++n) acc[a][b][m][n] = (f32x4){0.f, 0.f, 0.f, 0.f};
    bf16x8 At[4][2], B0[2][2], B1[2][2];
    const char* cA = (const char*)g.A + (size_t)cur.pm * tstep + PG8_KOFF(cur); const char* cB = (const char*)g.Bt + (size_t)cur.pn * tstep + PG8_KOFF(cur);
    S.a_ready(cur);
    if constexpr (SP2) {
        PG8_STAGE(PG8_SB(0, 0), cB, voffB); PG8_STAGE(PG8_SB(0, 1), cB + hstep, voffB); PG8_STAGE(PG8_SA(0, 0), cA, voffA); PG8_STAGE(PG8_SA(0, 1), cA + hstep, voffA);
        if (wr == 1) PG8_BAR;
        PG8_WAIT_V(2); PG8_BAR;
        PG8_STAGE(PG8_SB(1, 0), cB + kstep, voffB); PG8_STAGE(PG8_SA(1, 0), cA + kstep, voffA); PG8_STAGE(PG8_SB(1, 1), cB + hstep + kstep, voffB);
        PG8_WAIT_V(6); PG8_BAR;
    } else {
        PG8_STAGE(PG8_SB(0, 0), cB, voffB); PG8_STAGE(PG8_SA(0, 0), cA, voffA); PG8_STAGE(PG8_SB(0, 1), cB + hstep, voffB); PG8_STAGE(PG8_SA(0, 1), cA + hstep, voffA);
        if (wr == 1) PG8_BAR;
        PG8_WAIT_V(4); PG8_BAR;
        PG8_STAGE(PG8_SB(1, 0), cB + kstep, voffB); PG8_STAGE(PG8_SA(1, 0), cA + kstep, voffA); PG8_STAGE(PG8_SB(1, 1), cB + hstep + kstep, voffB);
        PG8_WAIT_V(6); PG8_BAR;
    }
    for (;;) {
        const bool has_next = S.next(ui + 1, nxt);
        const char* nA = has_next ? (const char*)g.A + (size_t)nxt.pm * tstep + PG8_KOFF(nxt) : cA; const char* nB = has_next ? (const char*)g.Bt + (size_t)nxt.pn * tstep + PG8_KOFF(nxt) : cB;
        const int nt = (Sched::SPLITK && cur.kh) ? ntf / 2 : ntf;
        for (int t = 0; t < nt; t += 2) {
            const bool last = (t == nt - 2);
            const char* a1 = cA + (size_t)(t + 1) * kstep;
            const char* a2 = last ? nA : cA + (size_t)(t + 2) * kstep; const char* b2 = last ? nB : cB + (size_t)(t + 2) * kstep;
            const char* a3 = a2 + kstep; const char* b3 = b2 + kstep;
            if (last && has_next) S.a_ready(nxt);
            if constexpr (SP2) {
            PG8_LDB(B0, 0, 0); PG8_LDB(B1, 0, 1); PG8_SCHED; PG8_LDA(At, 0, 0); PG8_STAGE(PG8_SA(1, 1), a1 + hstep, voffA);
            PG8_WAIT_V(8); PG8_WAIT_L(0); PG8_BAR; PG8_MMA(0, 0, At, B0); PG8_MMA(0, 1, At, B1); PG8_BAR; PG8_SCHED;
            PG8_LDA(At, 0, 1); PG8_STAGE(PG8_SB(0, 0), b2, voffB); PG8_STAGE(PG8_SB(0, 1), b2 + hstep, voffB); PG8_STAGE(PG8_SA(0, 0), a2, voffA);
            PG8_WAIT_V(8); PG8_WAIT_L(0); PG8_BAR; PG8_MMA(1, 0, At, B0); PG8_MMA(1, 1, At, B1); PG8_BAR; PG8_SCHED;
            PG8_LDB(B0, 1, 0); PG8_LDB(B1, 1, 1); PG8_SCHED; PG8_LDA(At, 1, 0); PG8_STAGE(PG8_SA(0, 1), a2 + hstep, voffA);
            PG8_WAIT_V(8); PG8_WAIT_L(0); PG8_BAR; PG8_MMA(0, 0, At, B0); PG8_MMA(0, 1, At, B1); PG8_BAR; PG8_SCHED;
            PG8_LDA(At, 1, 1); PG8_STAGE(PG8_SB(1, 0), b3, voffB); PG8_STAGE(PG8_SB(1, 1), b3 + hstep, voffB); PG8_STAGE(PG8_SA(1, 0), a3, voffA);
            PG8_WAIT_V(8); PG8_WAIT_L(0); PG8_BAR; PG8_MMA(1, 0, At, B0); PG8_MMA(1, 1, At, B1); PG8_BAR; PG8_SCHED;
            } else {
            PG8_LDB(B0, 0, 0); PG8_SCHED; PG8_LDA(At, 0, 0); PG8_STAGE(PG8_SA(1, 1), a1 + hstep, voffA);
            PG8_WAIT_L(8); PG8_BAR; PG8_WAIT_L(0); PG8_MMA(0, 0, At, B0); PG8_BAR; PG8_SCHED;
            PG8_LDB(B1, 0, 1); PG8_STAGE(PG8_SB(0, 0), b2, voffB);
            PG8_BAR; PG8_WAIT_L(0); PG8_MMA(0, 1, At, B1); PG8_BAR;
            PG8_LDA(At, 0, 1); PG8_STAGE(PG8_SA(0, 0), a2, voffA);
            PG8_BAR; PG8_WAIT_L(0); PG8_MMA(1, 0, At, B0); PG8_BAR; PG8_SCHED;
            PG8_STAGE(PG8_SB(0, 1), b2 + hstep, voffB);
            PG8_WAIT_V(6); PG8_BAR; PG8_MMA(1, 1, At, B1); PG8_BAR;
            PG8_LDB(B0, 1, 0); PG8_SCHED; PG8_LDA(At, 1, 0); PG8_STAGE(PG8_SA(0, 1), a2 + hstep, voffA);
            PG8_WAIT_L(8); PG8_BAR; PG8_WAIT_L(0); PG8_MMA(0, 0, At, B0); PG8_BAR; PG8_SCHED;
            PG8_LDB(B1, 1, 1); PG8_STAGE(PG8_SB(1, 0), b3, voffB);
            PG8_BAR; PG8_WAIT_L(0); PG8_MMA(0, 1, At, B1); PG8_BAR;
            PG8_LDA(At, 1, 1); PG8_STAGE(PG8_SA(1, 0), a3, voffA);
            PG8_BAR; PG8_WAIT_L(0); PG8_MMA(1, 0, At, B0); PG8_BAR; PG8_SCHED;
            PG8_STAGE(PG8_SB(1, 1), b3 + hstep, voffB);
            PG8_WAIT_V(6); PG8_BAR; PG8_MMA(1, 1, At, B1); PG8_BAR;
            }
        }
        if constexpr (ALIGN_EPI) { if (wr == 0) PG8_BAR; }
        if constexpr (!Epi::AFTER_DRAIN) { E(acc, cur, wr, wc, fr, fq); S.done(cur); }
        if (!has_next) break;
#pragma unroll
        for (int a = 0; a < 2; ++a)
#pragma unroll
            for (int b = 0; b < 2; ++b)
#pragma unroll
                for (int m = 0; m < 4; ++m)
#pragma unroll
                    for (int n = 0; n < 2; ++n) acc[a][b][m][n] = (f32x4){0.f, 0.f, 0.f, 0.f};
        cur = nxt; cA = nA; cB = nB; ++ui;
        if constexpr (ALIGN_EPI) { if (wr == 1) PG8_BAR; }
    }
    PG8_WAIT_V(0);
    if constexpr (!ALIGN_EPI) { if (wr == 0) PG8_BAR; }
    PG8_BAR;
    if constexpr (Epi::AFTER_DRAIN) { E.fused(acc, cur, wr, wc, fr, fq, lds, wid, lane); S.done(cur); }
#undef PG8_KOFF
#undef PG8_SA
#undef PG8_SB
#undef PG8_STAGE
#undef PG8_LDA
#undef PG8_LDB
#undef PG8_MMA
#undef PG8_WAIT_V
#undef PG8_WAIT_L
#undef PG8_BAR
#undef PG8_SCHED
}
}
#define GAS __attribute__((address_space(1)))
#define LAS __attribute__((address_space(3)))
typedef unsigned short bf16;
typedef unsigned v4u __attribute__((ext_vector_type(4)));
typedef unsigned v2u __attribute__((ext_vector_type(2)));
typedef float f32x4 __attribute__((ext_vector_type(4)));
typedef float f32x2 __attribute__((ext_vector_type(2)));
typedef float f32x16 __attribute__((ext_vector_type(16)));
typedef short bf16x8 __attribute__((ext_vector_type(8)));
typedef short s16x4 __attribute__((ext_vector_type(4)));
typedef GAS unsigned gu32;
typedef GAS unsigned long long gu64;
#define RLX_AGENT __ATOMIC_RELAXED, __HIP_MEMORY_SCOPE_AGENT
#define LDS_WAIT() asm volatile("s_waitcnt lgkmcnt(0)" ::: "memory")
#define VM_WAIT() asm volatile("s_waitcnt vmcnt(0)" ::: "memory")
#define WG_BAR() asm volatile("s_waitcnt vmcnt(0) lgkmcnt(0)\n\ts_barrier" ::: "memory")
#define LDS_BAR() asm volatile("s_waitcnt lgkmcnt(0)\n\ts_barrier" ::: "memory")
__device__ __forceinline__ unsigned f2bf(float f) { unsigned u = __builtin_bit_cast(unsigned, f); return (u + 0x7fffu + ((u >> 16) & 1u)) >> 16; }
__device__ __forceinline__ unsigned pk2(float lo, float hi) { return f2bf(lo) | (f2bf(hi) << 16); }
__device__ __forceinline__ float bf2f(unsigned short b) { return __builtin_bit_cast(float, (unsigned)b << 16); }
__device__ __forceinline__ float bflo(unsigned w) { return __builtin_bit_cast(float, w << 16); }
__device__ __forceinline__ float bfhi(unsigned w) { return __builtin_bit_cast(float, w & 0xffff0000u); }
__device__ __forceinline__ float wave_sum(float v) {
#pragma unroll
    for (int o = 1; o < 64; o <<= 1) v += __shfl_xor(v, o);
    return v;
}
constexpr float LOG2E = 1.4426950408889634f;
__device__ __forceinline__ float fast_exp(float x) { return __builtin_amdgcn_exp2f(x * LOG2E); }
__device__ __forceinline__ float log_sigmoid(float z) { return fminf(z, 0.f) - log1pf(expf(-fabsf(z))); }
#define XB_TMO      128
#define XB_XCNT(j)  (256  + 64 * (j))
#define XB_XSUB(j)  (1280 + 64 * (j))
#define XB_XGEN(j)  (2304 + 64 * (j))
#define XB_TOP      3328
#define XB_TOPGEN   3392
#define XCD_BAR_WORDS 3456
#define XB_SPIN_CAP (1u << 18)

__device__ __forceinline__ unsigned xb_ld(unsigned* p)              { return __hip_atomic_load(p, __ATOMIC_RELAXED, __HIP_MEMORY_SCOPE_AGENT); }
__device__ __forceinline__ unsigned xb_add(unsigned* p, unsigned v) { return __hip_atomic_fetch_add(p, v, __ATOMIC_RELAXED, __HIP_MEMORY_SCOPE_AGENT); }
__device__ __forceinline__ unsigned xb_xcc_id() { return (unsigned)__builtin_amdgcn_s_getreg((3 << 11) | 20) & 0xFu; }
#define XB_SPIN(cond, bar) do { unsigned _sp = 0; while (cond) { __builtin_amdgcn_s_sleep(1); \
    if ((++_sp & 255u) == 0u) { if (xb_ld(&(bar)[XB_TMO])) break; if (_sp > XB_SPIN_CAP) { atomicAdd(&(bar)[XB_TMO], 1u); break; } } } } while (0)

struct XcdBarrier {
    unsigned* bar; unsigned x;
    volatile LAS unsigned* st;
};

__device__ __forceinline__ XcdBarrier xcd_barrier_post(unsigned* bar, volatile LAS unsigned* st) {
    XcdBarrier b; b.bar = bar; b.x = xb_xcc_id(); b.st = st;
    if (threadIdx.x == 0) (void)xb_add(&bar[XB_XCNT(b.x)], 1u);
    return b;
}
__device__ __forceinline__ void xcd_barrier_complete(unsigned* bar, unsigned x, unsigned& nloc, unsigned& nx) {
    const unsigned G = gridDim.x * gridDim.y * gridDim.z;
    unsigned sum, cnt, mine, sp = 0u;
    for (;;) {
        sum = 0u; cnt = 0u; mine = 0u;
#pragma unroll
        for (unsigned j = 0; j < 16; ++j) { const unsigned c = xb_ld(&bar[XB_XCNT(j)]); sum += c; cnt += (c > 0u) ? 1u : 0u; mine = (j == x) ? c : mine; }
        if (sum == G) break;
        __builtin_amdgcn_s_sleep(1);
        if ((++sp & 255u) == 0u) { if (xb_ld(&bar[XB_TMO])) break; if (sp > XB_SPIN_CAP) { atomicAdd(&bar[XB_TMO], 1u); break; } }
    }
    nloc = mine > 0u ? mine : 1u; nx = cnt > 0u ? cnt : 1u;
}

__device__ __forceinline__ void xcd_barrier(const XcdBarrier& b) {
    asm volatile("s_waitcnt vmcnt(0)" ::: "memory");
    __syncthreads();
    if (threadIdx.x == 0) {
        unsigned* bar = b.bar;
        __builtin_amdgcn_s_waitcnt(0);
        unsigned nloc = b.st[0], nx = b.st[1];
        if (nloc == 0u) { xcd_barrier_complete(bar, b.x, nloc, nx); b.st[0] = nloc; b.st[1] = nx; }
        const unsigned old = xb_add(&bar[XB_XSUB(b.x)], 1u);
        const unsigned gen = old / nloc;
        if (old + 1u == (gen + 1u) * nloc) {
            __builtin_amdgcn_fence(__ATOMIC_RELEASE, "agent");
            asm volatile("s_waitcnt vmcnt(0)" ::: "memory");
            const unsigned og = xb_add(&bar[XB_TOP], 1u);
            const unsigned tg = og / nx;
            if (og + 1u == (tg + 1u) * nx) xb_add(&bar[XB_TOPGEN], 1u);
            else XB_SPIN(xb_ld(&bar[XB_TOPGEN]) == tg, bar);
            __builtin_amdgcn_fence(__ATOMIC_ACQUIRE, "agent");
            xb_add(&bar[XB_XGEN(b.x)], 1u);
            asm volatile("s_waitcnt vmcnt(0)" ::: "memory");
        } else {
            XB_SPIN(xb_ld(&bar[XB_XGEN(b.x)]) == gen, bar);
            __builtin_amdgcn_fence(__ATOMIC_ACQUIRE, "agent");
            asm volatile("s_waitcnt vmcnt(0)" ::: "memory");
        }
    }
    __syncthreads();
}
constexpr int NWAVES = 8, NTHR = 512;
constexpr int BATCH = 2, SEQ = 8192, DM = 1024, M = BATCH * SEQ, DEPTH = 4;
constexpr int W_AB = 3672, W_CD = 3080, FFD = 2816, FFE = 3584, NEXP = 8;
constexpr int NAB = 3840, NCD = 3072;
constexpr float ALPHA = 1.6817928305074290f, LN_EPS = 1e-5f;
constexpr int MOE_ROWS = 34816;
constexpr size_t MiB = 1u << 20;
constexpr size_t WS_CTL = 0, CTL_ZERO_BYTES = 128 * 1024;
constexpr size_t WS_X = 1 * MiB, WS_XB = 65 * MiB, WS_MIX = 97 * MiB, WS_Y = 129 * MiB, WS_ACT = 161 * MiB;
constexpr size_t WS_EVW = 289 * MiB, EV_WAB = 0, EV_WO = 8 * MiB, EV_W13 = 10 * MiB, EV_W2 = 21 * MiB;
constexpr size_t WS_MASK = 317 * MiB;
constexpr size_t WS_MISC = 349 * MiB, MI_FL = 0, MI_RTE = 1 * MiB, MI_RTR1 = MI_RTE + 65536, MI_RTR2 = MI_RTR1 + 65536, MI_RTG = MI_RTR2 + 65536, MI_ROW1 = MI_RTG + 131072, MI_ROW2 = MI_ROW1 + 65536, MI_SLC = MI_ROW2 + 65536  ;
constexpr size_t WS_BIG = 353 * MiB;
constexpr size_t BG_WCD = 0, BG_WOD = 6 * MiB, BG_W13M = 8 * MiB, BG_W2M = 120 * MiB, BG_H = 176 * MiB, BG_XG = 414 * MiB, BG_END = 482 * MiB;
constexpr size_t BG_SC = 176 * MiB;
constexpr size_t BG_DS = BG_END, BG_DEC = BG_END + 32 * MiB, BG_QS = 434 * MiB, BG_SP = 442 * MiB;
constexpr size_t WS_END = WS_BIG + BG_END + 33 * MiB;
constexpr size_t SCB = (size_t)4096 * 128 * 129 / 2;
static_assert(BG_SC + 2 * SCB * 4 <= BG_END, "scores fit");
constexpr int CW_TMO = 0, CW_BAR = 4096, CW_Q = 8192, CW_CNT = 12288;
constexpr int RING_BYTES = 131072;
constexpr int LDSCTL_OFF = RING_BYTES, MISC_OFF = LDSCTL_OFF + 320;
constexpr int LDS_BYTES = 147456;
struct Frame {
    LAS unsigned char* lds;
    volatile LAS unsigned* MISC;
    gu32* ctl;
    unsigned char* ws;
    int tid, lane, wave;
    int vcu, G, qk;
};
__device__ __forceinline__ int sel8i(int e, int a0, int a1, int a2, int a3, int a4, int a5, int a6, int a7) {
    int r = a0; r = e == 1 ? a1 : r; r = e == 2 ? a2 : r; r = e == 3 ? a3 : r; r = e == 4 ? a4 : r; r = e == 5 ? a5 : r; r = e == 6 ? a6 : r; r = e == 7 ? a7 : r; return r; }
__device__ __forceinline__ float sel8f(int e, const float (&a)[8]) {
    float r = a[0]; r = e == 1 ? a[1] : r; r = e == 2 ? a[2] : r; r = e == 3 ? a[3] : r; r = e == 4 ? a[4] : r; r = e == 5 ? a[5] : r; r = e == 6 ? a[6] : r; r = e == 7 ? a[7] : r; return r; }
__device__ __forceinline__ int q_issue(Frame& F, gu32* head) { unsigned v = 0u; if (F.tid == 0) v = __hip_atomic_fetch_add(head, 1u, RLX_AGENT); return (int)v; }
__device__ __forceinline__ int q_share(Frame& F, int v) {
    volatile LAS int* slot = (volatile LAS int*)(F.lds + LDSCTL_OFF + 64) + (F.qk & 1); F.qk += 1;
    if (F.tid == 0) *slot = v;
    WG_BAR();
    return *slot;
}
__device__ __forceinline__ void conv_item(const float* __restrict__ W, int ldw, int k0, int sc4, bf16* WT, int ldt, int drow0, LAS unsigned* P, int lane) {
    const int n4 = (lane & 15) * 4, kq = lane >> 4;
    f32x4 a[8], b[8];
    if (sc4 >= 0) {
#pragma unroll
        for (int i = 0; i < 8; ++i) { const float* p = W + (size_t)(k0 + 8 * i + 2 * kq) * ldw + sc4; a[i] = *(const GAS f32x4*)p; b[i] = *(const GAS f32x4*)(p + ldw); }
    } else {
#pragma unroll
        for (int i = 0; i < 8; ++i) { a[i] = (f32x4){0.f, 0.f, 0.f, 0.f}; b[i] = a[i]; }
    }
#pragma unroll
    for (int i = 0; i < 8; ++i) { v4u w; w.x = pk2(a[i].x, b[i].x); w.y = pk2(a[i].y, b[i].y); w.z = pk2(a[i].z, b[i].z); w.w = pk2(a[i].w, b[i].w);
        *(LAS v4u*)(P + (4 * i + kq) * 68 + n4) = w; }
    LDS_WAIT();
#pragma unroll
    for (int j = 0; j < 8; ++j) { const int ch = j * 64 + lane, n = ch >> 3, c = ch & 7; const LAS unsigned* s = P + (4 * c) * 68 + n;
        v4u o; o.x = s[0]; o.y = s[68]; o.z = s[136]; o.w = s[204];
        *(GAS v4u*)(WT + (size_t)(drow0 + n) * ldt + k0 + 8 * c) = o; }
    LDS_WAIT();
}
__device__ __forceinline__ void conv_matrix(Frame& F, int kind, const float* W, const float* W3, int ldw, int K, bf16* WT, int nrows) {
    LAS unsigned* scr = (LAS unsigned*)(F.lds + F.wave * 8704);
    const int gw = F.vcu * NWAVES + F.wave, NGW = F.G * NWAVES;
    const int ngrp = nrows / 64, nkb = K / 64, nitems = ngrp * nkb;
    for (int it = gw; it < nitems; it += NGW) {
        const int grp = it % ngrp, kb = it / ngrp; const int r = grp * 64 + (F.lane & 15) * 4;
        int sc = r; const float* src = W;
        if (kind == 1) { sc = r < 1536 ? r : (r < 3584 ? r + 16 : (r < 3600 ? 1536 + (r - 3584) : (r < 3672 ? r : -1))); }
        else if (kind == 2) { sc = r < 1536 ? r : r + 8; }
        else if (kind == 3) { const int j = r >> 8, w = r & 255; sc = 128 * j + (w & 127); src = (w < 128) ? W : W3; }
        conv_item(src, ldw, kb * 64, sc, WT, K, grp * 64, scr, F.lane);
    }
}
__device__ __forceinline__ void conv_odd_item(Frame& F, int lane_, int idx, const float* w1m, const float* w3m, const float* w2m, const float* wcd, const float* wod, unsigned char* big) {
    LAS unsigned* scr = (LAS unsigned*)(F.lds + F.wave * 8704);
    const int l4 = (lane_ & 15) * 4;
    if (idx < 14336) { const int e = idx / 1792, it = idx % 1792, grp = it % 112, kb = it / 112; const int r = grp * 64 + l4; const int jj = r >> 8, w = r & 255;
        const size_t eo = (size_t)e * DM * FFE;
        conv_item((w < 128 ? w1m : w3m) + eo, FFE, kb * 64, 128 * jj + (w & 127), (bf16*)(big + BG_W13M) + (size_t)e * 2 * FFE * DM, DM, grp * 64, scr, lane_); }
    else if (idx < 21504) { const int i2 = idx - 14336, e = i2 / 896, it = i2 % 896, grp = it % 16, kb = it / 16;
        conv_item(w2m + (size_t)e * DM * FFE, DM, kb * 64, grp * 64 + l4, (bf16*)(big + BG_W2M) + (size_t)e * DM * FFE, FFE, grp * 64, scr, lane_); }
    else if (idx < 22272) { const int it = idx - 21504, grp = it % 48, kb = it / 48; const int r = grp * 64 + l4;
        conv_item(wcd, W_CD, kb * 64, r < 1536 ? r : r + 8, (bf16*)(big + BG_WCD), DM, grp * 64, scr, lane_); }
    else { const int it = idx - 22272, grp = it % 16, kb = it / 16;
        conv_item(wod, DM, kb * 64, grp * 64 + l4, (bf16*)(big + BG_WOD), DM, grp * 64, scr, lane_); }
}
__device__ __forceinline__ void conv_even_item(Frame& F, int lane_, int idx, const float* wab, const float* wo, const float* w1, const float* w3, const float* w2, unsigned char* evw) {
    LAS unsigned* scr = (LAS unsigned*)(F.lds + F.wave * 8704);
    const int l4 = (lane_ & 15) * 4;
    if (idx < 960) { const int grp = idx % 60, kb = idx / 60; const int r = grp * 64 + l4;
        const int sc = r < 1536 ? r : (r < 3584 ? r + 16 : (r < 3600 ? 1536 + (r - 3584) : (r < 3672 ? r : -1)));
        conv_item(wab, W_AB, kb * 64, sc, (bf16*)(evw + EV_WAB), DM, grp * 64, scr, lane_); }
    else if (idx < 1216) { const int it = idx - 960, grp = it % 16, kb = it / 16;
        conv_item(wo, DM, kb * 64, grp * 64 + l4, (bf16*)(evw + EV_WO), DM, grp * 64, scr, lane_); }
    else if (idx < 2624) { const int it = idx - 1216, grp = it % 88, kb = it / 88; const int r = grp * 64 + l4; const int jj = r >> 8, w = r & 255;
        conv_item(w < 128 ? w1 : w3, FFD, kb * 64, 128 * jj + (w & 127), (bf16*)(evw + EV_W13), DM, grp * 64, scr, lane_); }
    else if (idx < 3328) { const int it = idx - 2624, grp = it % 16, kb = it / 16;
        conv_item(w2, DM, kb * 64, grp * 64 + l4, (bf16*)(evw + EV_W2), FFD, grp * 64, scr, lane_); }
}
__device__ __forceinline__ void rows_to_bf16(Frame& F, const float* x, bf16* xb) {
    const int gw = F.vcu * NWAVES + F.wave, NGW = F.G * NWAVES;
    for (int m = gw; m < M; m += NGW) {
        const GAS f32x4* xr = (const GAS f32x4*)(x + (size_t)m * DM) + F.lane; GAS v2u* o = (GAS v2u*)(xb + (size_t)m * DM) + F.lane;
#pragma unroll
        for (int j = 0; j < 4; ++j) { const f32x4 v = xr[64 * j]; v2u w; w.x = pk2(v.x, v.y); w.y = pk2(v.z, v.w); o[64 * j] = w; }
    }
}
__device__ __forceinline__ void ln_phase(Frame& F, const float* xres, const bf16* xres16, const bf16* Y, int ymode, const float* g, const float* bvec, float* xout, bf16* xbout,
                                         int proj, const float* pw, const float* pb, gu32* cnt, const float* ypart = nullptr) {
    LAS float* W8 = (LAS float*)(F.lds);
    volatile LAS int* tokE = (volatile LAS int*)(F.lds + 32768);
    const int* row1 = (const int*)(F.ws + WS_MISC + MI_ROW1); const int* row2 = (const int*)(F.ws + WS_MISC + MI_ROW2);
    float* rtg = (float*)(F.ws + WS_MISC + MI_RTG); int* rte = (int*)(F.ws + WS_MISC + MI_RTE); int* rtr1 = (int*)(F.ws + WS_MISC + MI_RTR1); int* rtr2 = (int*)(F.ws + WS_MISC + MI_RTR2);
    float* fl = (float*)(F.ws + WS_MISC + MI_FL);
    if (proj != 0) { for (int q = F.tid; q < 2048; q += NTHR) ((LAS f32x4*)W8)[q] = ((const GAS f32x4*)pw)[q]; }
    WG_BAR();
    const int lane = F.lane;
    for (int slab = blockIdx.x; slab < M / 64; slab += F.G) {
        const int mw = slab * 64 + F.wave * 8;
        int r1v = 0, r2v = 0; float g1v = 0.f, g2v = 0.f;
        if (ymode != 0) { const int mm = mw + (lane & 7); r1v = row1[mm]; r2v = row2[mm]; g1v = rtg[2 * mm]; g2v = rtg[2 * mm + 1]; }
        f32x4 xn[4]; v2u an[4], cn[4];
#define LN_YROW(yp_, r_, j_) ({ v2u o_; if ((r_) < 32768 || ypart == nullptr) o_ = (yp_)[64 * (j_)]; else { const GAS f32x4* p0_ = (const GAS f32x4*)(ypart + ((size_t)(((r_) - 32768) >> 8) * 2 * 256 + (((r_) - 32768) & 255)) * 1024) + lane + 64 * (j_); \
            const f32x4 s_ = p0_[0] + p0_[256 * 1024 / 4]; o_ = (v2u){pk2(s_.x, s_.y), pk2(s_.z, s_.w)}; } o_; })
#define LN_LOADX(j_) do { if (xres16 != nullptr) { const v2u q_ = ((const GAS v2u*)(xres16 + (size_t)m_ * DM) + lane)[64 * (j_)]; xn[j_] = (f32x4){bflo(q_.x), bfhi(q_.x), bflo(q_.y), bfhi(q_.y)}; } \
                              else xn[j_] = ((const GAS f32x4*)(xres + (size_t)m_ * DM) + lane)[64 * (j_)]; } while (0)
#define LN_LOAD(rr_) do { const int m_ = mw + (rr_); \
            if (ymode == 0) { const GAS v2u* yr_ = (const GAS v2u*)(Y + (size_t)m_ * DM) + lane; \
                _Pragma("unroll") for (int j = 0; j < 4; ++j) { LN_LOADX(j); an[j] = yr_[64 * j]; cn[j] = (v2u){0u, 0u}; } } \
            else { const int r1_ = __shfl(r1v, (rr_)), r2_ = __shfl(r2v, (rr_)); const GAS v2u* y1_ = (const GAS v2u*)(Y + (size_t)r1_ * DM) + lane; const GAS v2u* y2_ = (const GAS v2u*)(Y + (size_t)r2_ * DM) + lane; \
                _Pragma("unroll") for (int j = 0; j < 4; ++j) { LN_LOADX(j); an[j] = LN_YROW(y1_, r1_, j); cn[j] = LN_YROW(y2_, r2_, j); } } } while (0)
        LN_LOAD(0);
        for (int rr = 0; rr < 8; ++rr) {
            const int m = mw + rr;
            f32x4 xc[4]; v2u ac[4], cc[4];
#pragma unroll
            for (int j = 0; j < 4; ++j) { xc[j] = xn[j]; ac[j] = an[j]; cc[j] = cn[j]; }
            if (rr + 1 < 8) LN_LOAD(rr + 1);
            f32x4 v[4];
            if (ymode == 0) {
#pragma unroll
                for (int j = 0; j < 4; ++j) { const f32x4 xv = xc[j]; const v2u yw = ac[j];
                    v[j].x = ALPHA * xv.x + bflo(yw.x); v[j].y = ALPHA * xv.y + bfhi(yw.x); v[j].z = ALPHA * xv.z + bflo(yw.y); v[j].w = ALPHA * xv.w + bfhi(yw.y); }
            } else {
                const float g1 = __shfl(g1v, rr), g2 = __shfl(g2v, rr);
#pragma unroll
                for (int j = 0; j < 4; ++j) { const f32x4 xv = xc[j]; const v2u a = ac[j], c = cc[j];
                    v[j].x = ALPHA * xv.x + (g1 * bflo(a.x) + g2 * bflo(c.x)); v[j].y = ALPHA * xv.y + (g1 * bfhi(a.x) + g2 * bfhi(c.x));
                    v[j].z = ALPHA * xv.z + (g1 * bflo(a.y) + g2 * bflo(c.y)); v[j].w = ALPHA * xv.w + (g1 * bfhi(a.y) + g2 * bfhi(c.y)); }
            }
            float s = 0.f;
#pragma unroll
            for (int j = 0; j < 4; ++j) s += (v[j].x + v[j].y) + (v[j].z + v[j].w);
            const float mean = wave_sum(s) * (1.f / DM); float s2 = 0.f;
#pragma unroll
            for (int j = 0; j < 4; ++j) { v[j] = v[j] - mean; s2 += (v[j].x * v[j].x + v[j].y * v[j].y) + (v[j].z * v[j].z + v[j].w * v[j].w); }
            const float rstd = 1.f / sqrtf(wave_sum(s2) * (1.f / DM) + LN_EPS);
            GAS f32x4* xo = (GAS f32x4*)(xout + (size_t)m * DM) + lane; GAS v2u* bo = (GAS v2u*)(xbout + (size_t)m * DM) + lane;
#pragma unroll
            for (int j = 0; j < 4; ++j) { const f32x4 gg = ((const GAS f32x4*)g)[lane + 64 * j], bb = ((const GAS f32x4*)bvec)[lane + 64 * j];
                v[j] = v[j] * rstd * gg + bb; if (xout != nullptr) xo[64 * j] = v[j]; v2u w; w.x = pk2(v[j].x, v[j].y); w.y = pk2(v[j].z, v[j].w); bo[64 * j] = w; }
            if (proj != 0) {
                float a8[8];
#pragma unroll
                for (int e = 0; e < 8; ++e) a8[e] = 0.f;
#pragma unroll
                for (int j = 0; j < 4; ++j)
#pragma unroll
                    for (int c = 0; c < 4; ++c) { const int slot = (4 * j + c) * 64 + lane; const f32x4 w0 = *(const LAS f32x4*)(W8 + slot * 4), w1 = *(const LAS f32x4*)(W8 + 4096 + slot * 4); const float xv = v[j][c];
                        a8[0] += xv * w0.x; a8[1] += xv * w0.y; a8[2] += xv * w0.z; a8[3] += xv * w0.w; a8[4] += xv * w1.x; a8[5] += xv * w1.y; a8[6] += xv * w1.z; a8[7] += xv * w1.w; }
#pragma unroll
                for (int e = 0; e < 8; ++e) a8[e] = wave_sum(a8[e]);
                if (proj == 2) {
                    const int e8 = lane & 7; float z = a8[0]; z = e8 == 1 ? a8[1] : z; z = e8 == 2 ? a8[2] : z; z = e8 == 3 ? a8[3] : z; z = e8 == 4 ? a8[4] : z; z = e8 == 5 ? a8[5] : z; z = e8 == 6 ? a8[6] : z; z = e8 == 7 ? a8[7] : z; z += pb[e8];
                    if (lane < 8) fl[(size_t)m * 8 + lane] = log_sigmoid(z);
                } else {
                    int e1 = 0; float v1 = a8[0];
#pragma unroll
                    for (int e = 1; e < 8; ++e) if (a8[e] > v1) { v1 = a8[e]; e1 = e; }
                    int e2 = -1; float v2 = -INFINITY;
#pragma unroll
                    for (int e = 0; e < 8; ++e) if (e != e1 && (e2 < 0 || a8[e] > v2)) { v2 = a8[e]; e2 = e; }
                    const float ex = __expf(v2 - v1); const float g1 = 1.f / (1.f + ex), g2 = ex / (1.f + ex);
                    if (lane == 0) { rtg[2 * m] = g1; rtg[2 * m + 1] = g2; tokE[F.wave * 8 + rr] = e1 | (e2 << 8); }
                }
            }
        }
        if (proj == 1) {
            LDS_BAR();
            if (F.wave == 0) {
                const int ee = tokE[lane]; const int e1 = ee & 255, e2 = ee >> 8; int r1 = 0, r2 = 0;
                const unsigned long long lt = (1ull << lane) - 1ull;
                int mycnt = 0, p1 = 0, p2 = 0;
#pragma unroll
                for (int e = 0; e < 8; ++e) {
                    const unsigned long long b1 = __ballot(e1 == e), b2 = __ballot(e2 == e);
                    const int c = __popcll(b1) + __popcll(b2), pos = __popcll(b1 & lt) + __popcll(b2 & lt);
                    mycnt = (lane == e) ? c : mycnt; p1 = (e1 == e) ? pos : p1; p2 = (e2 == e) ? pos : p2;
                }
                if (lane < 8) ((int*)(F.ws + WS_MISC + MI_SLC))[slab * 8 + lane] = mycnt;
                r1 = p1; r2 = p2;
                const int m = slab * 64 + lane; rte[m] = ee; rtr1[m] = r1; rtr2[m] = r2;
            }
            LDS_BAR();
        }
    }
}
#undef LN_LOAD
#undef LN_LOADX
#undef LN_YROW
__device__ __forceinline__ void w8_image(Frame& F, const float* w, int ld, int col0, float* img, int slice) {
    if (F.tid < 128) { const int i8 = slice * 128 + F.tid; const int i = i8 >> 3, e = i8 & 7; const int slot = (4 * (i >> 8) + (i & 3)) * 64 + ((i & 255) >> 2);
        img[(e >> 2) * 4096 + slot * 4 + (e & 3)] = w[(size_t)i * ld + col0 + e]; }
}
__device__ __forceinline__ void moe_tiles(const gu32* cnt, int (&ts)[9]) {
    ts[0] = 0;
#pragma unroll
    for (int e = 0; e < 8; ++e) { const int c = (int)__hip_atomic_load(cnt + 64 * e, RLX_AGENT); ts[e + 1] = ts[e] + ((c + 255) >> 8); }
}
__device__ __forceinline__ void scatter_phase(Frame& F, const bf16* xb, bf16* xg, gu32* cnt) {
    LAS int* base = (LAS int*)(F.lds); LAS int* wtot = (LAS int*)(F.lds + 8192);
    const int* slc = (const int*)(F.ws + WS_MISC + MI_SLC);
    { const int e = F.tid & 7, sg = F.tid >> 3;
      int c0 = slc[(4 * sg + 0) * 8 + e], c1 = slc[(4 * sg + 1) * 8 + e], c2 = slc[(4 * sg + 2) * 8 + e], c3 = slc[(4 * sg + 3) * 8 + e];
      int incl = c0 + c1 + c2 + c3; const int own = incl;
#pragma unroll
      for (int o = 8; o < 64; o <<= 1) { const int t = __shfl_up(incl, o); if (F.lane >= o) incl += t; }
      if (F.lane >= 56) wtot[F.wave * 8 + e] = incl;
      LDS_BAR();
      int pre = incl - own;
#pragma unroll
      for (int w = 0; w < 8; ++w) if (w < F.wave) pre += wtot[w * 8 + e];
      base[(4 * sg + 0) * 8 + e] = pre; base[(4 * sg + 1) * 8 + e] = pre + c0; base[(4 * sg + 2) * 8 + e] = pre + c0 + c1; base[(4 * sg + 3) * 8 + e] = pre + c0 + c1 + c2;
      LDS_BAR(); }
    int ts[9]; ts[0] = 0;
#pragma unroll
    for (int e = 0; e < 8; ++e) { int tot = 0;
#pragma unroll
        for (int w = 0; w < 8; ++w) tot += wtot[w * 8 + e];
        ts[e + 1] = ts[e] + ((tot + 255) >> 8);
        if (blockIdx.x == 0 && F.tid == 0) __hip_atomic_store(cnt + 64 * e, (unsigned)tot, RLX_AGENT); }
    const int* rte = (const int*)(F.ws + WS_MISC + MI_RTE); const int* rtr1 = (const int*)(F.ws + WS_MISC + MI_RTR1); const int* rtr2 = (const int*)(F.ws + WS_MISC + MI_RTR2);
    int* row1 = (int*)(F.ws + WS_MISC + MI_ROW1); int* row2 = (int*)(F.ws + WS_MISC + MI_ROW2);
    const int gw = F.vcu * NWAVES + F.wave, NGW = F.G * NWAVES;
    for (int m = gw; m < M; m += NGW) {
        const int ee = rte[m]; const int e1 = ee & 255, e2 = ee >> 8; const int slab = m >> 6;
        const int ra = 256 * sel8i(e1, ts[0], ts[1], ts[2], ts[3], ts[4], ts[5], ts[6], ts[7]) + base[slab * 8 + e1] + rtr1[m];
        const int rb = 256 * sel8i(e2, ts[0], ts[1], ts[2], ts[3], ts[4], ts[5], ts[6], ts[7]) + base[slab * 8 + e2] + rtr2[m];
        const GAS v4u* src = (const GAS v4u*)(xb + (size_t)m * DM) + F.lane;
        const v4u a = src[0], b = src[64];
        GAS v4u* d1 = (GAS v4u*)(xg + (size_t)ra * DM) + F.lane; GAS v4u* d2 = (GAS v4u*)(xg + (size_t)rb * DM) + F.lane;
        d1[0] = a; d1[64] = b; d2[0] = a; d2[64] = b;
        if (F.lane == 0) { row1[m] = ra; row2[m] = rb; }
    }
}
namespace att {
constexpr int SLOTB = 8192, NSLOT = 3;
constexpr int L_K = 0, L_V = NSLOT * SLOTB, L_WS = 2 * NSLOT * SLOTB, L_OST = L_WS + 8 * 256, L_END = L_OST + 8 * 4096;
constexpr int L_WMIN = L_END;
constexpr int L_TAB = L_END + 64;
constexpr int PITCH = 512;
constexpr int PSTRIDE = 8 * 72;
__device__ __forceinline__ int crow(int r, int hi) { return (r & 3) + 8 * (r >> 2) + 4 * hi; }
__device__ __forceinline__ void glds16(const void* gsrc, unsigned lds_dst) { unsigned keep;
    asm volatile("s_mov_b32 %0, m0\n\ts_mov_b32 m0, %2\n\ts_nop 0\n\tglobal_load_lds_dwordx4 %1, off\n\ts_mov_b32 m0, %0" : "=&s"(keep) : "v"(gsrc), "s"(lds_dst) : "memory"); }
__device__ __forceinline__ float max3f(float a, float b, float c) { return __builtin_fmaxf(__builtin_fmaxf(a, b), c); }
typedef __bf16 bf16x2_t __attribute__((ext_vector_type(2)));
__device__ __forceinline__ unsigned cvtpk_s(float lo, float hi) { f32x2 v = {lo, hi}; bf16x2_t b = __builtin_convertvector(v, bf16x2_t); return __builtin_bit_cast(unsigned, b); }
#define ATT_WAIT_BAR(N) asm volatile("s_waitcnt vmcnt(" #N ") lgkmcnt(0)\n\ts_barrier" ::: "memory")
__device__ __forceinline__ void qkt(f32x16& p0, f32x16& p1, const LAS unsigned char* Kslot, const bf16x8* qr, int r32, int hi) {
    const LAS unsigned char* kb = Kslot + hi * 1024 + r32 * 16;
    const f32x16 z = {};
    bf16x8 kf[8];
#pragma unroll
    for (int d0 = 0; d0 < 4; ++d0) { kf[2 * d0] = *(const LAS bf16x8*)(kb + d0 * 2048); kf[2 * d0 + 1] = *(const LAS bf16x8*)(kb + d0 * 2048 + 512); }
    __builtin_amdgcn_sched_barrier(0);
    p0 = __builtin_amdgcn_mfma_f32_32x32x16_bf16(kf[0], qr[0], z, 0, 0, 0); p1 = __builtin_amdgcn_mfma_f32_32x32x16_bf16(kf[1], qr[0], z, 0, 0, 0);
#pragma unroll
    for (int d0 = 1; d0 < 4; ++d0) { p0 = __builtin_amdgcn_mfma_f32_32x32x16_bf16(kf[2 * d0], qr[d0], p0, 0, 0, 0); p1 = __builtin_amdgcn_mfma_f32_32x32x16_bf16(kf[2 * d0 + 1], qr[d0], p1, 0, 0, 0); }
}
__device__ __forceinline__ float rowmax(const f32x16& p0, const f32x16& p1) {
    float a = max3f(p0[0], p0[1], p1[0]), b = max3f(p0[2], p0[3], p1[1]); a = max3f(a, p1[2], p1[3]);
#pragma unroll
    for (int r = 4; r < 16; r += 4) { a = max3f(a, p0[r], p0[r + 1]); b = max3f(b, p0[r + 2], p0[r + 3]); a = max3f(a, p1[r], p1[r + 1]); b = max3f(b, p1[r + 2], p1[r + 3]); }
    const float m = __builtin_fmaxf(a, b);
    auto rr = __builtin_amdgcn_permlane32_swap(__float_as_uint(m), __float_as_uint(m), false, false);
    return __builtin_fmaxf(__uint_as_float(rr[0]), __uint_as_float(rr[1]));
}
__device__ __forceinline__ void pv(f32x16* o, int vb, bf16x8 pa0, bf16x8 pa1, bf16x8 pa2, bf16x8 pa3) {
#pragma unroll
    for (int d0 = 0; d0 < 2; ++d0) { s16x4 lo[4], hi[4];
#pragma unroll
        for (int ks = 0; ks < 4; ++ks) {
            asm volatile("ds_read_b64_tr_b16 %0,%1 offset:%c2" : "=&v"(lo[ks]) : "v"(vb), "i"(d0 * 4096 + ks * 1024) : "memory");
            asm volatile("ds_read_b64_tr_b16 %0,%1 offset:%c2" : "=&v"(hi[ks]) : "v"(vb), "i"(d0 * 4096 + ks * 1024 + 512) : "memory"); }
        asm volatile("s_waitcnt lgkmcnt(0)" ::: "memory"); __builtin_amdgcn_sched_barrier(0);
#define ATT_PK(k) (bf16x8){lo[k][0], lo[k][1], lo[k][2], lo[k][3], hi[k][0], hi[k][1], hi[k][2], hi[k][3]}
        o[d0] = __builtin_amdgcn_mfma_f32_32x32x16_bf16(pa0, ATT_PK(0), o[d0], 0, 0, 0);
        o[d0] = __builtin_amdgcn_mfma_f32_32x32x16_bf16(pa1, ATT_PK(1), o[d0], 0, 0, 0);
        o[d0] = __builtin_amdgcn_mfma_f32_32x32x16_bf16(pa2, ATT_PK(2), o[d0], 0, 0, 0);
        o[d0] = __builtin_amdgcn_mfma_f32_32x32x16_bf16(pa3, ATT_PK(3), o[d0], 0, 0, 0);
#undef ATT_PK
    }
}
typedef __attribute__((address_space(3))) const char* lds_cptr;
typedef short v4i16_t __attribute__((ext_vector_type(4)));
__device__ __forceinline__ void kload2(bf16x8* kf, lds_cptr kp, int j) { kf[2 * j] = *(const LAS bf16x8*)(kp + j * 2048); kf[2 * j + 1] = *(const LAS bf16x8*)(kp + j * 2048 + 512); }
__device__ __forceinline__ s16x4 vtr(lds_cptr p) { return __builtin_bit_cast(s16x4, __builtin_amdgcn_ds_read_tr16_b64_v4i16((LAS v4i16_t*)p)); }
#define SBAR() __builtin_amdgcn_sched_barrier(0)
#define PIN(x) asm volatile("" : "+v"(x))
#define MFMA(a, b, c) __builtin_amdgcn_mfma_f32_32x32x16_bf16(a, b, c, 0, 0, 0)
template <class Hook>
__device__ __forceinline__ void attn_unit(Hook& hk, const bf16* Qh, const bf16* Kh, const bf16* Vh, bf16* Oh, long qrow0, int NT, LAS unsigned char* shm, int opitch) {
    int tid_ = threadIdx.x; asm volatile("" : "+v"(tid_)); const int tid = tid_, lane = tid & 63, r32 = lane & 31, hi = lane >> 5; const int wid = __builtin_amdgcn_readfirstlane(tid >> 6);
    const unsigned lds0 = (unsigned)(size_t)shm;
    LAS float* wsf = (LAS float*)(shm + L_WS) + wid * 64;
    constexpr long RSP = (long)Hook::RS * PITCH;
    const bf16* Qw = Qh + qrow0 * PITCH + (long)(wid * 32) * RSP;
    const bf16* ksrc = Kh + (long)lane * RSP + wid * 8;
    const bf16* vsrc = Vh + (long)(16 * (wid & 3) + (lane >> 2)) * RSP + (wid >> 2) * 32 + (lane & 3) * 8;
    const unsigned kdst = lds0 + L_K + wid * 1024, vdst = lds0 + L_V + wid * 1024;
#define DMA_K(t, slot) glds16(ksrc + hk.tile_row(t) * PITCH, (unsigned)__builtin_amdgcn_readfirstlane(kdst + (slot)))
#define DMA_V(t, slot) glds16(vsrc + hk.tile_row(t) * PITCH, (unsigned)__builtin_amdgcn_readfirstlane(vdst + (slot)))
    const lds_cptr vp0 = (lds_cptr)shm + L_V + ((lane >> 4) & 1) * 32 + (lane & 3) * 8 + (4 * hi + ((lane & 15) >> 2)) * 64;
    const lds_cptr kp0 = (lds_cptr)shm + L_K + hi * 1024 + r32 * 16;
    DMA_K(0, 0); DMA_V(0, 0); DMA_K(1, SLOTB);
    bf16x8 qr[4];
#pragma unroll
    for (int d0 = 0; d0 < 4; ++d0) qr[d0] = *(const bf16x8*)(Qw + (long)r32 * RSP + d0 * 16 + hi * 8);
    float mhat = 0.f, l_reg = 0.f; f32x16 o[2]; o[0] = f32x16{}; o[1] = f32x16{};
    f32x16 negm = f32x16{};
    if constexpr (Hook::PART_IN) {
        const float* pp = hk.part + (size_t)(wid * 32) * Hook::RS * PSTRIDE;
        mhat = pp[(size_t)r32 * Hook::RS * PSTRIDE]; l_reg = hi == 0 ? pp[(size_t)r32 * Hook::RS * PSTRIDE + 1] : 0.f;
#pragma unroll
        for (int r = 0; r < 16; ++r) { const float* pr = pp + (size_t)crow(r, hi) * Hook::RS * PSTRIDE + 8 + r32; o[0][r] = pr[0]; o[1][r] = pr[32]; negm[r] = -mhat; }
    }
    PIN(negm);
    bool resc = false;
    f32x16 pA0, pA1, pB0, pB1; bf16x8 kf[8]; s16x4 vlo[8], vhi[8]; v4u pw0, pw1, pw2, pw3;
    int sl_prev = 0, sl_cur = 0, sl_next = SLOTB;
#define ROT() do { sl_prev = sl_cur; sl_cur = sl_next; sl_next = (sl_next == 2 * SLOTB) ? 0 : sl_next + SLOTB; } while (0)
#define EX(v) __builtin_amdgcn_exp2f(v)
#define RESC() do { if (resc) { _Pragma("unroll") for (int d_ = 0; d_ < 2; ++d_) _Pragma("unroll") for (int r = 0; r < 16; ++r) o[d_][r] *= wsf[crow(r, hi)]; } } while (0)
    DMA_K(2, 2 * SLOTB);
    hk.prefetch(0, wid);
    ATT_WAIT_BAR(3);
    _Pragma("unroll") for (int d0 = 0; d0 < 4; ++d0) kload2(kf, kp0, d0);
    pA0 = MFMA(kf[0], qr[0], negm); pA1 = MFMA(kf[1], qr[0], negm); pA0 = MFMA(kf[2], qr[1], pA0); pA1 = MFMA(kf[3], qr[1], pA1);
    pA0 = MFMA(kf[4], qr[2], pA0); pA1 = MFMA(kf[5], qr[2], pA1); pA0 = MFMA(kf[6], qr[3], pA0); pA1 = MFMA(kf[7], qr[3], pA1);
    hk.apply(pA0, pA1, 0, r32, hi, wid);
    if constexpr (Hook::PART_IN) {
        const float rm = rowmax(pA0, pA1); const float dl = __builtin_fmaxf(rm, 0.f); mhat += dl; const float f = __builtin_amdgcn_exp2f(-dl); l_reg *= f;
        if (hi == 0) wsf[r32] = f;
        LDS_WAIT();
#pragma unroll
        for (int r = 0; r < 16; ++r) { const float fr_ = wsf[crow(r, hi)]; o[0][r] *= fr_; o[1][r] *= fr_; pA0[r] = EX(pA0[r] - dl); pA1[r] = EX(pA1[r] - dl); negm[r] = -mhat; }
        PIN(negm);
    } else { const float rm = rowmax(pA0, pA1); mhat = __builtin_fmaxf(rm, -1000.0f);
#pragma unroll
      for (int r = 0; r < 16; ++r) { pA0[r] = EX(pA0[r] - mhat); pA1[r] = EX(pA1[r] - mhat); negm[r] = -mhat; }
      PIN(negm); }
    hk.prefetch(1, wid);
    ATT_WAIT_BAR(0);
    DMA_K(3, 0); DMA_V(1, SLOTB); ROT();
    _Pragma("unroll") for (int d0 = 0; d0 < 4; ++d0) kload2(kf, kp0 + sl_cur, d0);
    ATT_WAIT_BAR(2);
#define PKW(P, i) cvtpk_s(P[i], P[i + 1])
#define PAF(k) __builtin_bit_cast(bf16x8, pw##k)
#define VFR(i) (bf16x8){vlo[i][0], vlo[i][1], vlo[i][2], vlo[i][3], vhi[i][0], vhi[i][1], vhi[i][2], vhi[i][3]}
#define VRD(i) do { vlo[i] = vtr(vp_ + (((i) >> 2) * 4096 + ((i) & 3) * 1024)); vhi[i] = vtr(vp_ + (((i) >> 2) * 4096 + ((i) & 3) * 1024 + 512)); } while (0)
#define KRD(G, d0) do { if (G) { kload2(kf, kp0 + sl_next, d0); SBAR(); } } while (0)
#define GAPA(MF, a0, a1, a2, a3, W0, W1, PW) do { MF; sacc += a0; sacc += a1; sacc += a2; sacc += a3; W0; W1; PIN(PW); PIN(sacc); SBAR(); } while (0)
#define GAPB(MF, X, i) do { MF; X[i] = EX(X[i]); X[i + 1] = EX(X[i + 1]); X[i + 2] = EX(X[i + 2]); X[i + 3] = EX(X[i + 3]); PIN(X); SBAR(); } while (0)
#define STEP(C0, C1, P0, P1, t, GK, GV, GL) do { SBAR(); \
    const lds_cptr vp_ = vp0 + sl_prev; \
    VRD(0); SBAR(); float sacc = P0[0] + P0[1]; \
                    GAPA(C0 = MFMA(kf[0], qr[0], negm), P0[2], P0[3], P0[4], P0[5],     pw0[0] = PKW(P0, 0),  pw0[1] = PKW(P0, 2),  pw0); \
    VRD(4); SBAR(); GAPA(C1 = MFMA(kf[1], qr[0], negm), P0[6], P0[7], P0[8], P0[9],     pw0[2] = PKW(P0, 4),  pw0[3] = PKW(P0, 6),  pw0); \
    VRD(1); SBAR(); GAPA(C0 = MFMA(kf[2], qr[1], C0),    P0[10], P0[11], P0[12], P0[13], pw1[0] = PKW(P0, 8),  pw1[1] = PKW(P0, 10), pw1); \
    VRD(5); SBAR(); GAPA(C1 = MFMA(kf[3], qr[1], C1),    P0[14], P0[15], P1[0], P1[1],   pw1[2] = PKW(P0, 12), pw1[3] = PKW(P0, 14), pw1); \
    VRD(2); SBAR(); GAPA(C0 = MFMA(kf[4], qr[2], C0),    P1[2], P1[3], P1[4], P1[5],     pw2[0] = PKW(P1, 0),  pw2[1] = PKW(P1, 2),  pw2); \
    VRD(6); SBAR(); GAPA(C1 = MFMA(kf[5], qr[2], C1),    P1[6], P1[7], P1[8], P1[9],     pw2[2] = PKW(P1, 4),  pw2[3] = PKW(P1, 6),  pw2); \
    VRD(3); SBAR(); GAPA(C0 = MFMA(kf[6], qr[3], C0),    P1[10], P1[11], P1[12], P1[13], pw3[0] = PKW(P1, 8),  pw3[1] = PKW(P1, 10), pw3); \
    VRD(7); SBAR(); GAPA(C1 = MFMA(kf[7], qr[3], C1),    P1[14], P1[15], 0.f, 0.f,       pw3[2] = PKW(P1, 12), pw3[3] = PKW(P1, 14), pw3); \
    l_reg += sacc; \
    if (GK) DMA_K((t) + 3, sl_cur); if (GV) DMA_V((t) + 1, sl_next); \
    hk.apply(C0, C1, (t), r32, hi, wid); \
    if ((t) + 1 < NT) hk.prefetch_issue((t) + 1, wid); \
    { const float rm = rowmax(C0, C1); resc = false; \
      if (__builtin_expect(__any(rm > 8.0f), 0)) { const float dl = __builtin_fmaxf(rm, 0.f); mhat += dl; \
          _Pragma("unroll") for (int r = 0; r < 16; ++r) { C0[r] -= dl; C1[r] -= dl; negm[r] = -mhat; } PIN(negm); \
          const float f = __builtin_amdgcn_exp2f(-dl); l_reg *= f; if (hi == 0) wsf[r32] = f; resc = true; } } \
    SBAR(); \
    GAPB(o[0] = MFMA(PAF(0), VFR(0), o[0]), C0, 0);              GAPB(o[1] = MFMA(PAF(0), VFR(4), o[1]), C0, 4); \
    KRD(GL, 0); GAPB(o[0] = MFMA(PAF(1), VFR(1), o[0]), C0, 8);  KRD(GL, 1); GAPB(o[1] = MFMA(PAF(1), VFR(5), o[1]), C0, 12); \
    KRD(GL, 2); GAPB(o[0] = MFMA(PAF(2), VFR(2), o[0]), C1, 0);  KRD(GL, 3); GAPB(o[1] = MFMA(PAF(2), VFR(6), o[1]), C1, 4); \
    GAPB(o[0] = MFMA(PAF(3), VFR(3), o[0]), C1, 8);              GAPB(o[1] = MFMA(PAF(3), VFR(7), o[1]), C1, 12); \
    if ((t) + 1 < NT) hk.prefetch_wait(); \
    } while (0)
    int t = 1;
    for (; t + 5 < NT; t += 2) {
        STEP(pB0, pB1, pA0, pA1, t, true, true, true);     ATT_WAIT_BAR(2); RESC(); ROT();
        STEP(pA0, pA1, pB0, pB1, t + 1, true, true, true); ATT_WAIT_BAR(2); RESC(); ROT();
    }
#define ENDW(tt) do { if ((tt) + 3 < NT) { ATT_WAIT_BAR(2); } else if ((tt) + 2 < NT) { ATT_WAIT_BAR(1); } else { ATT_WAIT_BAR(0); } } while (0)
    for (; t + 1 < NT; t += 2) {
        STEP(pB0, pB1, pA0, pA1, t, (t + 3 < NT), (t + 1 < NT), (t + 1 < NT));         ENDW(t);     RESC(); ROT();
        STEP(pA0, pA1, pB0, pB1, t + 1, (t + 4 < NT), (t + 2 < NT), (t + 2 < NT));     ENDW(t + 1); RESC(); ROT();
    }
    STEP(pB0, pB1, pA0, pA1, NT - 1, false, false, false); RESC();
    { float sacc = pB0[0] + pB0[1];
#pragma unroll
      for (int r = 2; r < 16; ++r) sacc += pB0[r];
#pragma unroll
      for (int r = 0; r < 16; ++r) sacc += pB1[r];
      l_reg += sacc;
      pw0 = (v4u){PKW(pB0, 0), PKW(pB0, 2), PKW(pB0, 4), PKW(pB0, 6)}; pw1 = (v4u){PKW(pB0, 8), PKW(pB0, 10), PKW(pB0, 12), PKW(pB0, 14)};
      pw2 = (v4u){PKW(pB1, 0), PKW(pB1, 2), PKW(pB1, 4), PKW(pB1, 6)}; pw3 = (v4u){PKW(pB1, 8), PKW(pB1, 10), PKW(pB1, 12), PKW(pB1, 14)};
      const lds_cptr vp_ = vp0 + sl_cur; _Pragma("unroll") for (int i = 0; i < 8; ++i) VRD(i);
      o[0] = MFMA(PAF(0), VFR(0), o[0]); o[1] = MFMA(PAF(0), VFR(4), o[1]); o[0] = MFMA(PAF(1), VFR(1), o[0]); o[1] = MFMA(PAF(1), VFR(5), o[1]);
      o[0] = MFMA(PAF(2), VFR(2), o[0]); o[1] = MFMA(PAF(2), VFR(6), o[1]); o[0] = MFMA(PAF(3), VFR(3), o[0]); o[1] = MFMA(PAF(3), VFR(7), o[1]); }
    { auto rr = __builtin_amdgcn_permlane32_swap(__float_as_uint(l_reg), __float_as_uint(l_reg), false, false); l_reg = __uint_as_float(rr[0]) + __uint_as_float(rr[1]); }
    if constexpr (Hook::PART_OUT) {
        float* pp = hk.part + (size_t)(wid * 32) * Hook::RS * PSTRIDE;
        if (hi == 0) { pp[(size_t)r32 * Hook::RS * PSTRIDE] = mhat; pp[(size_t)r32 * Hook::RS * PSTRIDE + 1] = l_reg; }
#pragma unroll
        for (int r = 0; r < 16; ++r) { float* pr = pp + (size_t)crow(r, hi) * Hook::RS * PSTRIDE + 8 + r32; pr[0] = o[0][r]; pr[32] = o[1][r]; }
    } else {
    if (hi == 0) wsf[32 + r32] = l_reg;
    LDS_WAIT();
    float rli[16];
#pragma unroll
    for (int r = 0; r < 16; ++r) rli[r] = __builtin_amdgcn_rcpf(wsf[32 + crow(r, hi)]);
    bf16* Ow = Oh + (qrow0 + (long)(wid * 32) * Hook::RS) * opitch;
    { LAS bf16* stg = (LAS bf16*)(shm + L_OST) + wid * 2048;
#pragma unroll
        for (int r = 0; r < 16; ++r) { const int orow = crow(r, hi);
#pragma unroll
            for (int d0 = 0; d0 < 2; ++d0) stg[orow * 64 + d0 * 32 + r32] = (bf16)f2bf(o[d0][r] * rli[r]); }
        LDS_WAIT();
#pragma unroll
        for (int i = 0; i < 4; ++i) { const int row = i * 8 + (lane >> 3), ch = lane & 7; const v4u v = *(const LAS v4u*)(stg + row * 64 + ch * 8); *(v4u*)(Ow + (long)row * Hook::RS * opitch + ch * 8) = v; } }
    }
    asm volatile("s_waitcnt lgkmcnt(0)\n\ts_barrier" ::: "memory");
#undef DMA_K
#undef DMA_V
#undef ROT
#undef EX
#undef RESC
#undef PKW
#undef PAF
#undef VFR
#undef VRD
#undef KRD
#undef ENDW
#undef GAPA
#undef GAPB
#undef STEP
}
#undef SBAR
#undef PIN
#undef MFMA
template <class Hook>
__device__ __forceinline__ void attn_unit_pipe(Hook& hk, const bf16* Qh, const bf16* Kh, const bf16* Vh, bf16* Oh, long qrow0, int NT, LAS unsigned char* shm, int opitch) {
    int tid_ = threadIdx.x; asm volatile("" : "+v"(tid_)); const int tid = tid_, lane = tid & 63, r32 = lane & 31, hi = lane >> 5; const int wid = __builtin_amdgcn_readfirstlane(tid >> 6);
    const unsigned lds0 = (unsigned)(size_t)shm;
    LAS float* wsf = (LAS float*)(shm + L_WS) + wid * 64;
    volatile LAS float* wmin = (volatile LAS float*)(shm + L_WMIN);
    const bf16* Qw = Qh + (qrow0 + wid * 32) * PITCH;
    const bf16* ksrc = Kh + (long)lane * PITCH + wid * 8;
    const bf16* vsrc = Vh + (long)(16 * (wid & 3) + (lane >> 2)) * PITCH + (wid >> 2) * 32 + (lane & 3) * 8;
    const unsigned kdst = lds0 + L_K + wid * 1024, vdst = lds0 + L_V + wid * 1024;
#define ATT_DMAK(t, slot) glds16(ksrc + hk.tile_row(t) * PITCH, (unsigned)__builtin_amdgcn_readfirstlane(kdst + (slot)))
#define ATT_DMAV(t, slot) glds16(vsrc + hk.tile_row(t) * PITCH, (unsigned)__builtin_amdgcn_readfirstlane(vdst + (slot)))
    const int vb0 = (int)(lds0 + L_V) + ((lane >> 4) & 1) * 32 + (lane & 3) * 8 + (4 * hi + ((lane & 15) >> 2)) * 64;
    bf16x8 qr[4];
#pragma unroll
    for (int d0 = 0; d0 < 4; ++d0) qr[d0] = *(const bf16x8*)(Qw + (long)r32 * PITCH + d0 * 16 + hi * 8);
    ATT_DMAK(0, 0);
    if (NT > 1) ATT_DMAK(1, SLOTB);
    ATT_DMAV(0, 0);
    if (NT > 2) ATT_DMAK(2, 2 * SLOTB);
    if (NT > 1) ATT_DMAV(1, SLOTB);
    float mhat = -1e30f, l_reg = 0.f; f32x16 o[2]; o[0] = f32x16{}; o[1] = f32x16{};
    f32x16 pA0, pA1, pB0, pB1;
    if (NT > 2) { ATT_WAIT_BAR(4); } else { ATT_WAIT_BAR(0); }
    qkt(pA0, pA1, shm + L_K, qr, r32, hi);
    hk.prefetch(0, wid);
    int slc = 0, sln = SLOTB, sl2 = 2 * SLOTB;
#define ATT_ROT() do { const int t_ = slc; slc = sln; sln = sl2; sl2 = t_; } while (0)
#define ATT_STEP(C0, C1, N0, N1, t) do { \
        if ((t) + 2 < NT) { ATT_WAIT_BAR(2); } else if ((t) + 1 < NT) { ATT_WAIT_BAR(1); } else { ATT_WAIT_BAR(0); } \
        if (Hook::EARLY && (t) >= 4) { const int wb_ = (((t) - 1) & 1) * 8; \
            const float mm_ = __builtin_fminf(__builtin_fminf(__builtin_fminf(wmin[wb_ + 0], wmin[wb_ + 1]), __builtin_fminf(wmin[wb_ + 2], wmin[wb_ + 3])), \
                                              __builtin_fminf(__builtin_fminf(wmin[wb_ + 4], wmin[wb_ + 5]), __builtin_fminf(wmin[wb_ + 6], wmin[wb_ + 7]))); \
            if (hk.stop((t), mm_)) { asm volatile("s_waitcnt vmcnt(0)" ::: "memory"); goto att_done; } } \
        if ((t) + 3 < NT) ATT_DMAK((t) + 3, slc); \
        if ((t) + 2 < NT) ATT_DMAV((t) + 2, sl2); \
        __builtin_amdgcn_sched_barrier(0); \
        if ((t) + 1 < NT) qkt(N0, N1, shm + L_K + sln, qr, r32, hi); \
        __builtin_amdgcn_sched_barrier(0); \
        hk.apply(C0, C1, (t), r32, hi, wid); \
        if ((t) + 1 < NT) hk.prefetch_issue((t) + 1, wid); \
        { const float rm = rowmax(C0, C1); bool resc = false; \
          if (__any(rm > mhat + 8.0f)) { const float mn = __builtin_fmaxf(mhat, rm); const float f = __builtin_amdgcn_exp2f(mhat - mn); l_reg *= f; mhat = mn; if (hi == 0) wsf[r32] = f; resc = true; } \
          float sacc = 0.f; \
          _Pragma("unroll") for (int r = 0; r < 16; ++r) { C0[r] = __builtin_amdgcn_exp2f(C0[r] - mhat); C1[r] = __builtin_amdgcn_exp2f(C1[r] - mhat); sacc += C0[r] + C1[r]; } \
          l_reg += sacc; \
          if (Hook::EARLY) { float mw = mhat; \
              _Pragma("unroll") for (int o_ = 1; o_ < 64; o_ <<= 1) mw = __builtin_fminf(mw, __shfl_xor(mw, o_)); \
              if (lane == 0) wmin[((t) & 1) * 8 + wid] = mw; } \
          const v4u pw0 = (v4u){cvtpk_s(C0[0], C0[1]), cvtpk_s(C0[2], C0[3]), cvtpk_s(C0[4], C0[5]), cvtpk_s(C0[6], C0[7])}; \
          const v4u pw1 = (v4u){cvtpk_s(C0[8], C0[9]), cvtpk_s(C0[10], C0[11]), cvtpk_s(C0[12], C0[13]), cvtpk_s(C0[14], C0[15])}; \
          const v4u pw2 = (v4u){cvtpk_s(C1[0], C1[1]), cvtpk_s(C1[2], C1[3]), cvtpk_s(C1[4], C1[5]), cvtpk_s(C1[6], C1[7])}; \
          const v4u pw3 = (v4u){cvtpk_s(C1[8], C1[9]), cvtpk_s(C1[10], C1[11]), cvtpk_s(C1[12], C1[13]), cvtpk_s(C1[14], C1[15])}; \
          if (resc) { LDS_WAIT(); \
              _Pragma("unroll") for (int r = 0; r < 16; ++r) { const float f = wsf[crow(r, hi)]; o[0][r] *= f; o[1][r] *= f; } } \
          __builtin_amdgcn_sched_barrier(0); \
          pv(o, vb0 + slc, __builtin_bit_cast(bf16x8, pw0), __builtin_bit_cast(bf16x8, pw1), __builtin_bit_cast(bf16x8, pw2), __builtin_bit_cast(bf16x8, pw3)); } \
        if ((t) + 1 < NT) hk.prefetch_wait(); \
        ATT_ROT(); \
    } while (0)
    {
        int t = 0;
        for (; t + 1 < NT; t += 2) { ATT_STEP(pA0, pA1, pB0, pB1, t); ATT_STEP(pB0, pB1, pA0, pA1, t + 1); }
        if (t < NT) { ATT_STEP(pA0, pA1, pB0, pB1, t); }
    }
att_done:
    { auto rr = __builtin_amdgcn_permlane32_swap(__float_as_uint(l_reg), __float_as_uint(l_reg), false, false); l_reg = __uint_as_float(rr[0]) + __uint_as_float(rr[1]); }
    if (hi == 0) wsf[32 + r32] = l_reg;
    LDS_WAIT();
    float rli[16];
#pragma unroll
    for (int r = 0; r < 16; ++r) rli[r] = __builtin_amdgcn_rcpf(wsf[32 + crow(r, hi)]);
    bf16* Ow = Oh + (qrow0 + wid * 32) * opitch;
    { LAS bf16* stg = (LAS bf16*)(shm + L_OST) + wid * 2048;
#pragma unroll
        for (int r = 0; r < 16; ++r) { const int orow = crow(r, hi);
#pragma unroll
            for (int d0 = 0; d0 < 2; ++d0) stg[orow * 64 + d0 * 32 + r32] = (bf16)f2bf(o[d0][r] * rli[r]); }
        LDS_WAIT();
#pragma unroll
        for (int i = 0; i < 4; ++i) { const int row = i * 8 + (lane >> 3), ch = lane & 7; const v4u v = *(const LAS v4u*)(stg + row * 64 + ch * 8); *(v4u*)(Ow + (long)row * opitch + ch * 8) = v; } }
    asm volatile("s_waitcnt lgkmcnt(0)\n\ts_barrier" ::: "memory");
#undef ATT_DMAK
#undef ATT_DMAV
#undef ATT_ROT
#undef ATT_STEP
}
__device__ __forceinline__ int t5_bucket(int d) {
    if (d < 16) return d < 0 ? 0 : d;
    return 16 + (d >= 22) + (d >= 30) + (d >= 40) + (d >= 54) + (d >= 73) + (d >= 99) + (d >= 134) + (d >= 182) + (d >= 246) + (d >= 332) + (d >= 450) + (d >= 609) + (d >= 825) + (d >= 1117) + (d >= 1513);
}
struct FoxHook {
    static constexpr bool EARLY = true, PART_IN = false, PART_OUT = false; static constexpr int RS = 1; float* part;
    __device__ __forceinline__ void prefetch(int, int) {}
    __device__ __forceinline__ void prefetch_issue(int, int) {}
    __device__ __forceinline__ void prefetch_wait() {}
    long rowbase; int NT, q0; const LAS float* Ft; const LAS float* knp; float qmax;
    __device__ __forceinline__ bool stop(int t, float mm) const { const int kt = NT - 1 - t; const float bound = qmax * knp[kt] * 1.001f + 0.01f + (Ft[q0] - Ft[64 * kt + 63]); return bound < mm - 48.0f; }
    __device__ __forceinline__ long tile_row(int t) const { return rowbase + 64 * (NT - 1 - t); }
    __device__ __forceinline__ void apply(f32x16& p0, f32x16& p1, int t, int r32, int hi, int wid) const {
        const int kb = 64 * (NT - 1 - t); const int tq = q0 + wid * 32 + r32; const float Fq = Ft[tq];
#pragma unroll
        for (int g = 0; g < 4; ++g) { const f32x4 f0 = *(const LAS f32x4*)(Ft + kb + 8 * g + 4 * hi), f1 = *(const LAS f32x4*)(Ft + kb + 32 + 8 * g + 4 * hi);
#pragma unroll
            for (int i = 0; i < 4; ++i) { p0[4 * g + i] += Fq - f0[i]; p1[4 * g + i] += Fq - f1[i]; }
            __builtin_amdgcn_sched_barrier(0); }
        if (kb + 63 > q0 + wid * 32) {
#pragma unroll
            for (int r = 0; r < 16; ++r) { const int key = kb + crow(r, hi); if (key > tq) p0[r] = -INFINITY; if (key + 32 > tq) p1[r] = -INFINITY; }
        }
    }
};
typedef unsigned u32x16 __attribute__((ext_vector_type(16)));
struct DsaHook {
    static constexpr bool EARLY = false, PART_IN = false, PART_OUT = false; static constexpr int RS = 1; float* part;
    __device__ __forceinline__ bool stop(int, float) const { return false; }
    long rowbase; int q0; const LAS float* tb; float c31; const unsigned long long* maskq;
    u32x16 ma, mb;
    __device__ __forceinline__ long tile_row(int t) const { return rowbase + 64 * t; }
    __device__ __forceinline__ unsigned long long mptr(int t, int wid) const { const unsigned long long* mp = maskq + ((size_t)wid * 128 + t) * 32;
        return ((unsigned long long)(unsigned)__builtin_amdgcn_readfirstlane((int)((unsigned long long)mp & 0xffffffffull))) | ((unsigned long long)(unsigned)__builtin_amdgcn_readfirstlane((int)((unsigned long long)mp >> 32)) << 32); }
    __device__ __forceinline__ void prefetch(int t, int wid) { const unsigned long long mpu = mptr(t, wid); unsigned d0, d1;
        asm volatile("s_load_dwordx16 %0, %4, 0x0\n\ts_load_dwordx16 %1, %4, 0x40\n\ts_load_dword %2, %4, 0x80\n\ts_load_dword %3, %4, 0xc0\n\ts_waitcnt lgkmcnt(0)" : "=&s"(ma), "=&s"(mb), "=&s"(d0), "=&s"(d1) : "s"(mpu) : "memory"); }
    unsigned pd0, pd1;
    __device__ __forceinline__ void prefetch_issue(int t, int wid) { const unsigned long long mpu = mptr(t, wid);
        asm volatile("s_load_dwordx16 %0, %4, 0x0\n\ts_load_dwordx16 %1, %4, 0x40\n\ts_load_dword %2, %4, 0x80\n\ts_load_dword %3, %4, 0xc0" : "=&s"(ma), "=&s"(mb), "=&s"(pd0), "=&s"(pd1) : "s"(mpu) : "memory"); }
    __device__ __forceinline__ void prefetch_wait() { asm volatile("s_waitcnt lgkmcnt(0)" : "+s"(ma), "+s"(mb), "+s"(pd0), "+s"(pd1) :: "memory"); }
    __device__ __forceinline__ void apply(f32x16& p0, f32x16& p1, int t, int r32, int hi, int wid) {
        const int kb = 64 * t; const int q0w = q0 + wid * 32; const int tq = q0w + r32;
        asm volatile("s_nop 3" : "+v"(p0), "+v"(p1));
        const unsigned long long mpu = mptr(t, wid);
        u32x16 a, b;
        asm volatile("s_load_dwordx16 %0, %2, 0x80\n\ts_load_dwordx16 %1, %2, 0xc0" : "=&s"(a), "=&s"(b) : "s"(mpu) : "memory");
        if (q0w - (kb + 63) < 1513) {
            const LAS float* tl = tb + (tq + 256 - kb - 4 * hi);
#pragma unroll
            for (int g = 0; g < 4; ++g) { float t0[4], t1[4];
#pragma unroll
                for (int i = 0; i < 4; ++i) { t0[i] = tl[-(8 * g + i)]; t1[i] = tl[-(8 * g + i) - 32]; }
#pragma unroll
                for (int i = 0; i < 4; ++i) { asm volatile("v_add_f32 %0, %1, %2" : "=v"(p0[4 * g + i]) : "v"(p0[4 * g + i]), "v"(t0[i])); asm volatile("v_add_f32 %0, %1, %2" : "=v"(p1[4 * g + i]) : "v"(p1[4 * g + i]), "v"(t1[i])); }
                __builtin_amdgcn_sched_barrier(0); }
        }
        const float NEG = -INFINITY;
#pragma unroll
        for (int r = 0; r < 8; ++r) { const unsigned long long mk = ((unsigned long long)ma[2 * r + 1] << 32) | ma[2 * r]; asm volatile("v_cndmask_b32_e64 %0, %1, %2, %3" : "=v"(p0[r]) : "v"(NEG), "v"(p0[r]), "s"(mk)); }
#pragma unroll
        for (int r = 0; r < 8; ++r) { const unsigned long long mk = ((unsigned long long)mb[2 * r + 1] << 32) | mb[2 * r]; asm volatile("v_cndmask_b32_e64 %0, %1, %2, %3" : "=v"(p0[8 + r]) : "v"(NEG), "v"(p0[8 + r]), "s"(mk)); }
        asm volatile("s_waitcnt lgkmcnt(0)" : "+s"(a), "+s"(b) :: "memory");
#pragma unroll
        for (int r = 0; r < 8; ++r) { const unsigned long long mk = ((unsigned long long)a[2 * r + 1] << 32) | a[2 * r]; asm volatile("v_cndmask_b32_e64 %0, %1, %2, %3" : "=v"(p1[r]) : "v"(NEG), "v"(p1[r]), "s"(mk)); }
#pragma unroll
        for (int r = 0; r < 8; ++r) { const unsigned long long mk = ((unsigned long long)b[2 * r + 1] << 32) | b[2 * r]; asm volatile("v_cndmask_b32_e64 %0, %1, %2, %3" : "=v"(p1[8 + r]) : "v"(NEG), "v"(p1[8 + r]), "s"(mk)); }
    }
};
template <int RS_, bool PIN_, bool POUT_>
struct DilHookT {
    static constexpr bool EARLY = false, PART_IN = PIN_, PART_OUT = POUT_; static constexpr int RS = RS_; float* part;
    __device__ __forceinline__ void prefetch(int, int) {}
    __device__ __forceinline__ void prefetch_issue(int, int) {}
    __device__ __forceinline__ void prefetch_wait() {}
    __device__ __forceinline__ bool stop(int, float) const { return false; }
    long rowbase; int q0, kt0; const LAS float* tb;
    __device__ __forceinline__ long tile_row(int t) const { return rowbase + (long)RS_ * 64 * (kt0 + t); }
    __device__ __forceinline__ void apply(f32x16& p0, f32x16& p1, int t, int r32, int hi, int wid) const {
        const int kb = 64 * (kt0 + t); const int tq = q0 + wid * 32 + r32;
        const LAS float* tl = tb + (tq + 256 - kb - 4 * hi);
        asm volatile("s_nop 3" : "+v"(p0), "+v"(p1));
#pragma unroll
        for (int g = 0; g < 4; ++g) { float t0[4], t1[4];
#pragma unroll
            for (int i = 0; i < 4; ++i) { t0[i] = tl[-(8 * g + i)]; t1[i] = tl[-(8 * g + i) - 32]; }
#pragma unroll
            for (int i = 0; i < 4; ++i) { asm volatile("v_add_f32 %0, %1, %2" : "=v"(p0[4 * g + i]) : "v"(p0[4 * g + i]), "v"(t0[i])); asm volatile("v_add_f32 %0, %1, %2" : "=v"(p1[4 * g + i]) : "v"(p1[4 * g + i]), "v"(t1[i])); }
            __builtin_amdgcn_sched_barrier(0); }
    }
};
}
namespace gla {
constexpr int LS = 72;
constexpr int O_QT = 0, O_KT = 9216, O_KHT = 18432, O_VT = 27648, O_AT = 46080, O_GA = 55296, O_WG = 59392, O_TOT = 63488, O_END = 65536;
__device__ __forceinline__ bf16x8 frag(const LAS bf16* base, int row, int k0) { return *(const LAS bf16x8*)(base + row * LS + k0); }
__device__ __forceinline__ int swz(int row, int k) { return row * LS + ((((k >> 3) ^ (row >> 3)) & 7) << 3) + (k & 7); }
__device__ __forceinline__ bf16x8 frag_sw(const LAS bf16* base, int row, int k0) { return *(const LAS bf16x8*)(base + swz(row, k0)); }
#define GLA_MFMA(x, y, c) __builtin_amdgcn_mfma_f32_16x16x32_bf16(x, y, c, 0, 0, 0)
__device__ __forceinline__ void chunk_unit(Frame& F, int b, int h, int c, const float* w_gate, const float* b_gate) {
    unsigned char* act = F.ws + WS_ACT; unsigned char* big = F.ws + WS_BIG;
    const bf16* QA = (const bf16*)(act + pg8::A_QA); const bf16* KA = (const bf16*)(act + pg8::A_KA); const bf16* VA = (const bf16*)(act + pg8::A_VA);
    const float* SM = (const float*)(act + pg8::A_SMALL);
    float* DS = (float*)(big + BG_DS); float* OI = (float*)(F.ws + WS_Y); bf16* QS = (bf16*)(big + BG_QS); float* DEC = (float*)(big + BG_DEC);
    LAS bf16* QT = (LAS bf16*)(F.lds + O_QT); LAS bf16* KT = (LAS bf16*)(F.lds + O_KT); LAS bf16* KHT = (LAS bf16*)(F.lds + O_KHT); LAS bf16* VT = (LAS bf16*)(F.lds + O_VT); LAS bf16* AT = (LAS bf16*)(F.lds + O_AT);
    LAS float* GA = (LAS float*)(F.lds + O_GA); LAS float* WG = (LAS float*)(F.lds + O_WG); LAS float* TOT = (LAS float*)(F.lds + O_TOT);
    int tidl_ = threadIdx.x; asm volatile("" : "+v"(tidl_));
    const int tid = tidl_, lane = tid & 63, wave = __builtin_amdgcn_readfirstlane(tid >> 6); const size_t m0 = (size_t)b * SEQ + 64 * c; const int bh = b * 4 + h;
    unsigned short qraw[8], kraw[8];
#pragma unroll
    for (int a = 0; a < 8; ++a) { const size_t o_ = (m0 + 8 * wave + a) * 256 + 64 * h + (tid & 63); qraw[a] = QA[o_]; kraw[a] = KA[o_]; }
    for (int i = tid; i < 1024; i += NTHR) { GA[i] = SM[(m0 + (i >> 4)) * 32 + (i & 15)]; WG[i] = w_gate[(i >> 6) * 256 + 64 * h + (i & 63)]; }
    for (int ch = tid; ch < 1024; ch += NTHR) { const int j = ch >> 4, v0 = (ch & 15) * 8; const v4u w = *(const GAS v4u*)(VA + (m0 + j) * 512 + 128 * h + v0);
        LAS bf16* pv_ = VT + swz(v0, j);
        pv_[0 * LS] = (bf16)(w.x & 0xffff); pv_[1 * LS] = (bf16)(w.x >> 16); pv_[2 * LS] = (bf16)(w.y & 0xffff); pv_[3 * LS] = (bf16)(w.y >> 16);
        pv_[4 * LS] = (bf16)(w.z & 0xffff); pv_[5 * LS] = (bf16)(w.z >> 16); pv_[6 * LS] = (bf16)(w.w & 0xffff); pv_[7 * LS] = (bf16)(w.w >> 16); }
    LDS_BAR();
    const int kap = tid & 63, part = wave;
    float cg[8];
    { const float bg = b_gate[64 * h + kap]; float run = 0.f;
#pragma unroll
      for (int a = 0; a < 8; ++a) { float z = bg;
#pragma unroll
          for (int r = 0; r < 16; ++r) z += GA[(8 * part + a) * 16 + r] * WG[r * 64 + kap];
          run += log_sigmoid(z) * (1.0f / 16.0f); cg[a] = run; }
      TOT[part * 64 + kap] = run; }
    LDS_BAR();
    float offs = 0.f, gmid = 0.f, glast = 0.f;
#pragma unroll
    for (int p = 0; p < 8; ++p) { const float tv = TOT[p * 64 + kap]; if (p < part) offs += tv; if (p < 4) gmid += tv; glast += tv; }
#pragma unroll
    for (int a = 0; a < 8; ++a) { const int i = 8 * part + a; const float G = offs + cg[a];
        const float q = bf2f(qraw[a]), k = bf2f(kraw[a]);
        QT[i * LS + kap] = (bf16)f2bf(q * __expf(G - gmid)); KT[i * LS + kap] = (bf16)f2bf(k * __expf(gmid - G)); KHT[kap * LS + i] = (bf16)f2bf(k * __expf(glast - G));
        QS[(m0 + i) * 256 + 64 * h + kap] = (bf16)f2bf(q * __expf(G)); }
    if (part == 7) DEC[((size_t)bh * 128 + c) * 64 + kap] = __expf(glast);
    LDS_BAR();
    const int fr = lane & 15, fq = lane >> 4;
#pragma unroll
    for (int tt = 0; tt < 2; ++tt) { const int tile = 2 * wave + tt, it = tile >> 2, jt = tile & 3; f32x4 acc = {0.f, 0.f, 0.f, 0.f};
        if (jt <= it) {
#pragma unroll
            for (int ks = 0; ks < 2; ++ks) acc = GLA_MFMA(frag(QT, 16 * it + fr, 32 * ks + 8 * fq), frag(KT, 16 * jt + fr, 32 * ks + 8 * fq), acc); }
#pragma unroll
        for (int r = 0; r < 4; ++r) { const int i = 16 * it + 4 * fq + r, j = 16 * jt + fr; AT[i * LS + j] = (bf16)f2bf(j <= i ? acc[r] : 0.f); } }
    LDS_BAR();
    { const int it = wave & 3;
#pragma unroll
      for (int vv = 0; vv < 4; ++vv) { const int vt = 4 * (wave >> 2) + vv; f32x4 ao = {0.f, 0.f, 0.f, 0.f}, ad = {0.f, 0.f, 0.f, 0.f};
#pragma unroll
          for (int ks = 0; ks < 2; ++ks) { const bf16x8 y = frag_sw(VT, 16 * vt + fr, 32 * ks + 8 * fq);
              ao = GLA_MFMA(frag(AT, 16 * it + fr, 32 * ks + 8 * fq), y, ao); ad = GLA_MFMA(frag(KHT, 16 * it + fr, 32 * ks + 8 * fq), y, ad); }
          *(f32x4*)(OI + (((((size_t)bh * 128 + c) * 8 + wave) * 4 + vv) * 64 + lane) * 4) = ao;
#pragma unroll
          for (int r = 0; r < 4; ++r) { const int i = 16 * it + 4 * fq + r, v = 16 * vt + fr;
              DS[(((size_t)bh * 128 + c) * 64 + i) * 128 + v] = ad[r]; } } }
}
__device__ __forceinline__ void scan_unit(Frame& F, int u) {
    unsigned char* big = F.ws + WS_BIG;
    const float* DS = (const float*)(big + BG_DS); const float* DEC = (const float*)(big + BG_DEC); bf16* SP = (bf16*)(big + BG_SP);
    int tidl_ = threadIdx.x; asm volatile("" : "+v"(tidl_));
    const int bh = u >> 4, e = (u & 15) * 512 + tidl_, kap = e >> 7;
    const float* ds = DS + (size_t)bh * 128 * 8192 + e; const float* dc = DEC + (size_t)bh * 128 * 64 + kap; bf16* sp = SP + (size_t)bh * 128 * 8192 + e;
    float S = 0.f;
    for (int c0 = 0; c0 < 128; c0 += 16) { float d[16], g[16];
#pragma unroll
        for (int k = 0; k < 16; ++k) { d[k] = ds[(size_t)(c0 + k) * 8192]; g[k] = dc[(c0 + k) * 64]; }
#pragma unroll
        for (int k = 0; k < 16; ++k) { sp[(size_t)(c0 + k) * 8192] = (bf16)f2bf(S); S = g[k] * S + d[k]; } }
}
__device__ __forceinline__ void out_unit(Frame& F, int b, int h, int c, const float* g_norm) {
    unsigned char* act = F.ws + WS_ACT; unsigned char* big = F.ws + WS_BIG;
    const bf16* RA = (const bf16*)(act + pg8::A_RA); const float* OI = (const float*)(F.ws + WS_Y); const bf16* QS = (const bf16*)(big + BG_QS); const bf16* SP = (const bf16*)(big + BG_SP);
    bf16* MIX = (bf16*)(F.ws + WS_MIX);
    LAS bf16* QL = (LAS bf16*)(F.lds + 0); LAS bf16* ST = (LAS bf16*)(F.lds + 9216); LAS float* SS = (LAS float*)(F.lds + 27648);
    int tidl_ = threadIdx.x; asm volatile("" : "+v"(tidl_));
    const int tid = tidl_, lane = tid & 63, wave = __builtin_amdgcn_readfirstlane(tid >> 6); const size_t m0 = (size_t)b * SEQ + 64 * c; const int bh = b * 4 + h;
    LAS bf16* RL = (LAS bf16*)(F.lds + 28672); LAS bf16* OL = (LAS bf16*)(F.lds + 46080);
    f32x4 oi[4];
#pragma unroll
    for (int vv = 0; vv < 4; ++vv) oi[vv] = *(const GAS f32x4*)(OI + (((((size_t)bh * 128 + c) * 8 + wave) * 4 + vv) * 64 + lane) * 4);
#pragma unroll
    for (int k = 0; k < 2; ++k) { const int q = tid + 512 * k, row = q >> 4, cc = (q & 15) * 8; *(LAS v4u*)(RL + row * 136 + cc) = *(const GAS v4u*)(RA + (m0 + row) * 512 + 128 * h + cc); }
    { const int i = tid >> 3, k0 = (tid & 7) * 8; *(LAS v4u*)(QL + i * LS + k0) = *(const GAS v4u*)(QS + (m0 + i) * 256 + 64 * h + k0); }
    const bf16* sp = SP + ((size_t)bh * 128 + c) * 8192;
    for (int ch = tid; ch < 1024; ch += NTHR) { const int kap = ch >> 4, v0 = (ch & 15) * 8; const v4u w = *(const GAS v4u*)(sp + kap * 128 + v0);
        LAS bf16* ps_ = ST + swz(v0, kap);
        ps_[0 * LS] = (bf16)(w.x & 0xffff); ps_[1 * LS] = (bf16)(w.x >> 16); ps_[2 * LS] = (bf16)(w.y & 0xffff); ps_[3 * LS] = (bf16)(w.y >> 16);
        ps_[4 * LS] = (bf16)(w.z & 0xffff); ps_[5 * LS] = (bf16)(w.z >> 16); ps_[6 * LS] = (bf16)(w.w & 0xffff); ps_[7 * LS] = (bf16)(w.w >> 16); }
    LDS_BAR();
    const int fr = lane & 15, fq = lane >> 4, it = wave & 3, vh = wave >> 2;
    f32x4 o[4]; float ss[4] = {0.f, 0.f, 0.f, 0.f};
#pragma unroll
    for (int vv = 0; vv < 4; ++vv) { const int vt = 4 * vh + vv; f32x4 a = {0.f, 0.f, 0.f, 0.f};
#pragma unroll
        for (int ks = 0; ks < 2; ++ks) a = GLA_MFMA(frag(QL, 16 * it + fr, 32 * ks + 8 * fq), frag_sw(ST, 16 * vt + fr, 32 * ks + 8 * fq), a);
#pragma unroll
        for (int r = 0; r < 4; ++r) { const int i = 16 * it + 4 * fq + r, v = 16 * vt + fr; const float x = a[r] + oi[vv][r]; a[r] = x; ss[r] += x * x; }
        o[vv] = a; }
#pragma unroll
    for (int r = 0; r < 4; ++r) { float s = ss[r]; s += __shfl_xor(s, 1); s += __shfl_xor(s, 2); s += __shfl_xor(s, 4); s += __shfl_xor(s, 8); ss[r] = s; }
    if (fr == 0) {
#pragma unroll
        for (int r = 0; r < 4; ++r) SS[vh * 64 + 16 * it + 4 * fq + r] = ss[r]; }
    LDS_BAR();
#pragma unroll
    for (int r = 0; r < 4; ++r) { const int i = 16 * it + 4 * fq + r; const float tot = SS[i] + SS[64 + i]; const float rinv = 1.0f / sqrtf(tot * (1.0f / 128.0f) + LN_EPS);
#pragma unroll
        for (int vv = 0; vv < 4; ++vv) { const int v = 16 * (4 * vh + vv) + fr; const float rr = bf2f(RL[i * 136 + v]);
            const float of = o[vv][r] * rinv * g_norm[v]; const float sg = rr / (1.0f + __expf(-rr));
            OL[i * 136 + v] = (bf16)f2bf(of * sg); } }
    LDS_BAR();
#pragma unroll
    for (int k = 0; k < 2; ++k) { const int q = tid + 512 * k, row = q >> 4, cc = (q & 15) * 8; *(GAS v4u*)(MIX + (m0 + row) * 1024 + 128 * h + cc) = *(const LAS v4u*)(OL + row * 136 + cc); }
}
}

namespace dsa {
__device__ __forceinline__ size_t sc_base(int b, int tq) { const size_t J = (size_t)(tq >> 6); return (size_t)b * SCB + 4096 * (J * (J + 1) / 2) + (size_t)(tq & 63) * 64 * (J + 1); }
__device__ __forceinline__ void score_unit(Frame& F, int b, int qb32) {
    unsigned char* act = F.ws + WS_ACT;
    const bf16* QI = (const bf16*)(act + pg8::A_QI); const bf16* KI = (const bf16*)(act + pg8::A_KI); const float* SM = (const float*)(act + pg8::A_SMALL);
    float* SC = (float*)(F.ws + WS_BIG + BG_SC);
    int tidl_ = threadIdx.x; asm volatile("" : "+v"(tidl_));
    const int lane = tidl_ & 63, wv_ = __builtin_amdgcn_readfirstlane(tidl_ >> 6), fr = lane & 15, fq = lane >> 4, qs = wv_ & 1, kp = wv_ >> 1;
    const int tq = 32 * qb32 + 16 * qs + fr; const size_t m = (size_t)b * SEQ + tq;
    bf16x8 qf[8][2]; float wv[8];
#pragma unroll
    for (int h = 0; h < 8; ++h) { wv[h] = SM[m * 32 + 16 + h];
#pragma unroll
        for (int ks = 0; ks < 2; ++ks) qf[h][ks] = *(const bf16x8*)(QI + m * 512 + 64 * h + 32 * ks + 8 * fq); }
    float* srow = SC + sc_base(b, tq);
    const int ntile = (qb32 >> 1) + 1;
    const bf16* kbase = KI + ((size_t)b * SEQ + fr) * 64 + 8 * fq;
    bf16x8 kn[4][2];
    if (kp < ntile) {
#pragma unroll
        for (int s4 = 0; s4 < 4; ++s4) { kn[s4][0] = *(const bf16x8*)(kbase + (size_t)(64 * kp + 16 * s4) * 64); kn[s4][1] = *(const bf16x8*)(kbase + (size_t)(64 * kp + 16 * s4) * 64 + 32); } }
    for (int kt = kp; kt < ntile; kt += 4) {
        bf16x8 kc[4][2];
#pragma unroll
        for (int s4 = 0; s4 < 4; ++s4) { kc[s4][0] = kn[s4][0]; kc[s4][1] = kn[s4][1]; }
        if (kt + 4 < ntile) {
#pragma unroll
            for (int s4 = 0; s4 < 4; ++s4) { kn[s4][0] = *(const bf16x8*)(kbase + (size_t)(64 * (kt + 4) + 16 * s4) * 64); kn[s4][1] = *(const bf16x8*)(kbase + (size_t)(64 * (kt + 4) + 16 * s4) * 64 + 32); } }
#pragma unroll
        for (int s4 = 0; s4 < 4; ++s4) {
            f32x4 acc = {0.f, 0.f, 0.f, 0.f};
#pragma unroll
            for (int h = 0; h < 8; ++h) { f32x4 d = {0.f, 0.f, 0.f, 0.f}; d = GLA_MFMA(kc[s4][0], qf[h][0], d); d = GLA_MFMA(kc[s4][1], qf[h][1], d);
#pragma unroll
                for (int r = 0; r < 4; ++r) acc[r] += wv[h] * __builtin_fmaxf(d[r], 0.f); }
            *(f32x4*)(srow + 64 * kt + 16 * s4 + 4 * fq) = acc; }
    }
}
__device__ __forceinline__ unsigned okey(float v) { const unsigned u = __float_as_uint(v + 0.0f); return u ^ ((u >> 31) ? 0xffffffffu : 0x80000000u); }
__device__ __forceinline__ void hadd(LAS unsigned* hist, unsigned bin) { __hip_atomic_fetch_add(&hist[bin >> 1], 1u << ((bin & 1u) * 16u), __ATOMIC_RELAXED, __HIP_MEMORY_SCOPE_WORKGROUP); }
__device__ __forceinline__ int hget(const LAS unsigned* hist, int bin) { return (int)((hist[bin >> 1] >> ((bin & 1) * 16)) & 0xffffu); }
__device__ __forceinline__ void find_bin(const LAS unsigned* hist, int wpl, int need, int lane, int& bin, int& above) {
    int cnt = 0;
#pragma unroll 1
    for (int i = 0; i < wpl; i += 4) { const v4u w = *(const LAS v4u*)(hist + lane * wpl + i);
        cnt += (int)(w.x & 0xffffu) + (int)(w.x >> 16) + (int)(w.y & 0xffffu) + (int)(w.y >> 16) + (int)(w.z & 0xffffu) + (int)(w.z >> 16) + (int)(w.w & 0xffffu) + (int)(w.w >> 16); }
    int incl = cnt;
#pragma unroll
    for (int o = 1; o < 64; o <<= 1) { const int t = __shfl_down(incl, o); if (lane + o < 64) incl += t; }
    const int sfx = incl - cnt; const bool mine = (sfx < need) && (sfx + cnt >= need);
    const unsigned long long bal = __ballot(mine); const int tl = __ffsll((long long)bal) - 1;
    const int sfx_t = __shfl(sfx, tl), nb = 2 * wpl, base_bin = tl * nb;
    const int hv = (lane < nb) ? hget(hist, base_bin + lane) : 0;
    int inc = hv;
#pragma unroll
    for (int o = 1; o < 32; o <<= 1) { const int t = __shfl_down(inc, o); if (lane + o < 64) inc += t; }
    const bool hit = (lane < nb) && (sfx_t + inc - hv < need) && (sfx_t + inc >= need);
    const unsigned long long bal2 = __ballot(hit); const int bl = __ffsll((long long)bal2) - 1;
    bin = base_bin + bl; above = sfx_t + __shfl(inc - hv, bl);
}
constexpr int SEL_CAP = 1024;
__device__ __forceinline__ void select_unit(Frame& F, int b, int qb32, unsigned long long* maskp) {
    const float* SC = (const float*)(F.ws + WS_BIG + BG_SC);
    LAS unsigned* W = (LAS unsigned*)(F.lds);
    LAS unsigned* hist = (LAS unsigned*)(F.lds + 32768 + __builtin_amdgcn_readfirstlane((int)threadIdx.x >> 6) * 10240); LAS unsigned* ckey = hist + 1024; LAS unsigned short* cidx = (LAS unsigned short*)(ckey + 1024);
    int tidl_ = threadIdx.x; asm volatile("" : "+v"(tidl_));
    const int tid = tidl_, lane = tid & 63; const unsigned long long lt = (1ull << lane) - 1ull;
    for (int i = tid; i < 8192; i += NTHR) W[i] = 0u;
    LDS_BAR();
#define SEL_OR(s_) __hip_atomic_fetch_or(&W[s_], qbit, __ATOMIC_RELAXED, __HIP_MEMORY_SCOPE_WORKGROUP)
#define SEL_ZERO(nw_) do { LDS_WAIT(); for (int i_ = lane; i_ < (nw_); i_ += 64) hist[i_] = 0u; LDS_WAIT(); } while (0)
    for (int qi = 0; qi < 4; ++qi) {
        const int q = 4 * __builtin_amdgcn_readfirstlane((int)threadIdx.x >> 6) + qi, tq = 32 * qb32 + q, n = tq + 1; const unsigned qbit = 1u << q;
        const float* row = SC + sc_base(b, tq);
        if (n <= 256) { for (int s = lane; s < n; s += 64) SEL_OR(s); continue; }
        const int nch = (n + 255) >> 8;
        int B1, B2, B3, ab1, ab2, ab3;
        SEL_ZERO(1024);
        { f32x4 vn[4];
#define SEL_LOADG(c0_) do { _Pragma("unroll") for (int u = 0; u < 4; ++u) { const int s0 = ((c0_) + u) * 256 + lane * 4; vn[u] = (s0 < n) ? *(const GAS f32x4*)(row + s0) : (f32x4){0.f, 0.f, 0.f, 0.f}; } } while (0)
          SEL_LOADG(0);
          for (int c0 = 0; c0 < nch; c0 += 4) { f32x4 v[4];
#pragma unroll
            for (int u = 0; u < 4; ++u) v[u] = vn[u];
            if (c0 + 4 < nch) SEL_LOADG(c0 + 4);
#pragma unroll
            for (int u = 0; u < 4; ++u) { const int s0 = (c0 + u) * 256 + lane * 4;
#pragma unroll
                for (int c = 0; c < 4; ++c) if (s0 + c < n) hadd(hist, okey(v[u][c]) >> 21); } } }
        LDS_WAIT(); find_bin(hist, 16, 256, lane, B1, ab1);
        const int need1 = 256 - ab1, cnt1 = hget(hist, B1);
        if (cnt1 <= SEL_CAP) {
            int cbase = 0;
            { f32x4 vn[4];
              SEL_LOADG(0);
              for (int c0 = 0; c0 < nch; c0 += 4) { f32x4 v[4];
#pragma unroll
                for (int u = 0; u < 4; ++u) v[u] = vn[u];
                if (c0 + 4 < nch) SEL_LOADG(c0 + 4);
#pragma unroll
                for (int u = 0; u < 4; ++u) { const int s0 = (c0 + u) * 256 + lane * 4;
#pragma unroll
                    for (int c = 0; c < 4; ++c) { const unsigned k = okey(v[u][c]); const int bin = (int)(k >> 21); const bool valid = s0 + c < n;
                        if (valid && bin > B1) SEL_OR(s0 + c);
                        const bool isc = valid && bin == B1; const unsigned long long bal = __ballot(isc);
                        if (isc) { const int pos = cbase + __popcll(bal & lt); ckey[pos] = k; cidx[pos] = (unsigned short)(s0 + c); }
                        cbase += __popcll(bal); } } } }
#undef SEL_LOADG
            const int C = cbase;
            SEL_ZERO(1024);
            for (int i = lane; i < C; i += 64) hadd(hist, (ckey[i] >> 10) & 2047u);
            LDS_WAIT(); find_bin(hist, 16, need1, lane, B2, ab2);
            const int need2 = need1 - ab2;
            SEL_ZERO(512);
            for (int i = lane; i < C; i += 64) { const unsigned k = ckey[i]; if ((int)((k >> 10) & 2047u) == B2) hadd(hist, k & 1023u); }
            LDS_WAIT(); find_bin(hist, 8, need2, lane, B3, ab3);
            const int need3 = need2 - ab3, cnt3 = hget(hist, B3);
            const unsigned T = ((unsigned)B1 << 21) | ((unsigned)B2 << 10) | (unsigned)B3;
            if (need3 >= cnt3) { for (int i = lane; i < C; i += 64) if (ckey[i] >= T) SEL_OR((int)cidx[i]); }
            else { for (int i0 = 0; i0 < C; i0 += 64) { const int i = i0 + lane; const bool valid = i < C; const unsigned k = valid ? ckey[i] : 0u; const int id = valid ? (int)cidx[i] : 0;
                       bool sel = valid && k > T;
                       if (__any(valid && k == T)) { int rank = 0; for (int jj = 0; jj < C; ++jj) rank += (ckey[jj] == T && (int)cidx[jj] < id) ? 1 : 0; if (valid && k == T && rank < need3) sel = true; }
                       if (sel) SEL_OR(id); } }
        } else {
            SEL_ZERO(1024);
            for (int ci = 0; ci < nch; ++ci) { const int s0 = ci * 256 + lane * 4; if (s0 < n) { const f32x4 v = *(const GAS f32x4*)(row + s0);
#pragma unroll
                for (int c = 0; c < 4; ++c) { const unsigned k = okey(v[c]); if (s0 + c < n && (int)(k >> 21) == B1) hadd(hist, (k >> 10) & 2047u); } } }
            LDS_WAIT(); find_bin(hist, 16, need1, lane, B2, ab2);
            const unsigned pre2 = ((unsigned)B1 << 11) | (unsigned)B2; const int need2 = need1 - ab2;
            SEL_ZERO(512);
            for (int ci = 0; ci < nch; ++ci) { const int s0 = ci * 256 + lane * 4; if (s0 < n) { const f32x4 v = *(const GAS f32x4*)(row + s0);
#pragma unroll
                for (int c = 0; c < 4; ++c) { const unsigned k = okey(v[c]); if (s0 + c < n && (k >> 10) == pre2) hadd(hist, k & 1023u); } } }
            LDS_WAIT(); find_bin(hist, 8, need2, lane, B3, ab3);
            const unsigned T = (pre2 << 10) | (unsigned)B3; const int need_eq = need2 - ab3, cnt_eq = hget(hist, B3);
            if (need_eq >= cnt_eq) {
                for (int ci = 0; ci < nch; ++ci) { const int s0 = ci * 256 + lane * 4; if (s0 < n) { const f32x4 v = *(const GAS f32x4*)(row + s0);
#pragma unroll
                    for (int c = 0; c < 4; ++c) if (s0 + c < n && okey(v[c]) >= T) SEL_OR(s0 + c); } }
            } else {
                int running = 0;
                for (int s0 = 0; s0 < n; s0 += 64) { const int s = s0 + lane; const bool valid = s < n; const unsigned k = valid ? okey(row[s]) : 0u;
                    const bool eq = valid && k == T, gt = valid && k > T; const unsigned long long bal = __ballot(eq);
                    const int rank = running + __popcll(bal & lt); if (gt || (eq && rank < need_eq)) SEL_OR(s); running += __popcll(bal); }
            }
        }
        LDS_WAIT();
    }
#undef SEL_OR
#undef SEL_ZERO
    LDS_BAR();
    const int ntile = 4 * (qb32 >> 3) + 4;
    for (int idx = tid; idx < ntile * 32; idx += NTHR) { const int kt = idx >> 5, j = idx & 31, p = j >> 4, r = j & 15; const int klo = 64 * kt + 32 * p + (r & 3) + 8 * (r >> 2);
        maskp[(size_t)kt * 32 + j] = (unsigned long long)W[klo] | ((unsigned long long)W[klo + 4] << 32); }
}
}
__device__ __forceinline__ void dsa_attn_unit(Frame& F, int b, int h, int qb, const float* rel, const unsigned long long* mask_layer) {
    unsigned char* act = F.ws + WS_ACT;
    LAS float* tb = (LAS float*)(F.lds + att::L_TAB);
    const float b31 = rel[31 * 8 + h];
    for (int i = F.tid; i < 1920; i += NTHR) { const int d = i - 256; tb[i] = (rel[att::t5_bucket(d) * 8 + h] - b31) * LOG2E; }
    att::DsaHook hk; hk.rowbase = (long)b * SEQ; hk.q0 = 256 * qb; hk.tb = tb; hk.c31 = rel[31 * 8 + h] * LOG2E;
    hk.maskq = mask_layer + ((size_t)(b * 256 + 8 * qb) * 128) * 32;
    att::attn_unit(hk, (const bf16*)(act + pg8::A_QB) + 64 * h, (const bf16*)(act + pg8::A_KB) + 64 * h, (const bf16*)(act + pg8::A_VB) + 64 * h,
                   (bf16*)(F.ws + WS_MIX) + 512 + 64 * h, (long)b * SEQ + 256 * qb, 4 * (qb + 1), F.lds, 1024);
}
constexpr size_t BG_PARTF = BG_W13M;
constexpr size_t BG_PART = BG_H;
__device__ __forceinline__ void dil_attn_unit(Frame& F, int b, int h, int qb, const float* rel) {
    unsigned char* act = F.ws + WS_ACT;
    LAS float* tb = (LAS float*)(F.lds + att::L_TAB);
    for (int i = F.tid; i < 1024; i += NTHR) { const int d = i - 256; float v = -INFINITY;
        if (d >= 0 && d <= 512) { const int mult = (d <= 128 ? 1 : 0) + (((d & 3) == 0) ? 1 : 0) + (((d & 15) == 0) ? 1 : 0);
            if (mult > 0) v = (rel[att::t5_bucket(d) * 8 + h] + (mult == 1 ? 0.f : (mult == 2 ? 0.6931471805599453f : 1.0986122886681098f))) * LOG2E; }
        tb[i] = v; }
    att::DilHookT<1, true, false> hk; hk.rowbase = (long)b * SEQ; hk.q0 = 256 * qb; hk.kt0 = (4 * qb - 8) > 0 ? (4 * qb - 8) : 0; hk.tb = tb;
    hk.part = (float*)(F.ws + WS_BIG + BG_PART) + ((size_t)((long)b * SEQ + 256 * qb) * 8 + h) * 72;
    att::attn_unit(hk, (const bf16*)(act + pg8::A_QD) + 64 * h, (const bf16*)(act + pg8::A_KD) + 64 * h, (const bf16*)(act + pg8::A_VD) + 64 * h,
                   (bf16*)(F.ws + WS_MIX) + 512 + 64 * h, (long)b * SEQ + 256 * qb, 4 * (qb + 1) - hk.kt0, F.lds, 1024);
}
__device__ __forceinline__ void dil_far_unit(Frame& F, int b, int h, int r, int blk, const float* rel) {
    unsigned char* act = F.ws + WS_ACT;
    LAS float* tb = (LAS float*)(F.lds + att::L_TAB);
    for (int i = F.tid; i < 640; i += NTHR) { const int dc = i - 256; tb[i] = (dc >= 33 && dc <= 128) ? rel[att::t5_bucket(16 * dc) * 8 + h] * LOG2E : -INFINITY; }
    att::DilHookT<16, false, true> hk; hk.rowbase = (long)b * SEQ + r; hk.q0 = 256 * blk; hk.kt0 = blk ? 2 : 0; hk.tb = tb;
    const long qrow0 = (long)b * SEQ + r + 16 * 256 * blk;
    hk.part = (float*)(F.ws + WS_BIG + BG_PART) + ((size_t)qrow0 * 8 + h) * 72;
    att::attn_unit(hk, (const bf16*)(act + pg8::A_QD) + 64 * h, (const bf16*)(act + pg8::A_KD) + 64 * h, (const bf16*)(act + pg8::A_VD) + 64 * h,
                   (bf16*)nullptr, qrow0, blk ? 6 : 4, F.lds, 1024);
}
constexpr size_t MI_W8 = 3 * MiB + 512 * 1024;
constexpr size_t MI_FG = 2 * MiB, MI_KNT = MI_FG + 2 * 8 * SEQ * 4;
__device__ __forceinline__ void fox_fscan_unit(Frame& F, int bh) {
    const int b = bh >> 3, h = bh & 7;
    const float* fl = (const float*)(F.ws + WS_MISC + MI_FL) + (size_t)b * SEQ * 8 + h; float* FG = (float*)(F.ws + WS_MISC + MI_FG) + (size_t)bh * SEQ;
    LAS float* wt = (LAS float*)(F.lds);
    const int s0 = 16 * F.tid; float v[16]; float run = 0.f;
#pragma unroll
    for (int k = 0; k < 16; ++k) { run += fl[(size_t)(s0 + k) * 8]; v[k] = run; }
    float incl = run;
#pragma unroll
    for (int o = 1; o < 64; o <<= 1) { const float t = __shfl_up(incl, o); if (F.lane >= o) incl += t; }
    if (F.lane == 63) wt[F.wave] = incl;
    LDS_BAR();
    float base = incl - run;
#pragma unroll
    for (int w = 0; w < 8; ++w) if (w < F.wave) base += wt[w];
#pragma unroll
    for (int k = 0; k < 16; k += 4) *(GAS f32x4*)(FG + s0 + k) = (f32x4){(base + v[k]) * LOG2E, (base + v[k + 1]) * LOG2E, (base + v[k + 2]) * LOG2E, (base + v[k + 3]) * LOG2E};
}
__device__ __forceinline__ void knorm_unit(Frame& F, int u) {
    const int item = 8 * u + F.wave, bh = item >> 7, tile = item & 127, b = bh >> 3, h = bh & 7;
    const bf16* KC = (const bf16*)(F.ws + WS_ACT + pg8::A_KC) + ((size_t)b * SEQ + 64 * tile + F.lane) * 512 + 64 * h;
    float ss = 0.f;
#pragma unroll
    for (int c = 0; c < 8; ++c) { const v4u w = *(const GAS v4u*)(KC + 8 * c);
        ss += bflo(w.x) * bflo(w.x) + bfhi(w.x) * bfhi(w.x) + bflo(w.y) * bflo(w.y) + bfhi(w.y) * bfhi(w.y) + bflo(w.z) * bflo(w.z) + bfhi(w.z) * bfhi(w.z) + bflo(w.w) * bflo(w.w) + bfhi(w.w) * bfhi(w.w); }
#pragma unroll
    for (int o = 1; o < 64; o <<= 1) ss = __builtin_fmaxf(ss, __shfl_xor(ss, o));
    if (F.lane == 0) ((float*)(F.ws + WS_MISC + MI_KNT))[item] = sqrtf(ss);
}
__device__ __forceinline__ void fox_attn_unit(Frame& F, int b, int h, int qb) {
    unsigned char* act = F.ws + WS_ACT;
    LAS float* Ft = (LAS float*)(F.lds + att::L_TAB); LAS float* knp = (LAS float*)(F.lds + att::L_TAB + 32768); LAS float* red = knp + 128;
    int tidl = threadIdx.x; asm volatile("" : "+v"(tidl));
    const int bh = b * 8 + h; const int n = 256 * (qb + 1), NT = 4 * (qb + 1);
    const float* FG = (const float*)(F.ws + WS_MISC + MI_FG) + (size_t)bh * SEQ; const float* KNT = (const float*)(F.ws + WS_MISC + MI_KNT) + bh * 128;
    { const int s0 = 16 * tidl; if (s0 < n) {
#pragma unroll
          for (int k = 0; k < 16; k += 4) *(LAS f32x4*)(Ft + s0 + k) = *(const GAS f32x4*)(FG + s0 + k); } }
    if (tidl < 128) { float m = tidl < NT ? KNT[tidl] : 0.f;
#pragma unroll
        for (int o = 1; o < 64; o <<= 1) { const float t = __shfl_up(m, o); if (F.lane >= o) m = __builtin_fmaxf(m, t); }
        if (tidl == 63) red[8] = m; knp[tidl] = m; }
    { const bf16* qp = (const bf16*)(act + pg8::A_QC) + ((size_t)b * SEQ + 256 * qb + (tidl >> 1)) * 512 + 64 * h + 32 * (tidl & 1); float ss = 0.f;
#pragma unroll
      for (int c = 0; c < 4; ++c) { const v4u w = *(const GAS v4u*)(qp + 8 * c);
          ss += bflo(w.x) * bflo(w.x) + bfhi(w.x) * bfhi(w.x) + bflo(w.y) * bflo(w.y) + bfhi(w.y) * bfhi(w.y) + bflo(w.z) * bflo(w.z) + bfhi(w.z) * bfhi(w.z) + bflo(w.w) * bflo(w.w) + bfhi(w.w) * bfhi(w.w); }
      ss += __shfl_xor(ss, 1);
#pragma unroll
      for (int o = 2; o < 64; o <<= 1) ss = __builtin_fmaxf(ss, __shfl_xor(ss, o));
      if (F.lane == 0) red[F.wave] = ss; }
    LDS_BAR();
    if (tidl >= 64 && tidl < 128) knp[tidl] = __builtin_fmaxf(knp[tidl], red[8]);
    LDS_BAR();
    float qm = red[0];
#pragma unroll
    for (int w = 1; w < 8; ++w) qm = __builtin_fmaxf(qm, red[w]);
    att::FoxHook hk; hk.rowbase = (long)b * SEQ; hk.NT = NT; hk.q0 = 256 * qb; hk.Ft = Ft; hk.knp = knp; hk.qmax = sqrtf(qm);
    att::attn_unit_pipe(hk, (const bf16*)(act + pg8::A_QC) + 64 * h, (const bf16*)(act + pg8::A_KC) + 64 * h, (const bf16*)(act + pg8::A_VC) + 64 * h,
                   (bf16*)(F.ws + WS_MIX) + 64 * h, (long)b * SEQ + 256 * qb, NT, F.lds, 1024);
}

struct Args {
    const float *x, *ln_g, *ln_b, *rel, *w_in_ab, *w_gate, *b_gate, *g_norm, *w_out_ab, *w_in_cd, *b_forget, *w_out_cd, *w1d, *w3d, *w2d, *w_router, *w1m, *w3m, *w2m;
    float* out; unsigned char* ws; int ph_lo, ph_hi;
};
#ifndef PH_MASK
#define PH_MASK 0x7ff
#endif
#define PH_EN(k) (((PH_MASK) >> (k)) & 1)
#ifndef REP_K
#define REP_K (-1)
#endif
#ifndef REP_PAR
#define REP_PAR 2
#endif
#ifndef REP_SUB
#define REP_SUB 0
#endif
#define SUBSKIP(first) (rep == 1 && ((REP_SUB == 1 && !(first)) || (REP_SUB == 2 && (first))))
#define NREP(k) ((REP_K == (k) && (REP_PAR == 2 || REP_PAR == (ly & 1))) ? 2 : 1)
constexpr int PH_PER_LAYER = 11, PH_TOTAL = DEPTH * PH_PER_LAYER;
__global__ void __launch_bounds__(NTHR, 2) hyb_fwd(Args args) {
    extern __shared__ __attribute__((aligned(16))) unsigned char lds_raw[];
    Frame F;
    F.lds = (LAS unsigned char*)lds_raw;
    F.MISC = (volatile LAS unsigned*)(F.lds + MISC_OFF);
    F.tid = threadIdx.x; F.lane = F.tid & 63; F.wave = __builtin_amdgcn_readfirstlane(F.tid >> 6);
    F.qk = 0; F.G = gridDim.x; { const int bx = blockIdx.x; F.vcu = (F.G % 8 == 0) ? (bx % 8) * (F.G / 8) + bx / 8 : bx; }
    F.ws = args.ws; F.ctl = (gu32*)(args.ws + WS_CTL);
    for (int u = F.tid; u < (LDS_BYTES - LDSCTL_OFF) / 4; u += NTHR) ((LAS unsigned*)(F.lds + LDSCTL_OFF))[u] = 0u;
    __syncthreads();
    const int lo = args.ph_lo, hi = args.ph_hi;
    const bool use_bar = (hi - lo) > 1;
    XcdBarrier bar; bar.bar = (unsigned*)(F.ctl + CW_BAR); bar.x = 0; bar.st = nullptr;
    if (use_bar) bar = xcd_barrier_post((unsigned*)(F.ctl + CW_BAR), F.MISC + 8);
#define RUN(g) (lo <= (g) && (g) < hi)
#if defined(PROF_A)
    volatile LAS unsigned long long* pstamp = (volatile LAS unsigned long long*)(F.lds + LDSCTL_OFF + 512);
    if (blockIdx.x == 0 && F.tid == 0) { for (int i_ = 0; i_ <= PH_TOTAL; ++i_) pstamp[i_] = 0ull; pstamp[0] = __builtin_amdgcn_s_memrealtime(); }
#define STAMP(g) do { if (blockIdx.x == 0 && threadIdx.x == 0) pstamp[(g) + 1] = __builtin_amdgcn_s_memrealtime(); } while (0)
#else
#define STAMP(g) do { } while (0)
#endif
#define PHASE_BEGIN() do { int t_ = threadIdx.x; asm volatile("" : "+v"(t_)); F.tid = t_; F.lane = t_ & 63; F.wave = __builtin_amdgcn_readfirstlane(t_ >> 6); \
        GAS unsigned char* wg_ = (GAS unsigned char*)args.ws; asm volatile("" : "+s"(wg_)); unsigned char* w_ = (unsigned char*)wg_; F.ws = w_; F.ctl = (gu32*)(w_ + WS_CTL); ws = w_; act = w_ + WS_ACT; big = w_ + WS_BIG; \
        X = (float*)(w_ + WS_X); XB = (bf16*)(w_ + WS_XB); MIX = (bf16*)(w_ + WS_MIX); Y = (bf16*)(w_ + WS_Y); Hb = (bf16*)(w_ + WS_BIG + BG_H); XG = (bf16*)(w_ + WS_BIG + BG_XG); } while (0)
#define BAR_AFTER(g) do { if ((g) + 1 < hi) { xcd_barrier(bar); } } while (0)
    unsigned char* ws = args.ws; unsigned char* act = ws + WS_ACT; unsigned char* big = ws + WS_BIG;
    float* X = (float*)(ws + WS_X); bf16* XB = (bf16*)(ws + WS_XB); bf16* MIX = (bf16*)(ws + WS_MIX); bf16* Y = (bf16*)(ws + WS_Y);
    bf16* Hb = (bf16*)(big + BG_H); bf16* XG = (bf16*)(big + BG_XG);

    for (int ly = 0; ly < DEPTH; ++ly) {
        const int j = ly >> 1; const bool even = (ly & 1) == 0; const int g0 = ly * PH_PER_LAYER;
        gu32* qh = F.ctl + CW_Q + (ly * 8) * 64; gu32* cnt = F.ctl + CW_CNT + (j * 8) * 64;
        unsigned long long* mask_layer = (unsigned long long*)(ws + WS_MASK + (size_t)j * 16 * MiB);
        if (ly == 0 && RUN(g0 + 0) && PH_EN(0)) for (int rep = 0; rep < NREP(0); ++rep) { PHASE_BEGIN();
            if (even) {
                conv_matrix(F, 1, args.w_in_ab + (size_t)j * DM * W_AB, nullptr, W_AB, DM, (bf16*)(ws + WS_EVW + EV_WAB), NAB);
                for (int s_ = blockIdx.x; s_ < 256; s_ += F.G) { const int k = s_ >> 6, sl = s_ & 63, jj = k >> 1; float* img = (float*)(ws + WS_MISC + MI_W8) + (size_t)k * 8192;
                    if (k & 1) w8_image(F, args.w_in_cd + (size_t)jj * DM * W_CD, W_CD, 1536, img, sl); else w8_image(F, args.w_router + (size_t)jj * DM * NEXP, NEXP, 0, img, sl); }
                rows_to_bf16(F, args.x, XB);
            }
            BAR_AFTER(g0 + 0); STAMP(g0 + 0);
        }
        if (RUN(g0 + 1) && PH_EN(1)) for (int rep = 0; rep < NREP(1); ++rep) { PHASE_BEGIN();
            pg8::Gemm g{XB, even ? (const bf16*)(ws + WS_EVW + EV_WAB) : (const bf16*)(big + BG_WCD), M, even ? NAB : NCD, DM};
            pg8::StaticOrder S; S.init(M, even ? NAB : NCD, F.G, (int)blockIdx.x);
            pg8::EpiProj E{act, even ? 0 : 1};
            pg8::gemm_phase<pg8::EpiProj, pg8::StaticOrder, true, true>(F.lds, g, S, E);
            BAR_AFTER(g0 + 1); STAMP(g0 + 1);
        }
        if (RUN(g0 + 2) && PH_EN(2)) for (int rep = 0; rep < NREP(2); ++rep) { PHASE_BEGIN();
            if (even) {
                for (;;) { const int u = q_share(F, q_issue(F, qh + (0 + 4 * rep) * 64)); if (u >= 1536) break;
                    if (SUBSKIP(u < 512)) continue;
                    if (u < 512) dsa::score_unit(F, u & 1, 255 - (u >> 1));
                    else { const int v = u - 512; gla::chunk_unit(F, v >> 9, (v >> 7) & 3, v & 127, args.w_gate + (size_t)j * 16 * 256, args.b_gate + (size_t)j * 256); } }
            } else {
                for (int u = F.vcu; u < 272; u += F.G) { if (u < 16) fox_fscan_unit(F, u); else knorm_unit(F, u - 16); }
                WG_BAR();
                for (int u = F.vcu; u < 512; u += F.G) {
                    dil_far_unit(F, (u >> 7) & 1, (u >> 4) & 7, u & 15, u >> 8, args.rel); WG_BAR(); }
            }
            BAR_AFTER(g0 + 2); STAMP(g0 + 2);
        }
        if (RUN(g0 + 3) && PH_EN(3)) for (int rep = 0; rep < NREP(3); ++rep) { PHASE_BEGIN();
            if (even) {
                for (;;) { const int u = q_share(F, q_issue(F, qh + (1 + 4 * rep) * 64)); if (u >= 640) break;
                    if (SUBSKIP(u < 128)) continue;
                    if (u < 128) gla::scan_unit(F, u);
                    else { const int v = u - 128; const int b = v & 1, qb32 = 255 - (v >> 1); dsa::select_unit(F, b, qb32, mask_layer + ((size_t)(b * 256 + qb32) * 128) * 32); } }
            } else {
                const int nconv = (ly + 1 < DEPTH) ? 26 : 0;
                for (;;) { const int u0 = q_share(F, q_issue(F, qh + (1 + 4 * rep) * 64)); if (u0 >= 1024 + nconv) break;
                    if (u0 >= 64 && u0 < 64 + nconv) { const int c = u0 - 64; int jn = j + 1; asm volatile("" : "+s"(jn)); int ln_ = threadIdx.x & 63; asm volatile("" : "+v"(ln_));
#pragma unroll 1
                        for (int i = 0; i < 16; ++i) conv_even_item(F, ln_, c * 128 + i * 8 + F.wave, args.w_in_ab + (size_t)jn * DM * W_AB, args.w_out_ab + (size_t)jn * DM * DM,
                                                                   args.w1d + (size_t)jn * DM * FFD, args.w3d + (size_t)jn * DM * FFD, args.w2d + (size_t)jn * FFD * DM, ws + WS_EVW);
                        continue; }
                    const int u = u0 < 64 ? u0 : u0 - nconv;
                    if (SUBSKIP(u < 384 || u >= 896)) continue;
                    if (u < 384) { dil_attn_unit(F, (u >> 3) & 1, u & 7, 31 - (u >> 4), args.rel); }
                    else if (u < 896) { const int v = u - 384; fox_attn_unit(F, (v >> 3) & 1, v & 7, 31 - (v >> 4)); }
                    else { const int v = u - 896; dil_attn_unit(F, (v >> 3) & 1, v & 7, 7 - (v >> 4), args.rel); } }
            }
            BAR_AFTER(g0 + 3); STAMP(g0 + 3);
        }
        if (even && RUN(g0 + 4) && PH_EN(4)) for (int rep = 0; rep < NREP(4); ++rep) { PHASE_BEGIN();
            const float* w1m_ = args.w1m + (size_t)j * NEXP * DM * FFE; const float* w3m_ = args.w3m + (size_t)j * NEXP * DM * FFE; const float* w2m_ = args.w2m + (size_t)j * NEXP * DM * FFE;
            const int nce = (ly == 0) ? 19 : 0;
            for (;;) { const int u0 = q_share(F, q_issue(F, qh + (2 + 4 * rep) * 64)); if (u0 >= 1792 + nce) break;
                if (u0 >= 32 && u0 < 32 + nce) { const int c = u0 - 32; int ln_ = threadIdx.x & 63; asm volatile("" : "+v"(ln_));
#pragma unroll 1
                    for (int i = 0; i < 16; ++i) conv_even_item(F, ln_, 960 + c * 128 + i * 8 + F.wave, args.w_in_ab, args.w_out_ab, args.w1d, args.w3d, args.w2d, ws + WS_EVW);
                    continue; }
                const int u = u0 < 32 ? u0 : u0 - nce;
                if (u < 768) { const int w_ = u - 256; const int g3 = u < 256 ? 0 : (w_ >> 1), r3 = (u < 256 || (w_ & 1) == 0) ? 0 : 2;
                    if (r3 < 2) { if (SUBSKIP(true)) continue; const int d = u < 256 ? u : 256 + g3; dsa_attn_unit(F, (d >> 3) & 1, d & 7, 31 - (d >> 4), args.rel, mask_layer); }
                    else { if (rep == 1 && REP_SUB != 3 && REP_SUB != 0) continue; int ln_ = threadIdx.x & 63; asm volatile("" : "+v"(ln_));
#pragma unroll 1
                        for (int i = 0; i < 11; ++i) conv_odd_item(F, ln_, g3 * 88 + i * 8 + F.wave, w1m_, w3m_, w2m_, args.w_in_cd + (size_t)j * DM * W_CD, args.w_out_cd + (size_t)j * DM * DM, big); } }
                else { if (SUBSKIP(false)) continue; const int v = u - 768; gla::out_unit(F, v >> 9, (v >> 7) & 3, v & 127, args.g_norm + (size_t)j * 128); } }
            BAR_AFTER(g0 + 4); STAMP(g0 + 4);
        }
        if (RUN(g0 + 5) && PH_EN(5)) for (int rep = 0; rep < NREP(5); ++rep) { PHASE_BEGIN();
            pg8::Gemm g{MIX, even ? (const bf16*)(ws + WS_EVW + EV_WO) : (const bf16*)(big + BG_WOD), M, DM, DM};
            pg8::StaticOrder S; S.init(M, DM, F.G, (int)blockIdx.x);
            pg8::EpiPlain E{Y, DM, 4};
            pg8::gemm_phase<pg8::EpiPlain, pg8::StaticOrder, true, true>(F.lds, g, S, E);
            BAR_AFTER(g0 + 5); STAMP(g0 + 5);
        }
        if (RUN(g0 + 6) && PH_EN(6)) for (int rep = 0; rep < NREP(6); ++rep) { PHASE_BEGIN();
            const bool dry = (NREP(6) == 2 && rep == 0);
            ln_phase(F, args.x, ly == 0 ? nullptr : XB, Y, 0, args.ln_g + (size_t)(ly * 2) * DM, args.ln_b + (size_t)(ly * 2) * DM, dry ? (float*)(act) : nullptr, dry ? (bf16*)(act + 64 * MiB) : XB,
                     even ? 0 : 1, (const float*)(ws + WS_MISC + MI_W8) + (size_t)(2 * j) * 8192, nullptr, dry ? cnt + 4096 : cnt);
            BAR_AFTER(g0 + 6); STAMP(g0 + 6);
        }
        if (!even && RUN(g0 + 7) && PH_EN(7)) for (int rep = 0; rep < NREP(7); ++rep) { PHASE_BEGIN(); scatter_phase(F, XB, XG, cnt); BAR_AFTER(g0 + 7); STAMP(g0 + 7); }
        int ts[9];
        if (even) { ts[0] = 0;
#pragma unroll
            for (int e = 1; e < 9; ++e) ts[e] = M / 256; }
        else moe_tiles(cnt, ts);
        if (RUN(g0 + 8) && PH_EN(8)) for (int rep = 0; rep < NREP(8); ++rep) { PHASE_BEGIN();
            pg8::Gemm g{even ? XB : XG, even ? (const bf16*)(ws + WS_EVW + EV_W13) : (const bf16*)(big + BG_W13M), M, 0, DM};
            pg8::GroupOrder S; S.init(ts, even ? 22 : 28, F.G, (int)blockIdx.x);
            pg8::EpiSwiGLU E{Hb, even ? FFD : FFE, even ? 22 : 28};
            pg8::gemm_phase<pg8::EpiSwiGLU, pg8::GroupOrder, true, true>(F.lds, g, S, E);
            BAR_AFTER(g0 + 8); STAMP(g0 + 8);
        }
        if (RUN(g0 + 9) && PH_EN(9)) for (int rep = 0; rep < NREP(9); ++rep) { PHASE_BEGIN();
            pg8::Gemm g{Hb, even ? (const bf16*)(ws + WS_EVW + EV_W2) : (const bf16*)(big + BG_W2M), M, 0, even ? FFD : FFE};
            if (even) {
                pg8::GroupOrder S; S.init(ts, 4, F.G, (int)blockIdx.x);
                pg8::EpiPlain E{Y, DM, 4};
                pg8::gemm_phase<pg8::EpiPlain, pg8::GroupOrder, true, true>(F.lds, g, S, E);
            } else {
                LAS int* tsl = (LAS int*)(F.lds + LDSCTL_OFF + 128);
                if (F.tid == 0) { tsl[0] = ts[0]; tsl[1] = ts[1]; tsl[2] = ts[2]; tsl[3] = ts[3]; tsl[4] = ts[4]; tsl[5] = ts[5]; tsl[6] = ts[6]; tsl[7] = ts[7]; tsl[8] = ts[8]; }
                WG_BAR();
                pg8::SplitTailOrder S; S.init(tsl, ts[8], F.G, (int)blockIdx.x);
                pg8::EpiPlainSplit E{XG, (float*)(big + BG_PARTF), DM, 4};
                pg8::gemm_phase<pg8::EpiPlainSplit, pg8::SplitTailOrder, true, true>(F.lds, g, S, E);
            }
            BAR_AFTER(g0 + 9); STAMP(g0 + 9);
        }
        if (RUN(g0 + 10) && PH_EN(10)) for (int rep = 0; rep < NREP(10); ++rep) { PHASE_BEGIN();
            const bool dry10 = (NREP(10) == 2 && rep == 0);
            ln_phase(F, nullptr, XB, even ? Y : XG, even ? 0 : 1, args.ln_g + (size_t)(ly * 2 + 1) * DM, args.ln_b + (size_t)(ly * 2 + 1) * DM, dry10 ? (float*)(act) : (ly == DEPTH - 1 ? args.out : nullptr), dry10 ? (bf16*)(act + 64 * MiB) : XB,
                     even ? 2 : 0, (const float*)(ws + WS_MISC + MI_W8) + (size_t)(2 * j + 1) * 8192, args.b_forget + (size_t)j * 8, cnt, even ? nullptr : (const float*)(big + BG_PARTF));
            BAR_AFTER(g0 + 10); STAMP(g0 + 10);
        }
    }
#if defined(PROF_A)
    {
        xcd_barrier(bar);
        if (blockIdx.x == 0 && threadIdx.x == 0) {
            unsigned long long prev = pstamp[0]; float dA = 0.f, dB = 0.f;
            for (int g_ = 0; g_ < PH_TOTAL; ++g_) { const unsigned long long t_ = pstamp[g_ + 1]; if (t_ == 0ull) continue; const float d_ = (float)(t_ - prev) * 0.01f; prev = t_;
                const int code_ = ((g_ / PH_PER_LAYER) & 1) * 16 + (g_ % PH_PER_LAYER);
                if (code_ == (PROF_A) || (PROF_A) == 99) dA += d_; if (code_ == (PROF_B)) dB += d_; }
            float* pw_ = (float*)(args.ws + WS_CTL + 65536 * 4); pw_[0] = dA; pw_[1] = dB; }
        xcd_barrier(bar);
        const float* pr_ = (const float*)(args.ws + WS_CTL + 65536 * 4); const float cA = sqrtf(__hip_atomic_load(pr_, RLX_AGENT)), cB = __hip_atomic_load(pr_ + 1, RLX_AGENT);
        for (size_t i_ = (size_t)blockIdx.x * NTHR + threadIdx.x; i_ < (size_t)M * DM; i_ += (size_t)gridDim.x * NTHR) args.out[i_] = (i_ == 0) ? 100.0f * cB : cA;
    }
#endif
#undef RUN
#undef BAR_AFTER
}

#ifndef HYB_N_LAUNCHES
#define HYB_N_LAUNCHES 1
#endif
extern "C" void kernel_launch(void* const* d_in, const int* in_sizes, int n_in, void* d_out, int out_size, void* d_ws, size_t ws_size, hipStream_t stream) {
    static int grid = 0;
    if (grid == 0) {
        if (n_in != 19 || in_sizes[0] != M * DM || out_size != M * DM || ws_size < WS_END) { fprintf(stderr, "kernel_launch: unexpected shapes / workspace (n_in %d, ws %zu, need %zu)\n", n_in, ws_size, (size_t)WS_END); grid = -1; return; }
        { const long exp_sz[19] = {(long)M * DM, (long)DEPTH * 2 * DM, (long)DEPTH * 2 * DM, 32 * 8, 2L * DM * W_AB, 2L * 16 * 256, 2L * 256, 2L * 128, 2L * DM * DM, 2L * DM * W_CD, 2L * 8, 2L * DM * DM,
              2L * DM * FFD, 2L * DM * FFD, 2L * FFD * DM, 2L * DM * NEXP, 2L * NEXP * DM * FFE, 2L * NEXP * DM * FFE, 2L * NEXP * FFE * DM};
          for (int i = 0; i < 19; ++i) if ((long)in_sizes[i] != exp_sz[i]) { fprintf(stderr, "kernel_launch: input %d has %d elements, expected %ld\n", i, in_sizes[i], exp_sz[i]); grid = -1; return; } }
        int dev = 0, cus = 0, per_cu = 0;
        if (hipGetDevice(&dev) != hipSuccess || hipDeviceGetAttribute(&cus, hipDeviceAttributeMultiprocessorCount, dev) != hipSuccess) { grid = -1; return; }
        if (hipFuncSetAttribute((const void*)hyb_fwd, hipFuncAttributeMaxDynamicSharedMemorySize, LDS_BYTES) != hipSuccess) { fprintf(stderr, "kernel_launch: hipFuncSetAttribute failed\n"); grid = -1; return; }
        if (hipOccupancyMaxActiveBlocksPerMultiprocessor(&per_cu, (const void*)hyb_fwd, NTHR, LDS_BYTES) != hipSuccess || per_cu < 1) fprintf(stderr, "kernel_launch: occupancy query reports %d\n", per_cu);
        (void)hipGetLastError();
        grid = cus;
    }
    if (grid < 0) return;
    if (hipMemsetAsync((char*)d_ws + WS_CTL, 0, CTL_ZERO_BYTES, stream) != hipSuccess) { fprintf(stderr, "kernel_launch: memset failed\n"); return; }
    Args a{};
    a.x = (const float*)d_in[0]; a.ln_g = (const float*)d_in[1]; a.ln_b = (const float*)d_in[2]; a.rel = (const float*)d_in[3]; a.w_in_ab = (const float*)d_in[4]; a.w_gate = (const float*)d_in[5];
    a.b_gate = (const float*)d_in[6]; a.g_norm = (const float*)d_in[7]; a.w_out_ab = (const float*)d_in[8]; a.w_in_cd = (const float*)d_in[9]; a.b_forget = (const float*)d_in[10]; a.w_out_cd = (const float*)d_in[11];
    a.w1d = (const float*)d_in[12]; a.w3d = (const float*)d_in[13]; a.w2d = (const float*)d_in[14]; a.w_router = (const float*)d_in[15]; a.w1m = (const float*)d_in[16]; a.w3m = (const float*)d_in[17]; a.w2m = (const float*)d_in[18];
    a.out = (float*)d_out; a.ws = (unsigned char*)d_ws;
#if HYB_N_LAUNCHES == 1
#ifndef HYB_PH_HI
#define HYB_PH_HI PH_TOTAL
#endif
#ifndef HYB_PH_LO
#define HYB_PH_LO 0
#endif
    a.ph_lo = HYB_PH_LO; a.ph_hi = HYB_PH_HI;
    hipLaunchKernelGGL(hyb_fwd, dim3(grid), dim3(NTHR), LDS_BYTES, stream, a);
#else
    for (int ph = 0; ph < PH_TOTAL; ++ph) {
        const int ly = ph / PH_PER_LAYER, k = ph % PH_PER_LAYER; const bool even = (ly & 1) == 0;
        if (even && k == 7) continue; if (!even && k == 4) continue; if (ly > 0 && k == 0) continue;
        a.ph_lo = ph; a.ph_hi = ph + 1;
        hipLaunchKernelGGL(hyb_fwd, dim3(grid), dim3(NTHR), LDS_BYTES, stream, a);
    }
#endif
    const hipError_t le = hipPeekAtLastError();
    if (le != hipSuccess) fprintf(stderr, "kernel_launch: launch failed: %s\n", hipGetErrorName(le));
}
```
